# Optimizing an MI355X kernel written in HIP

```python
import jax, jax.numpy as jnp
from jax import lax
import numpy as np

D_MODEL = 1024
BATCH = 2
SEQ = 8192
DEPTH = 1
DEC_BATCH = 32
DEC_SEQ = 8
PAST_LEN = 8192
PAGE_SIZE = 128

HEAD_DIM = 64
MIX_W = D_MODEL
ATT_W = 3 * D_MODEL // 8
RWKV_W = 3 * D_MODEL // 8
MEM_W = D_MODEL // 4
ATT_HEADS = ATT_W // HEAD_DIM
RWKV_HEADS = RWKV_W // HEAD_DIM
MEM_HEADS = MEM_W // HEAD_DIM
DILATED = ((128, 1), (512, 4), (2048, 16))
MAX_WINDOW = 2048
BAND_UNITS = 128
ROPE_DIM = HEAD_DIM // 4
ROPE_THETA = 500000.0
N_MEM = 256
LORA_W = 64
LORA_A = 64
SHIFT_W = 3 * RWKV_W + LORA_W + LORA_A
IN_SPLITS = (ATT_W, 2 * ATT_W, 3 * ATT_W, 3 * ATT_W + SHIFT_W, 3 * ATT_W + SHIFT_W + MEM_W)
IN_W = 3 * ATT_W + SHIFT_W + MEM_W + MIX_W
NORM_EPS = 1e-6
LNX_EPS = 64e-5

kernel_name = "hybrid_dilated_rwkv7_memory_step"


def rms_norm(x, g):
    xf = x.astype(jnp.float32)
    y = xf * lax.rsqrt(jnp.mean(xf * xf, axis=-1, keepdims=True) + NORM_EPS)
    return (y * g.astype(jnp.float32)).astype(x.dtype)


def partial_rope(x, pos):
    half = ROPE_DIM // 2
    inv_freq = ROPE_THETA ** (-jnp.arange(half, dtype=jnp.float32) / half)
    ang = pos.astype(jnp.float32)[:, None] * inv_freq[None, :]
    cos = jnp.cos(ang)[None, :, None, :]
    sin = jnp.sin(ang)[None, :, None, :]
    xr = x[..., :ROPE_DIM].astype(jnp.float32)
    x1, x2 = xr[..., :half], xr[..., half:]
    rot = jnp.concatenate([x1 * cos - x2 * sin, x2 * cos + x1 * sin], axis=-1)
    return jnp.concatenate([rot.astype(x.dtype), x[..., ROPE_DIM:]], axis=-1)


def input_projection(x, norm_g, w_in):
    B, S, _ = x.shape
    z = rms_norm(x, norm_g) @ w_in
    q_a, k_a, v_a, z_b, q_m, gate = jnp.split(z, IN_SPLITS, axis=-1)
    heads = lambda t, n: t.reshape(B, S, n, HEAD_DIM)
    return (heads(q_a, ATT_HEADS), heads(k_a, ATT_HEADS), heads(v_a, ATT_HEADS),
            z_b, heads(q_m, MEM_HEADS), gate)


def dilated_branch_prompt(q, k, v, dil):
    B, S, H, Dh = q.shape
    Qb = BAND_UNITS
    span = dil * Qb
    S_pad = -(-S // span) * span
    L = S_pad // dil
    nb = L // Qb
    pad = ((0, 0), (0, S_pad - S), (0, 0), (0, 0))

    def to_blocks(t):
        t = jnp.pad(t, pad).reshape(B, L, dil, H, Dh)
        return t.transpose(0, 2, 3, 1, 4).reshape(B, dil, H, nb, Qb, Dh)

    def with_prev(t):
        prev = jnp.pad(t[:, :, :, :-1], ((0, 0), (0, 0), (0, 0), (1, 0), (0, 0), (0, 0)))
        return jnp.concatenate([prev, t], axis=4)

    qb = to_blocks(q)
    kb = with_prev(to_blocks(k))
    vb = with_prev(to_blocks(v)).astype(jnp.float32)
    s = jnp.einsum('brhnqd,brhnkd->brhnqk', qb, kb).astype(jnp.float32)
    qi = jnp.arange(Qb)[:, None]
    kj = jnp.arange(2 * Qb)[None, :]
    dist = Qb + qi - kj
    band = (dist >= 0) & (dist <= BAND_UNITS)
    has_prev = (jnp.arange(nb)[:, None, None] > 0) | (kj >= Qb)[None]
    mask = band[None] & has_prev
    s = jnp.where(mask, s, -jnp.inf)
    m = jnp.max(s, axis=-1, keepdims=True)
    p = jnp.exp(s - m)
    l = jnp.sum(p, axis=-1, keepdims=True)
    o = jnp.einsum('brhnqk,brhnkd->brhnqd', p, vb) / l
    lse = (m + jnp.log(l))[..., 0]
    o = o.reshape(B, dil, H, L, Dh).transpose(0, 3, 1, 2, 4).reshape(B, S_pad, H, Dh)[:, :S]
    lse = lse.reshape(B, dil, H, L).transpose(0, 3, 1, 2).reshape(B, S_pad, H)[:, :S]
    return o, lse


def dilated_branch_sample(q, k_all, v_all, dil, n_past):
    T = q.shape[1]
    j = jnp.arange(BAND_UNITS + 1)
    idx = n_past + jnp.arange(T)[:, None] - dil * j[None, :]
    valid = idx >= 0
    idx_c = jnp.maximum(idx, 0)
    kg = k_all[:, idx_c]
    vg = v_all[:, idx_c].astype(jnp.float32)
    s = jnp.einsum('bthd,btjhd->bthj', q, kg).astype(jnp.float32)
    s = jnp.where(valid[None, :, None, :], s, -jnp.inf)
    m = jnp.max(s, axis=-1, keepdims=True)
    p = jnp.exp(s - m)
    l = jnp.sum(p, axis=-1, keepdims=True)
    o = jnp.einsum('bthj,btjhd->bthd', p, vg) / l
    return o, (m + jnp.log(l))[..., 0]


def combine_dilations(outs, lses, dtype):
    w = jax.nn.softmax(jnp.stack(lses, axis=-1), axis=-1)
    o = sum(w[..., i, None] * outs[i] for i in range(len(outs)))
    return o.astype(dtype)


def rwkv7_branch(z, shift0, state0, mu, w0, w2, a0, a2, k_k, k_a, r_k, lnx_g, lnx_b):
    B, S, _ = z.shape
    H, N = RWKV_HEADS, HEAD_DIM
    f32 = jnp.float32
    zf = z.astype(f32)
    z_prev = jnp.concatenate([shift0[:, None].astype(f32), zf[:, :-1]], axis=1)
    zs = zf + (z_prev - zf) * mu.astype(f32)
    r, k, v, wl, al = jnp.split(zs, (RWKV_W, 2 * RWKV_W, 3 * RWKV_W, 3 * RWKV_W + LORA_W), axis=-1)
    w = -jax.nn.softplus(-(w0.astype(f32) + jnp.tanh(wl) @ w2.astype(f32))) - 0.5
    decay = jnp.exp(-jnp.exp(w))
    a = jax.nn.sigmoid(a0.astype(f32) + al @ a2.astype(f32))
    heads = lambda t: t.reshape(B, S, H, N)
    kk = heads(k * k_k.astype(f32))
    kk = kk / jnp.maximum(jnp.sqrt(jnp.sum(kk * kk, axis=-1, keepdims=True)), 1e-12)
    k = k * (1.0 + (a - 1.0) * k_a.astype(f32))
    r, k, v, decay, a = heads(r), heads(k), heads(v), heads(decay), heads(a)
    b = kk * a

    def step(st, inp):
        r_t, k_t, v_t, w_t, kk_t, b_t = inp
        sa = jnp.einsum('bhvk,bhk->bhv', st, -kk_t)
        st = st * w_t[:, :, None, :] + sa[..., None] * b_t[:, :, None, :] + v_t[..., None] * k_t[:, :, None, :]
        return st, jnp.einsum('bhvk,bhk->bhv', st, r_t)

    tm = lambda t: jnp.swapaxes(t, 0, 1)
    state, y = lax.scan(step, state0.astype(f32), (tm(r), tm(k), tm(v), tm(decay), tm(kk), tm(b)))
    y = tm(y)
    mean = jnp.mean(y, axis=-1, keepdims=True)
    var = jnp.mean((y - mean) ** 2, axis=-1, keepdims=True)
    y = ((y - mean) * lax.rsqrt(var + LNX_EPS)).reshape(B, S, RWKV_W)
    y = y * lnx_g.astype(f32) + lnx_b.astype(f32)
    bonus = jnp.sum(r * k * r_k.astype(f32), axis=-1, keepdims=True) * v
    y = y + bonus.reshape(B, S, RWKV_W)
    return y.astype(z.dtype), state.astype(state0.dtype), z[:, -1]


def memory_attention(q, mem_k, mem_v):
    s = jnp.einsum('bshd,bmhd->bhsm', q, mem_k).astype(jnp.float32)
    p = jax.nn.softmax(s, axis=-1)
    return jnp.einsum('bhsm,bmhd->bshd', p, mem_v.astype(jnp.float32)).astype(q.dtype)


def memory_kv(mem, norm_g, w_kv):
    B = mem.shape[0]
    mk, mv = jnp.split(rms_norm(mem, norm_g) @ w_kv, 2, axis=-1)
    return mk.reshape(B, N_MEM, MEM_HEADS, HEAD_DIM), mv.reshape(B, N_MEM, MEM_HEADS, HEAD_DIM)


def output_projection(x, o_a, o_b, o_m, gate, w_out):
    B, S, _ = x.shape
    o = jnp.concatenate([o_a.reshape(B, S, ATT_W), o_b, o_m.reshape(B, S, MEM_W)], axis=-1)
    return x + (o * jax.nn.silu(gate)) @ w_out


def setup_inputs(seed: int = 0) -> dict:
    key = jax.random.key(seed)
    ks = jax.random.split(key, 32)
    f32 = jnp.float32
    nrm = lambda k, shape, scale: jax.random.normal(k, shape, f32) * scale
    Lr = DEPTH
    win_past = min(MAX_WINDOW, PAST_LEN)
    return {
        "x_prompt": nrm(ks[0], (BATCH, SEQ, D_MODEL), 1.0),
        "x_sample": nrm(ks[1], (DEC_BATCH, DEC_SEQ, D_MODEL), 1.0),
        "cache_win_k": nrm(ks[2], (Lr, DEC_BATCH, win_past, ATT_HEADS, HEAD_DIM), 1.0),
        "cache_win_v": nrm(ks[3], (Lr, DEC_BATCH, win_past, ATT_HEADS, HEAD_DIM), 1.0),
        "state_rwkv": nrm(ks[4], (Lr, DEC_BATCH, RWKV_HEADS, HEAD_DIM, HEAD_DIM), 1.0),
        "state_rwkv_shift": nrm(ks[5], (Lr, DEC_BATCH, SHIFT_W), 1.0),
        "cache_mem_k": nrm(ks[6], (Lr, DEC_BATCH, N_MEM, MEM_HEADS, HEAD_DIM), 1.0),
        "cache_mem_v": nrm(ks[7], (Lr, DEC_BATCH, N_MEM, MEM_HEADS, HEAD_DIM), 1.0),
        "mem_prompt": nrm(ks[8], (BATCH, N_MEM, D_MODEL), 1.0),
        "norm_in": 1.0 + nrm(ks[9], (Lr, D_MODEL), 0.02),
        "w_in": nrm(ks[10], (Lr, D_MODEL, IN_W), D_MODEL ** -0.5),
        "rwkv_mu": jax.random.uniform(ks[11], (Lr, SHIFT_W), f32),
        "rwkv_w0": jax.random.uniform(ks[12], (Lr, RWKV_W), f32, -6.0, -1.0),
        "rwkv_w2": nrm(ks[13], (Lr, LORA_W, RWKV_W), 0.5 * LORA_W ** -0.5),
        "rwkv_a0": nrm(ks[14], (Lr, RWKV_W), 0.1),
        "rwkv_a2": nrm(ks[15], (Lr, LORA_A, RWKV_W), LORA_A ** -0.5),
        "rwkv_k_k": 0.85 + nrm(ks[16], (Lr, RWKV_W), 0.05),
        "rwkv_k_a": 1.0 + nrm(ks[17], (Lr, RWKV_W), 0.05),
        "rwkv_r_k": nrm(ks[18], (Lr, RWKV_HEADS, HEAD_DIM), 0.1),
        "rwkv_lnx_g": 1.0 + nrm(ks[19], (Lr, RWKV_W), 0.02),
        "rwkv_lnx_b": nrm(ks[20], (Lr, RWKV_W), 0.02),
        "norm_mem": 1.0 + nrm(ks[21], (Lr, D_MODEL), 0.02),
        "w_mem_kv": nrm(ks[22], (Lr, D_MODEL, 2 * MEM_W), D_MODEL ** -0.5),
        "w_out": nrm(ks[23], (Lr, MIX_W, D_MODEL), MIX_W ** -0.5),
        "norm_final": 1.0 + nrm(ks[24], (D_MODEL,), 0.02),
    }


def reference(x_prompt, x_sample, cache_win_k, cache_win_v, state_rwkv, state_rwkv_shift,
              cache_mem_k, cache_mem_v, mem_prompt, norm_in, w_in, rwkv_mu, rwkv_w0, rwkv_w2,
              rwkv_a0, rwkv_a2, rwkv_k_k, rwkv_k_a, rwkv_r_k, rwkv_lnx_g, rwkv_lnx_b,
              norm_mem, w_mem_kv, w_out, norm_final):
    B, S, _ = x_prompt.shape
    DB, T, _ = x_sample.shape
    scale = HEAD_DIM ** -0.5
    pos_p = jnp.arange(S)
    pos_s = PAST_LEN + jnp.arange(T)
    win_p = min(MAX_WINDOW, S)
    n_past = cache_win_k.shape[2]
    xp, xs = x_prompt, x_sample
    wk_p, wv_p, st_p, sh_p, mk_p, mv_p = [], [], [], [], [], []
    wk_s, wv_s, st_s, sh_s = [], [], [], []
    for l in range(DEPTH):
        rw = (rwkv_mu[l], rwkv_w0[l], rwkv_w2[l], rwkv_a0[l], rwkv_a2[l], rwkv_k_k[l],
              rwkv_k_a[l], rwkv_r_k[l], rwkv_lnx_g[l], rwkv_lnx_b[l])
        q_a, k_a, v_a, z_b, q_m, gate = input_projection(xp, norm_in[l], w_in[l])
        q_a = partial_rope(q_a, pos_p) * scale
        k_a = partial_rope(k_a, pos_p)
        outs, lses = [], []
        for _, dil in DILATED:
            o_i, lse_i = dilated_branch_prompt(q_a, k_a, v_a, dil)
            outs.append(o_i)
            lses.append(lse_i)
        o_a = combine_dilations(outs, lses, xp.dtype)
        o_b, st_b, sh_b = rwkv7_branch(z_b, jnp.zeros((B, SHIFT_W), xp.dtype),
                                       jnp.zeros((B, RWKV_HEADS, HEAD_DIM, HEAD_DIM), xp.dtype), *rw)
        mk, mv = memory_kv(mem_prompt, norm_mem[l], w_mem_kv[l])
        o_m = memory_attention(q_m * scale, mk, mv)
        xp = output_projection(xp, o_a, o_b, o_m, gate, w_out[l])
        wk_p.append(k_a[:, S - win_p:])
        wv_p.append(v_a[:, S - win_p:])
        st_p.append(st_b)
        sh_p.append(sh_b)
        mk_p.append(mk)
        mv_p.append(mv)
        q_s, k_s, v_s, z_s, qm_s, gate_s = input_projection(xs, norm_in[l], w_in[l])
        q_s = partial_rope(q_s, pos_s) * scale
        k_s = partial_rope(k_s, pos_s)
        k_all = jnp.concatenate([cache_win_k[l], k_s], axis=1)
        v_all = jnp.concatenate([cache_win_v[l], v_s], axis=1)
        outs, lses = [], []
        for _, dil in DILATED:
            o_i, lse_i = dilated_branch_sample(q_s, k_all, v_all, dil, n_past)
            outs.append(o_i)
            lses.append(lse_i)
        oa_s = combine_dilations(outs, lses, xs.dtype)
        ob_s, stb_s, shb_s = rwkv7_branch(z_s, state_rwkv_shift[l], state_rwkv[l], *rw)
        om_s = memory_attention(qm_s * scale, cache_mem_k[l], cache_mem_v[l])
        xs = output_projection(xs, oa_s, ob_s, om_s, gate_s, w_out[l])
        wk_s.append(k_s)
        wv_s.append(v_s)
        st_s.append(stb_s)
        sh_s.append(shb_s)
    y_prompt = rms_norm(xp, norm_final)
    y_sample = rms_norm(xs, norm_final)
    return (y_prompt, y_sample,
            jnp.stack(wk_p), jnp.stack(wv_p), jnp.stack(st_p), jnp.stack(sh_p),
            jnp.stack(mk_p), jnp.stack(mv_p),
            jnp.stack(wk_s), jnp.stack(wv_s), jnp.stack(st_s), jnp.stack(sh_s))
```

```cpp
#include <hip/hip_runtime.h>
#include <hip/hip_cooperative_groups.h>
#include <cstdio>
#include <cstdint>
namespace cg = cooperative_groups;

#define LAS __attribute__((address_space(3)))
typedef unsigned short bf16_t;
typedef short bf16x8 __attribute__((ext_vector_type(8)));
typedef short s16x4 __attribute__((ext_vector_type(4)));
typedef float f32x4 __attribute__((ext_vector_type(4)));
typedef float f32x2 __attribute__((ext_vector_type(2)));
typedef float f32x16 __attribute__((ext_vector_type(16)));
typedef unsigned u32x4 __attribute__((ext_vector_type(4)));
typedef unsigned u32x2 __attribute__((ext_vector_type(2)));
typedef __bf16 bf16x2_t __attribute__((ext_vector_type(2)));

constexpr int DM = 1024, SEQ = 8192, NB = 2, DB = 32, DT = 8;
constexpr int MP = NB * SEQ;
constexpr int MS = DB * DT;
constexpr int MTOK = MP + MS;
constexpr int NMEM = 256, MMEM = NB * NMEM;
constexpr int MROWS = MTOK + MMEM;
constexpr int ATT_W = 384, RW = 384, MEM_W = 256, SHIFT_W = 1280, IN_W = 3712;
constexpr int NPAD = 3840;
constexpr int NWT = NPAD + 512;
constexpr int WINP = 2048;
constexpr int C_Q = 0, C_K = 384, C_V = 768, C_Z = 1152, C_QM = 2432, C_G = 2688;
constexpr size_t O_Y = 0, O_WK_P = 17039360, O_WV_P = 18612224, O_ST_P = 20185088, O_SH_P = 20234240, O_MK_P = 20236800, O_MV_P = 20367872,
                 O_WK_S = 20498944, O_WV_S = 20597248, O_ST_S = 20695552, O_SH_S = 21481984, O_END = 21522944;
constexpr size_t al256(size_t x) { return (x + 255) & ~(size_t)255; }
constexpr size_t WS_CTL = 0;
constexpr size_t WS_RINV = 1u << 20;
constexpr size_t WS_SS = al256(WS_RINV + (size_t)MROWS * 4);
constexpr size_t WS_ROPE = al256(WS_SS + (size_t)MTOK * 4);
constexpr int NPOS = 8200;
constexpr size_t WS_WT = al256(WS_ROPE + (size_t)NPOS * 16 * 4);
constexpr size_t WS_WOT = al256(WS_WT + (size_t)NWT * DM * 2);
constexpr size_t WS_XB = al256(WS_WOT + (size_t)DM * DM * 2);
constexpr size_t WS_Q = al256(WS_XB + (size_t)MROWS * DM * 2);
constexpr size_t WS_K = al256(WS_Q + (size_t)MTOK * ATT_W * 2);
constexpr size_t WS_V = al256(WS_K + (size_t)MTOK * ATT_W * 2);
constexpr size_t WS_ZB = al256(WS_V + (size_t)MTOK * ATT_W * 2);
constexpr size_t WS_QM = al256(WS_ZB + (size_t)MTOK * SHIFT_W * 4);
constexpr size_t WS_G = al256(WS_QM + (size_t)MTOK * MEM_W * 2);
constexpr size_t WS_MKB = al256(WS_G + (size_t)MTOK * DM * 2);
constexpr size_t WS_MVB = al256(WS_MKB + (size_t)MMEM * MEM_W * 2);
constexpr size_t WS_OAP = al256(WS_MVB + (size_t)MMEM * MEM_W * 2);
constexpr size_t WS_LSE = al256(WS_OAP + (size_t)3 * MP * ATT_W * 2);
constexpr size_t WS_OG = al256(WS_LSE + (size_t)3 * MP * 6 * 4);
constexpr size_t WS_END = al256(WS_OG + (size_t)MTOK * DM * 2);

constexpr int LDS_BYTES = 147456;
constexpr int NTHR = 512;

struct Params {
    const float* in[25];
    float* out;
    unsigned char* ws;
    int ph_lo, ph_hi, coop, pad;
};

__device__ __forceinline__ unsigned cvtpk(float lo, float hi) { f32x2 v = {lo, hi}; bf16x2_t b = __builtin_convertvector(v, bf16x2_t); return __builtin_bit_cast(unsigned, b); }
__device__ __forceinline__ bf16_t f2bf(float f) { return (bf16_t)(cvtpk(f, 0.f) & 0xffffu); }
__device__ __forceinline__ float bf2f(bf16_t b) { return __builtin_bit_cast(float, (unsigned)b << 16); }
__device__ __forceinline__ float bflo(unsigned w) { return __builtin_bit_cast(float, w << 16); }
__device__ __forceinline__ float bfhi(unsigned w) { return __builtin_bit_cast(float, w & 0xffff0000u); }
__device__ __forceinline__ float wave_sum(float v) {
#pragma unroll
    for (int o = 1; o < 64; o <<= 1) v += __shfl_xor(v, o);
    return v;
}
__device__ __forceinline__ float wave_max(float v) {
#pragma unroll
    for (int o = 1; o < 64; o <<= 1) v = fmaxf(v, __shfl_xor(v, o));
    return v;
}
#define LDS_WAIT() asm volatile("s_waitcnt lgkmcnt(0)" ::: "memory")

namespace pg8 {
constexpr int BM = 256, BK = 64, HALF = 128, HTB = HALF * BK * 2, STAGE_BYTES = 8 * HTB, NXCD = 8, WGM = 8;
__host__ __device__ __forceinline__ int lds_byte(int r, int c) { const int st = (r >> 4) * 2 + (c >> 5), rr = r & 15, cc = c & 31, ob = rr * 64 + cc * 2; return st * 1024 + (ob ^ (((ob >> 9) & 1) << 5)); }
__host__ __device__ __forceinline__ void stage_rc(int b, int& R, int& C) { const int st = b / 1024, sb = b % 1024, swz = sb ^ (((sb >> 9) & 1) << 5); R = (st >> 1) * 16 + swz / 64; C = (st & 1) * 32 + (swz % 64) / 2; }
__host__ __device__ __forceinline__ int perm32(int rho) { const int n = rho >> 4, i = rho & 15; return 8 * (i >> 2) + 4 * n + (i & 3); }
struct Unit { int pm, pn; };
struct Gemm { const bf16_t* A; const bf16_t* Bt; int M, N, K; };
struct StaticOrder {
    int nM, nN, nwg, G, c;
    __host__ __device__ void init(int M, int N, int G_, int c_) { nM = M / BM; nN = N / BM; nwg = nM * nN; G = G_; c = c_; }
    __host__ __device__ bool next(int i, Unit& u) const {
        const long L = (long)i * G + c; if (L >= nwg) return false;
        int wgid = (int)L; { const int q = nwg / NXCD, r = nwg % NXCD, xcd = wgid % NXCD, off = wgid / NXCD; wgid = (xcd < r ? xcd * (q + 1) : r * (q + 1) + (xcd - r) * q) + off; }
        const int nig = WGM * nN, gid = wgid / nig, fm = gid * WGM, gsz = (nM - fm) < WGM ? (nM - fm) : WGM;
        u.pm = fm + ((wgid % nig) % gsz); u.pn = (wgid % nig) / gsz; return true;
    }
    __device__ __forceinline__ void a_ready(const Unit&) const {}
    __device__ __forceinline__ void done(const Unit&) const {}
};

template <class Epi, class Sched, bool ALIGN_EPI = false, bool SP2 = false>
__device__ __forceinline__ void gemm_phase(LAS unsigned char* lds, const Gemm g, const Sched& S, const Epi& E) {
    const int tid = threadIdx.x, wid = __builtin_amdgcn_readfirstlane(tid >> 6), lane = tid & 63, wr = wid >> 2, wc = wid & 3, fr = lane & 15, fq = lane >> 4;
    const int K = g.K, nt = K / BK;
    unsigned voffA[2], voffB[2];
#pragma unroll
    for (int i = 0; i < 2; ++i) { int R, C; stage_rc(tid * 16 + i * 8192, R, C); const int Rb = Epi::PERM ? ((R & ~31) + perm32(R & 31)) : R;
        voffA[i] = (unsigned)(R * K + C) * 2u; voffB[i] = (unsigned)(Rb * K + C) * 2u; }
    const size_t kstep = (size_t)(BK * 2);
    const size_t hstep = (size_t)HALF * K * 2;
    const size_t tstep = 2 * hstep;
    const unsigned ldsw = (unsigned)wid * 1024u;
    const int aoff = lds_byte(wr * 64 + fr, fq * 8), boff = lds_byte(wc * 32 + fr, fq * 8);
#define PG8_SA(b, h) (((b) * 2 + (h)) * HTB)
#define PG8_SB(b, h) ((4 + (b) * 2 + (h)) * HTB)
#define PG8_STAGE(bufoff, gbase, voff) do { _Pragma("unroll") for (int _i = 0; _i < 2; ++_i) \
        __builtin_amdgcn_global_load_lds((const unsigned*)((const char*)(gbase) + (voff)[_i]), (LAS unsigned*)(lds + (bufoff) + ldsw + _i * 8192), 16, 0, 0); } while (0)
#define PG8_LDA(dst, b, h) do { _Pragma("unroll") for (int m = 0; m < 4; ++m) _Pragma("unroll") for (int k = 0; k < 2; ++k) dst[m][k] = *(const LAS bf16x8*)(lds + PG8_SA(b, h) + aoff + m * 2048 + k * 1024); } while (0)
#define PG8_LDB(dst, b, h) do { _Pragma("unroll") for (int n = 0; n < 2; ++n) _Pragma("unroll") for (int k = 0; k < 2; ++k) dst[n][k] = *(const LAS bf16x8*)(lds + PG8_SB(b, h) + boff + n * 2048 + k * 1024); } while (0)
#define PG8_MMA(ai, bj, At, Bt) do { __builtin_amdgcn_s_setprio(1); _Pragma("unroll") for (int m = 0; m < 4; ++m) _Pragma("unroll") for (int n = 0; n < 2; ++n) _Pragma("unroll") for (int k = 0; k < 2; ++k) \
        acc[ai][bj][m][n] = __builtin_amdgcn_mfma_f32_16x16x32_bf16(Bt[n][k], At[m][k], acc[ai][bj][m][n], 0, 0, 0); __builtin_amdgcn_s_setprio(0); } while (0)
#define PG8_WAIT_V(n) asm volatile("s_waitcnt vmcnt(" #n ")" ::: "memory")
#define PG8_WAIT_L(n) asm volatile("s_waitcnt lgkmcnt(" #n ")" ::: "memory")
#define PG8_BAR __builtin_amdgcn_s_barrier()
#define PG8_SCHED __builtin_amdgcn_sched_barrier(0)
    Unit cur, nxt; int ui = 0;
    if (!S.next(0, cur)) return;
    f32x4 acc[2][2][4][2];
#pragma unroll
    for (int a = 0; a < 2; ++a)
#pragma unroll
        for (int b = 0; b < 2; ++b)
#pragma unroll
            for (int m = 0; m < 4; ++m)
#pragma unroll
                for (int n = 0; n < 2; ++n) acc[a][b][m][n] = (f32x4){0.f, 0.f, 0.f, 0.f};
    bf16x8 At[4][2], B0[2][2], B1[2][2];
    const char* cA = (const char*)g.A + (size_t)cur.pm * tstep; const char* cB = (const char*)g.Bt + (size_t)cur.pn * tstep;
    S.a_ready(cur);
    if constexpr (SP2) {
        PG8_STAGE(PG8_SB(0, 0), cB, voffB); PG8_STAGE(PG8_SB(0, 1), cB + hstep, voffB); PG8_STAGE(PG8_SA(0, 0), cA, voffA); PG8_STAGE(PG8_SA(0, 1), cA + hstep, voffA);
        if (wr == 1) PG8_BAR;
        PG8_WAIT_V(2); PG8_BAR;
        PG8_STAGE(PG8_SB(1, 0), cB + kstep, voffB); PG8_STAGE(PG8_SA(1, 0), cA + kstep, voffA); PG8_STAGE(PG8_SB(1, 1), cB + hstep + kstep, voffB);
        PG8_WAIT_V(6); PG8_BAR;
    } else {
        PG8_STAGE(PG8_SB(0, 0), cB, voffB); PG8_STAGE(PG8_SA(0, 0), cA, voffA); PG8_STAGE(PG8_SB(0, 1), cB + hstep, voffB); PG8_STAGE(PG8_SA(0, 1), cA + hstep, voffA);
        if (wr == 1) PG8_BAR;
        PG8_WAIT_V(4); PG8_BAR;
        PG8_STAGE(PG8_SB(1, 0), cB + kstep, voffB); PG8_STAGE(PG8_SA(1, 0), cA + kstep, voffA); PG8_STAGE(PG8_SB(1, 1), cB + hstep + kstep, voffB);
        PG8_WAIT_V(6); PG8_BAR;
    }
    for (;;) {
        const bool has_next = S.next(ui + 1, nxt);
        const char* nA = has_next ? (const char*)g.A + (size_t)nxt.pm * tstep : cA; const char* nB = has_next ? (const char*)g.Bt + (size_t)nxt.pn * tstep : cB;
        for (int t = 0; t < nt; t += 2) {
            const bool last = (t == nt - 2);
            const char* a1 = cA + (size_t)(t + 1) * kstep;
            const char* a2 = last ? nA : cA + (size_t)(t + 2) * kstep; const char* b2 = last ? nB : cB + (size_t)(t + 2) * kstep;
            const char* a3 = a2 + kstep; const char* b3 = b2 + kstep;
            if (last && has_next) S.a_ready(nxt);
            if constexpr (SP2) {
            PG8_LDB(B0, 0, 0); PG8_LDB(B1, 0, 1); PG8_SCHED; PG8_LDA(At, 0, 0); PG8_STAGE(PG8_SA(1, 1), a1 + hstep, voffA);
            PG8_WAIT_V(8); PG8_WAIT_L(0); PG8_BAR; PG8_MMA(0, 0, At, B0); PG8_MMA(0, 1, At, B1); PG8_BAR; PG8_SCHED;
            PG8_LDA(At, 0, 1); PG8_STAGE(PG8_SB(0, 0), b2, voffB); PG8_STAGE(PG8_SB(0, 1), b2 + hstep, voffB); PG8_STAGE(PG8_SA(0, 0), a2, voffA);
            PG8_WAIT_V(8); PG8_WAIT_L(0); PG8_BAR; PG8_MMA(1, 0, At, B0); PG8_MMA(1, 1, At, B1); PG8_BAR; PG8_SCHED;
            PG8_LDB(B0, 1, 0); PG8_LDB(B1, 1, 1); PG8_SCHED; PG8_LDA(At, 1, 0); PG8_STAGE(PG8_SA(0, 1), a2 + hstep, voffA);
            PG8_WAIT_V(8); PG8_WAIT_L(0); PG8_BAR; PG8_MMA(0, 0, At, B0); PG8_MMA(0, 1, At, B1); PG8_BAR; PG8_SCHED;
            PG8_LDA(At, 1, 1); PG8_STAGE(PG8_SB(1, 0), b3, voffB); PG8_STAGE(PG8_SB(1, 1), b3 + hstep, voffB); PG8_STAGE(PG8_SA(1, 0), a3, voffA);
            PG8_WAIT_V(8); PG8_WAIT_L(0); PG8_BAR; PG8_MMA(1, 0, At, B0); PG8_MMA(1, 1, At, B1); PG8_BAR; PG8_SCHED;
            } else {
            PG8_LDB(B0, 0, 0); PG8_SCHED; PG8_LDA(At, 0, 0); PG8_STAGE(PG8_SA(1, 1), a1 + hstep, voffA);
            PG8_WAIT_L(8); PG8_BAR; PG8_WAIT_L(0); PG8_MMA(0, 0, At, B0); PG8_BAR; PG8_SCHED;
            PG8_LDB(B1, 0, 1); PG8_STAGE(PG8_SB(0, 0), b2, voffB);
            PG8_BAR; PG8_WAIT_L(0); PG8_MMA(0, 1, At, B1); PG8_BAR;
            PG8_LDA(At, 0, 1); PG8_STAGE(PG8_SA(0, 0), a2, voffA);
            PG8_BAR; PG8_WAIT_L(0); PG8_MMA(1, 0, At, B0); PG8_BAR; PG8_SCHED;
            PG8_STAGE(PG8_SB(0, 1), b2 + hstep, voffB);
            PG8_WAIT_V(6); PG8_BAR; PG8_MMA(1, 1, At, B1); PG8_BAR;
            PG8_LDB(B0, 1, 0); PG8_SCHED; PG8_LDA(At, 1, 0); PG8_STAGE(PG8_SA(0, 1), a2 + hstep, voffA);
            PG8_WAIT_L(8); PG8_BAR; PG8_WAIT_L(0); PG8_MMA(0, 0, At, B0); PG8_BAR; PG8_SCHED;
            PG8_LDB(B1, 1, 1); PG8_STAGE(PG8_SB(1, 0), b3, voffB);
            PG8_BAR; PG8_WAIT_L(0); PG8_MMA(0, 1, At, B1); PG8_BAR;
            PG8_LDA(At, 1, 1); PG8_STAGE(PG8_SA(1, 0), a3, voffA);
            PG8_BAR; PG8_WAIT_L(0); PG8_MMA(1, 0, At, B0); PG8_BAR; PG8_SCHED;
            PG8_STAGE(PG8_SB(1, 1), b3 + hstep, voffB);
            PG8_WAIT_V(6); PG8_BAR; PG8_MMA(1, 1, At, B1); PG8_BAR;
            }
        }
        if constexpr (ALIGN_EPI) { if (wr == 0) PG8_BAR; }
        if constexpr (!Epi::AFTER_DRAIN) { E(acc, cur, wr, wc, fr, fq); S.done(cur); }
        if (!has_next) break;
#pragma unroll
        for (int a = 0; a < 2; ++a)
#pragma unroll
            for (int b = 0; b < 2; ++b)
#pragma unroll
                for (int m = 0; m < 4; ++m)
#pragma unroll
                    for (int n = 0; n < 2; ++n) acc[a][b][m][n] = (f32x4){0.f, 0.f, 0.f, 0.f};
        cur = nxt; cA = nA; cB = nB; ++ui;
        if constexpr (ALIGN_EPI) { if (wr == 1) PG8_BAR; }
    }
    PG8_WAIT_V(0);
    if constexpr (!ALIGN_EPI) { if (wr == 0) PG8_BAR; }
    PG8_BAR;
    if constexpr (Epi::AFTER_DRAIN) { E.fused(acc, cur, wr, wc, fr, fq, lds, wid, lane); S.done(cur); }
#undef PG8_SA
#undef PG8_SB
#undef PG8_STAGE
#undef PG8_LDA
#undef PG8_LDB
#undef PG8_MMA
#undef PG8_WAIT_V
#undef PG8_WAIT_L
#undef PG8_BAR
#undef PG8_SCHED
}
}

constexpr int G1_NM = MTOK / 256, G1_NN = NPAD / 256, G1_MAIN = G1_NM * G1_NN, G1_UNITS = G1_MAIN + 4;
struct Sched1 {
    pg8::StaticOrder so;
    __device__ void init(int G, int c) { so.init(MTOK, NPAD, G, c); }
    __device__ bool next(int i, pg8::Unit& u) const {
        const long L = (long)i * so.G + so.c;
        if (L >= G1_UNITS) return false;
        if (L >= G1_MAIN) { const int e = (int)L - G1_MAIN; u.pm = G1_NM + (e >> 1); u.pn = G1_NN + (e & 1); return true; }
        return so.next(i, u);
    }
    __device__ __forceinline__ void a_ready(const pg8::Unit&) const {}
    __device__ __forceinline__ void done(const pg8::Unit&) const {}
};

struct Epi1 {
    static constexpr bool PERM = true, AFTER_DRAIN = false;
    const float* rinv; const float* rope; bf16_t *Qb, *Kb, *Vb, *QMb, *Gb, *MKB, *MVB; float* ZB; float* out;
    __device__ __forceinline__ void operator()(const f32x4 (&acc)[2][2][4][2], const pg8::Unit& u, int wr, int wc, int fr, int fq) const {
        const bool memu = u.pm >= G1_NM;
#pragma unroll
        for (int ai = 0; ai < 2; ++ai)
#pragma unroll
            for (int m = 0; m < 4; ++m) {
                const int row = u.pm * 256 + ai * 128 + wr * 64 + m * 16 + fr;
                const float rs = rinv[row];
#pragma unroll
                for (int bj = 0; bj < 2; ++bj) {
                    const int c0 = u.pn * 256 + bj * 128 + wc * 32 + 8 * fq;
                    float v[8];
#pragma unroll
                    for (int e = 0; e < 4; ++e) { v[e] = acc[ai][bj][m][0][e] * rs; v[4 + e] = acc[ai][bj][m][1][e] * rs; }
                    if (memu) {
                        const int mrow = row - MTOK, mc = c0 - NPAD;
                        float* of = out + (mc < 256 ? O_MK_P : O_MV_P) + (size_t)mrow * 256 + (mc & 255);
                        *(f32x4*)of = (f32x4){v[0], v[1], v[2], v[3]}; *(f32x4*)(of + 4) = (f32x4){v[4], v[5], v[6], v[7]};
                        bf16_t* ob = (mc < 256 ? MKB : MVB) + (size_t)mrow * 256 + (mc & 255);
                        *(u32x4*)ob = (u32x4){cvtpk(v[0], v[1]), cvtpk(v[2], v[3]), cvtpk(v[4], v[5]), cvtpk(v[6], v[7])};
                        continue;
                    }
                    const int cb = c0 >> 7;
                    const bool samp = row >= MP;
                    const int srow = row - MP;
                    if (cb < 6) {
                        if ((wc & 1) == 0) {
                            float pr[8];
#pragma unroll
                            for (int e = 0; e < 8; ++e) pr[e] = __shfl_xor(v[e], 16);
                            if (fq < 2) {
                                const int pos = samp ? (SEQ + (srow & 7)) : (row & (SEQ - 1));
                                const f32x4 c0v = *(const f32x4*)(rope + (size_t)pos * 16), c1v = *(const f32x4*)(rope + (size_t)pos * 16 + 4);
                                const f32x4 s0v = *(const f32x4*)(rope + (size_t)pos * 16 + 8), s1v = *(const f32x4*)(rope + (size_t)pos * 16 + 12);
                                const float cs[8] = {c0v[0], c0v[1], c0v[2], c0v[3], c1v[0], c1v[1], c1v[2], c1v[3]};
                                const float sn[8] = {s0v[0], s0v[1], s0v[2], s0v[3], s1v[0], s1v[1], s1v[2], s1v[3]};
                                const float sg = (fq == 0) ? -1.f : 1.f;
#pragma unroll
                                for (int e = 0; e < 8; ++e) v[e] = v[e] * cs[e] + sg * pr[e] * sn[e];
                            }
                        }
                        if (cb < 3) {
#pragma unroll
                            for (int e = 0; e < 8; ++e) v[e] *= 0.125f;
                            *(u32x4*)(Qb + (size_t)row * ATT_W + c0) = (u32x4){cvtpk(v[0], v[1]), cvtpk(v[2], v[3]), cvtpk(v[4], v[5]), cvtpk(v[6], v[7])};
                        } else {
                            const int cc = c0 - C_K;
                            *(u32x4*)(Kb + (size_t)row * ATT_W + cc) = (u32x4){cvtpk(v[0], v[1]), cvtpk(v[2], v[3]), cvtpk(v[4], v[5]), cvtpk(v[6], v[7])};
                            float* of = nullptr;
                            if (samp) of = out + O_WK_S + (size_t)srow * ATT_W + cc;
                            else { const int t = row & (SEQ - 1); if (t >= SEQ - WINP) of = out + O_WK_P + ((size_t)(row >> 13) * WINP + (t - (SEQ - WINP))) * ATT_W + cc; }
                            if (of) { *(f32x4*)of = (f32x4){v[0], v[1], v[2], v[3]}; *(f32x4*)(of + 4) = (f32x4){v[4], v[5], v[6], v[7]}; }
                        }
                    } else if (cb < 9) {
                        const int cc = c0 - C_V;
                        *(u32x4*)(Vb + (size_t)row * ATT_W + cc) = (u32x4){cvtpk(v[0], v[1]), cvtpk(v[2], v[3]), cvtpk(v[4], v[5]), cvtpk(v[6], v[7])};
                        float* of = nullptr;
                        if (samp) of = out + O_WV_S + (size_t)srow * ATT_W + cc;
                        else { const int t = row & (SEQ - 1); if (t >= SEQ - WINP) of = out + O_WV_P + ((size_t)(row >> 13) * WINP + (t - (SEQ - WINP))) * ATT_W + cc; }
                        if (of) { *(f32x4*)of = (f32x4){v[0], v[1], v[2], v[3]}; *(f32x4*)(of + 4) = (f32x4){v[4], v[5], v[6], v[7]}; }
                    } else if (cb < 19) {
                        const int cc = c0 - C_Z;
                        float* zf = ZB + (size_t)row * SHIFT_W + cc;
                        *(f32x4*)zf = (f32x4){v[0], v[1], v[2], v[3]}; *(f32x4*)(zf + 4) = (f32x4){v[4], v[5], v[6], v[7]};
                        float* of = nullptr;
                        if (samp) { if ((srow & 7) == 7) of = out + O_SH_S + (size_t)(srow >> 3) * SHIFT_W + cc; }
                        else if ((row & (SEQ - 1)) == SEQ - 1) of = out + O_SH_P + (size_t)(row >> 13) * SHIFT_W + cc;
                        if (of) { *(f32x4*)of = (f32x4){v[0], v[1], v[2], v[3]}; *(f32x4*)(of + 4) = (f32x4){v[4], v[5], v[6], v[7]}; }
                    } else if (cb < 21) {
                        const int cc = c0 - C_QM;
#pragma unroll
                        for (int e = 0; e < 8; ++e) v[e] *= 0.125f;
                        *(u32x4*)(QMb + (size_t)row * MEM_W + cc) = (u32x4){cvtpk(v[0], v[1]), cvtpk(v[2], v[3]), cvtpk(v[4], v[5]), cvtpk(v[6], v[7])};
                    } else if (cb < 29) {
                        const int cc = c0 - C_G;
#pragma unroll
                        for (int e = 0; e < 8; ++e) v[e] = v[e] / (1.f + __expf(-v[e]));
                        *(u32x4*)(Gb + (size_t)row * DM + cc) = (u32x4){cvtpk(v[0], v[1]), cvtpk(v[2], v[3]), cvtpk(v[4], v[5]), cvtpk(v[6], v[7])};
                    }
                }
            }
    }
};

struct Epi2 {
    static constexpr bool PERM = false, AFTER_DRAIN = false;
    const float* xp; const float* xs; float* Y; float* SS;
    __device__ __forceinline__ void operator()(const f32x4 (&acc)[2][2][4][2], const pg8::Unit& u, int wr, int wc, int fr, int fq) const {
#pragma unroll
        for (int ai = 0; ai < 2; ++ai)
#pragma unroll
            for (int m = 0; m < 4; ++m) {
                const int row = u.pm * 256 + ai * 128 + wr * 64 + m * 16 + fr;
                const float* xr = (row < MP) ? xp + (size_t)row * DM : xs + (size_t)(row - MP) * DM;
                float ss = 0.f;
#pragma unroll
                for (int bj = 0; bj < 2; ++bj)
#pragma unroll
                    for (int n = 0; n < 2; ++n) {
                        const int c = u.pn * 256 + bj * 128 + wc * 32 + n * 16 + 4 * fq;
                        const f32x4 xv = *(const f32x4*)(xr + c);
                        const f32x4 o = xv + acc[ai][bj][m][n];
                        ss += (o[0] * o[0] + o[1] * o[1]) + (o[2] * o[2] + o[3] * o[3]);
                        *(f32x4*)(Y + (size_t)row * DM + c) = o;
                    }
                ss += __shfl_xor(ss, 16); ss += __shfl_xor(ss, 32);
                if (fq == 0) atomicAdd(SS + row, ss);
            }
    }
};

constexpr int KS = 144, VS = 144;
constexpr float L2E = 1.4426950408889634f;
__device__ __forceinline__ int crow(int r, int hi) { return (r & 3) + 8 * (r >> 2) + 4 * hi; }
typedef short v4i16_t __attribute__((ext_vector_type(4)));
__device__ __forceinline__ s16x4 vtr(LAS const unsigned char* p) { return __builtin_bit_cast(s16x4, __builtin_amdgcn_ds_read_tr16_b64_v4i16((LAS v4i16_t*)p)); }

template <int NTG, int NG, bool BAND>
__device__ __forceinline__ void strip_attn(const bf16x8 (&qf)[4], LAS const unsigned char* Kl, LAS const unsigned char* Vl, int krow0, int lane, int kmin,
                                           f32x16 (&o)[2], float& m_out, float& l_out) {
    const int q = lane & 31, hi = lane >> 5;
    float m_run = -INFINITY, l_run = 0.f;
#pragma unroll
    for (int r = 0; r < 16; ++r) { o[0][r] = 0.f; o[1][r] = 0.f; }
#pragma unroll
    for (int g = 0; g < NG; ++g) {
        f32x16 S[NTG];
#pragma unroll
        for (int t = 0; t < NTG; ++t) {
#pragma unroll
            for (int r = 0; r < 16; ++r) S[t][r] = 0.f;
            LAS const unsigned char* kp = Kl + (size_t)(krow0 + (g * NTG + t) * 32 + q) * KS + hi * 16;
#pragma unroll
            for (int d0 = 0; d0 < 4; ++d0) {
                const bf16x8 kf = *(LAS const bf16x8*)(kp + d0 * 32);
                S[t] = __builtin_amdgcn_mfma_f32_32x32x16_bf16(kf, qf[d0], S[t], 0, 0, 0);
            }
        }
        float mx = -INFINITY;
#pragma unroll
        for (int t = 0; t < NTG; ++t)
#pragma unroll
            for (int r = 0; r < 16; ++r) {
                if (BAND) { const int ko = 32 * (g * NTG + t) + crow(r, hi); if (ko < q || ko > q + 128 || ko < kmin) S[t][r] = -INFINITY; }
                mx = fmaxf(mx, S[t][r]);
            }
        mx = fmaxf(mx, __shfl_xor(mx, 32));
        const float m_new = fmaxf(m_run, mx);
        const float alpha = __builtin_amdgcn_exp2f((m_run - m_new) * L2E);
        float ls = 0.f;
#pragma unroll
        for (int t = 0; t < NTG; ++t)
#pragma unroll
            for (int r = 0; r < 16; ++r) { const float p = __builtin_amdgcn_exp2f((S[t][r] - m_new) * L2E); S[t][r] = p; ls += p; }
        ls += __shfl_xor(ls, 32);
        l_run = l_run * alpha + ls; m_run = m_new;
        if (g > 0) {
#pragma unroll
            for (int r = 0; r < 16; ++r) { const float a = __shfl(alpha, crow(r, hi)); o[0][r] *= a; o[1][r] *= a; }
        }
#pragma unroll
        for (int t = 0; t < NTG; ++t)
#pragma unroll
            for (int s = 0; s < 2; ++s) {
                u32x4 pw; pw[0] = cvtpk(S[t][8 * s + 0], S[t][8 * s + 1]); pw[1] = cvtpk(S[t][8 * s + 2], S[t][8 * s + 3]);
                pw[2] = cvtpk(S[t][8 * s + 4], S[t][8 * s + 5]); pw[3] = cvtpk(S[t][8 * s + 6], S[t][8 * s + 7]);
                const bf16x8 pa = __builtin_bit_cast(bf16x8, pw);
                const int vrow = krow0 + (g * NTG + t) * 32 + 16 * s + 4 * hi + ((lane & 15) >> 2);
                LAS const unsigned char* vp = Vl + (size_t)vrow * VS + (16 * ((lane >> 4) & 1) + 4 * (lane & 3)) * 2;
#pragma unroll
                for (int dt = 0; dt < 2; ++dt) {
                    const s16x4 lo = vtr(vp + dt * 64), hh = vtr(vp + dt * 64 + 8 * VS);
                    const bf16x8 vb = (bf16x8){lo[0], lo[1], lo[2], lo[3], hh[0], hh[1], hh[2], hh[3]};
                    o[dt] = __builtin_amdgcn_mfma_f32_32x32x16_bf16(pa, vb, o[dt], 0, 0, 0);
                }
            }
    }
    m_out = m_run; l_out = l_run;
}

struct Ptrs {
    const float* in[25]; float* out; unsigned char* ws;
    float *RINV, *SS, *ROPE, *ZB, *LSE;
    bf16_t *WT, *WOT, *XB, *Qb, *Kb, *Vb, *QMb, *Gb, *MKB, *MVB, *OAP, *OG;
};

constexpr int N_DIL_UNITS = NB * 6 * 3 * 32;
__device__ __forceinline__ void dil_unit(const Ptrs& P, LAS unsigned char* lds, int unit, int tid) {
    const int lane = tid & 63, wave = tid >> 6;
    const int u32 = unit & 31, x = unit >> 5, di = x % 3, bh = x / 3, b = bh / 6, h = bh % 6;
    const int dil = (di == 0) ? 1 : (di == 1 ? 4 : 16), nb2 = 32 / dil, res = u32 / nb2, j = u32 % nb2;
    LAS unsigned char* Kl = lds; LAS unsigned char* Vl = lds + 384 * KS;
    const int l0 = 256 * j - 128;
#pragma unroll
    for (int i = 0; i < 6; ++i) {
        const int e = tid + NTHR * i, row = e >> 3, c = e & 7, l = l0 + row;
        u32x4 kv = (u32x4){0u, 0u, 0u, 0u}, vv = kv;
        if (l >= 0) { const size_t off = ((size_t)b * SEQ + (size_t)l * dil + res) * ATT_W + h * 64 + c * 8; kv = *(const u32x4*)(P.Kb + off); vv = *(const u32x4*)(P.Vb + off); }
        *(LAS u32x4*)(Kl + row * KS + c * 16) = kv; *(LAS u32x4*)(Vl + row * VS + c * 16) = vv;
    }
    __syncthreads();
    const int q = lane & 31, hi = lane >> 5, lq0 = 256 * j + 32 * wave;
    const size_t tokq = (size_t)b * SEQ + (size_t)(lq0 + q) * dil + res;
    bf16x8 qf[4];
#pragma unroll
    for (int d0 = 0; d0 < 4; ++d0) qf[d0] = *(const bf16x8*)(P.Qb + tokq * ATT_W + h * 64 + d0 * 16 + hi * 8);
    f32x16 o[2]; float mm, ll;
    strip_attn<5, 1, true>(qf, Kl, Vl, 32 * wave, lane, (lq0 < 128) ? 128 - lq0 : 0, o, mm, ll);
    const float linv = 1.f / ll;
#pragma unroll
    for (int r = 0; r < 16; ++r) {
        const int qq = crow(r, hi); const float li = __shfl(linv, qq);
        const size_t tok = (size_t)b * SEQ + (size_t)(lq0 + qq) * dil + res;
        bf16_t* op = P.OAP + ((size_t)di * MP + tok) * ATT_W + h * 64 + q;
        op[0] = f2bf(o[0][r] * li); op[32] = f2bf(o[1][r] * li);
    }
    if (hi == 0) P.LSE[((size_t)di * MP + tokq) * 6 + h] = mm + __logf(ll);
    __syncthreads();
}

constexpr int N_MEMA_UNITS = NB * 4 * 32;
__device__ __forceinline__ void mem_unit(const Ptrs& P, LAS unsigned char* lds, int unit, int tid) {
    const int lane = tid & 63, wave = tid >> 6;
    const int jq = unit & 31, bh = unit >> 5, b = bh >> 2, hm = bh & 3;
    LAS unsigned char* Kl = lds; LAS unsigned char* Vl = lds + 256 * KS;
#pragma unroll
    for (int i = 0; i < 4; ++i) {
        const int e = tid + NTHR * i, row = e >> 3, c = e & 7;
        const size_t off = ((size_t)b * NMEM + row) * MEM_W + hm * 64 + c * 8;
        *(LAS u32x4*)(Kl + row * KS + c * 16) = *(const u32x4*)(P.MKB + off); *(LAS u32x4*)(Vl + row * VS + c * 16) = *(const u32x4*)(P.MVB + off);
    }
    __syncthreads();
    const int q = lane & 31, hi = lane >> 5;
    const size_t tok0 = (size_t)b * SEQ + 256 * jq + 32 * wave;
    bf16x8 qf[4];
#pragma unroll
    for (int d0 = 0; d0 < 4; ++d0) qf[d0] = *(const bf16x8*)(P.QMb + (tok0 + q) * MEM_W + hm * 64 + d0 * 16 + hi * 8);
    f32x16 o[2]; float mm, ll;
    strip_attn<4, 2, false>(qf, Kl, Vl, 0, lane, 0, o, mm, ll);
    const float linv = 1.f / ll;
#pragma unroll
    for (int r = 0; r < 16; ++r) {
        const int qq = crow(r, hi); const float li = __shfl(linv, qq);
        const size_t oo = (tok0 + qq) * DM + 768 + hm * 64 + q;
        P.OG[oo] = f2bf(o[0][r] * li * bf2f(P.Gb[oo])); P.OG[oo + 32] = f2bf(o[1][r] * li * bf2f(P.Gb[oo + 32]));
    }
    __syncthreads();
}

constexpr int N_SDIL_ITEMS = DB * DT;
__device__ __forceinline__ void sdil_item(const Ptrs& P, LAS unsigned char* lds, int item, int tid) {
    const int db = item >> 3, i = item & 7, lane = tid & 63, wave = tid >> 6;
    LAS float* sc = (LAS float*)lds;
    LAS float* st = sc + 3 * 132 * 6;
    LAS float* red = st + 32;
    const int g = tid / 96, u = tid % 96, hh = u >> 4;
    const size_t srow = (size_t)MP + db * 8 + i;
    const float* ck = P.in[2] + (size_t)db * WINP * ATT_W; const float* cv = P.in[3] + (size_t)db * WINP * ATT_W;
    const float* nk = P.out + O_WK_S + (size_t)db * 8 * ATT_W; const float* nv = P.out + O_WV_S + (size_t)db * 8 * ATT_W;
    f32x4 q4 = (f32x4){0.f, 0.f, 0.f, 0.f};
    if (g < 5) { const u32x2 w = *(const u32x2*)(P.Qb + srow * ATT_W + u * 4); q4 = (f32x4){bflo(w[0]), bfhi(w[0]), bflo(w[1]), bfhi(w[1])}; }
    for (int di = 0; di < 3; ++di) {
        const int dil = (di == 0) ? 1 : (di == 1 ? 4 : 16);
        for (int jj = g; jj < 129 + 4; jj += 5) {
            float d = 0.f;
            if (g < 5 && jj < 129) { const int idx = WINP + i - dil * jj; const float* kr = (idx >= WINP) ? nk + (size_t)(idx - WINP) * ATT_W : ck + (size_t)idx * ATT_W;
                const f32x4 k4 = *(const f32x4*)(kr + u * 4); d = (k4[0] * q4[0] + k4[1] * q4[1]) + (k4[2] * q4[2] + k4[3] * q4[3]); }
            d += __shfl_xor(d, 1); d += __shfl_xor(d, 2); d += __shfl_xor(d, 4); d += __shfl_xor(d, 8);
            if (g < 5 && jj < 129 && (u & 15) == 0) sc[(di * 132 + jj) * 6 + hh] = d;
        }
    }
    __syncthreads();
    LAS float* stm = st + 32 + 5 * 384;
    for (int pr = wave; pr < 18; pr += 8) {
        const int di = pr / 6, h2 = pr % 6;
        float v0 = sc[(di * 132 + lane) * 6 + h2], v1 = sc[(di * 132 + 64 + lane) * 6 + h2], v2 = (lane == 0) ? sc[(di * 132 + 128) * 6 + h2] : -INFINITY;
        const float mx = wave_max(fmaxf(fmaxf(v0, v1), v2));
        v0 = __expf(v0 - mx); v1 = __expf(v1 - mx); v2 = (lane == 0) ? __expf(v2 - mx) : 0.f;
        const float sm = wave_sum(v0 + v1 + v2);
        sc[(di * 132 + lane) * 6 + h2] = v0; sc[(di * 132 + 64 + lane) * 6 + h2] = v1; if (lane == 0) { sc[(di * 132 + 128) * 6 + h2] = v2; stm[pr] = mx; stm[18 + pr] = sm; }
    }
    __syncthreads();
    if (tid < 6) {
        const float l0 = stm[tid] + __logf(stm[18 + tid]), l1 = stm[6 + tid] + __logf(stm[24 + tid]), l2 = stm[12 + tid] + __logf(stm[30 + tid]);
        const float mx = fmaxf(l0, fmaxf(l1, l2)); const float e0 = __expf(l0 - mx), e1 = __expf(l1 - mx), e2 = __expf(l2 - mx); const float inv = 1.f / (e0 + e1 + e2);
        st[tid] = e0 * inv / stm[18 + tid]; st[6 + tid] = e1 * inv / stm[24 + tid]; st[12 + tid] = e2 * inv / stm[30 + tid];
    }
    __syncthreads();
    if (g < 5) {
        f32x4 a = (f32x4){0.f, 0.f, 0.f, 0.f};
        for (int di = 0; di < 3; ++di) {
            const int dil = (di == 0) ? 1 : (di == 1 ? 4 : 16); const float cf = st[di * 6 + hh];
            for (int jj = g; jj < 129; jj += 5) { const int idx = WINP + i - dil * jj; const float* vr = (idx >= WINP) ? nv + (size_t)(idx - WINP) * ATT_W : cv + (size_t)idx * ATT_W;
                const f32x4 v4 = *(const f32x4*)(vr + u * 4); const float pw = sc[(di * 132 + jj) * 6 + hh] * cf; a += v4 * pw; }
        }
        *(LAS f32x4*)(red + g * 384 + u * 4) = a;
    }
    __syncthreads();
    if (tid < 96) {
        f32x4 a = *(LAS f32x4*)(red + tid * 4);
#pragma unroll
        for (int k = 1; k < 5; ++k) a += *(LAS f32x4*)(red + k * 384 + tid * 4);
        const u32x2 gw = *(const u32x2*)(P.Gb + srow * DM + tid * 4);
        u32x2 w; w[0] = cvtpk(a[0] * bflo(gw[0]), a[1] * bfhi(gw[0])); w[1] = cvtpk(a[2] * bflo(gw[1]), a[3] * bfhi(gw[1]));
        *(u32x2*)(P.OG + srow * DM + tid * 4) = w;
    }
    __syncthreads();
}

constexpr int N_SMEM_ITEMS = DB * 4;
__device__ __forceinline__ void smem_item(const Ptrs& P, LAS unsigned char* lds, int item, int tid) {
    const int db = item >> 2, hm = item & 3, lane = tid & 63, wave = tid >> 6;
    LAS float* qs = (LAS float*)lds;
    LAS float* sc = qs + 512;
    LAS float* li = sc + 2048;
    { const int qi = tid >> 6, d = tid & 63; qs[tid] = bf2f(P.QMb[((size_t)MP + db * 8 + qi) * MEM_W + hm * 64 + d]); }
    __syncthreads();
    {
        const int m = tid & 255, qh = tid >> 8;
        const float* kr = P.in[6] + (((size_t)db * NMEM + m) * 4 + hm) * 64;
        float d0 = 0.f, d1 = 0.f, d2 = 0.f, d3 = 0.f;
#pragma unroll 4
        for (int c = 0; c < 16; ++c) {
            const f32x4 k4 = *(const f32x4*)(kr + c * 4);
            const f32x4 a0 = *(LAS f32x4*)(qs + (qh * 4 + 0) * 64 + c * 4), a1 = *(LAS f32x4*)(qs + (qh * 4 + 1) * 64 + c * 4), a2 = *(LAS f32x4*)(qs + (qh * 4 + 2) * 64 + c * 4), a3 = *(LAS f32x4*)(qs + (qh * 4 + 3) * 64 + c * 4);
            d0 += (k4[0] * a0[0] + k4[1] * a0[1]) + (k4[2] * a0[2] + k4[3] * a0[3]); d1 += (k4[0] * a1[0] + k4[1] * a1[1]) + (k4[2] * a1[2] + k4[3] * a1[3]);
            d2 += (k4[0] * a2[0] + k4[1] * a2[1]) + (k4[2] * a2[2] + k4[3] * a2[3]); d3 += (k4[0] * a3[0] + k4[1] * a3[1]) + (k4[2] * a3[2] + k4[3] * a3[3]);
        }
        sc[(qh * 4 + 0) * 256 + m] = d0; sc[(qh * 4 + 1) * 256 + m] = d1; sc[(qh * 4 + 2) * 256 + m] = d2; sc[(qh * 4 + 3) * 256 + m] = d3;
    }
    __syncthreads();
    {
        float v[4]; float mx = -INFINITY;
#pragma unroll
        for (int k = 0; k < 4; ++k) { v[k] = sc[wave * 256 + k * 64 + lane]; mx = fmaxf(mx, v[k]); }
        mx = wave_max(mx); float sm = 0.f;
#pragma unroll
        for (int k = 0; k < 4; ++k) { v[k] = __expf(v[k] - mx); sm += v[k]; sc[wave * 256 + k * 64 + lane] = v[k]; }
        sm = wave_sum(sm); if (lane == 0) li[wave] = 1.f / sm;
    }
    __syncthreads();
    {
        const int qi = tid >> 6, d = tid & 63;
        const float* vr = P.in[7] + (((size_t)db * NMEM) * 4 + hm) * 64 + d;
        float a = 0.f;
#pragma unroll 8
        for (int m = 0; m < 256; ++m) a += sc[qi * 256 + m] * vr[(size_t)m * 256];
        const size_t oo = ((size_t)MP + db * 8 + qi) * DM + 768 + hm * 64 + d;
        P.OG[oo] = f2bf(a * li[qi] * bf2f(P.Gb[oo]));
    }
    __syncthreads();
}

constexpr int N_SCAN_P = NB * 6, N_SCAN_S = DB * 6;
constexpr int CH = 32;
__device__ __forceinline__ float softplusf(float x) { return fmaxf(x, 0.f) + log1pf(__expf(-fabsf(x))); }
__device__ __forceinline__ void scan_item(const Ptrs& P, LAS unsigned char* lds, bool sample, int bb, int h, int tid) {
    const int lane = tid & 63, wave = tid >> 6;
    const int T = sample ? DT : SEQ;
    const size_t row0 = sample ? (size_t)MP + bb * DT : (size_t)bb * SEQ;
    LAS float* W2h = (LAS float*)lds;
    LAS float* A2h = W2h + 4096;
    LAS float* Rr = A2h + 4096;
    LAS float* Kk = Rr + CH * 64;
    LAS float* Vv = Kk + CH * 64;
    LAS float* Wd = Vv + CH * 64;
    LAS float* KK = Wd + CH * 64;
    LAS float* Bb = KK + CH * 64;
    LAS float* TW = Bb + CH * 64;
    LAS float* AL = TW + CH * 64;
    LAS float* Yb = AL + CH * 64;
    const float* mu = P.in[11]; const float* w0 = P.in[12]; const float* w2 = P.in[13]; const float* a0 = P.in[14]; const float* a2 = P.in[15];
    const float* k_k = P.in[16]; const float* k_a = P.in[17]; const float* r_k = P.in[18]; const float* lnx_g = P.in[19]; const float* lnx_b = P.in[20];
    for (int e = tid; e < 4096; e += NTHR) { const int jr = e >> 6, c = e & 63; W2h[e] = w2[(size_t)jr * RW + h * 64 + c]; A2h[e] = a2[(size_t)jr * RW + h * 64 + c]; }
    const int v = tid >> 3, kq = tid & 7;
    float s[8];
    if (sample) {
        const float* sp = P.in[4] + (((size_t)bb * 6 + h) * 64 + v) * 64 + kq * 8;
#pragma unroll
        for (int e = 0; e < 8; ++e) s[e] = sp[e];
    } else {
#pragma unroll
        for (int e = 0; e < 8; ++e) s[e] = 0.f;
    }
    const float* shift0 = P.in[5] + (size_t)bb * SHIFT_W;
    __syncthreads();
    for (int c0 = 0; c0 < T; c0 += CH) {
        const int n = (T - c0) < CH ? (T - c0) : CH;
        for (int idx = tid; idx < n * 320; idx += NTHR) {
            const int t = idx / 320, ci = idx % 320, grp = ci >> 6, cc = ci & 63;
            const int col = (grp < 3) ? grp * RW + h * 64 + cc : 3 * RW + (grp - 3) * 64 + cc;
            const size_t row = row0 + c0 + t;
            const float z = P.ZB[row * SHIFT_W + col];
            const float zp = (c0 + t == 0) ? (sample ? shift0[col] : 0.f) : P.ZB[(row - 1) * SHIFT_W + col];
            const float zs = z + (zp - z) * mu[col];
            if (grp == 0) Rr[t * 64 + cc] = zs; else if (grp == 1) Kk[t * 64 + cc] = zs; else if (grp == 2) Vv[t * 64 + cc] = zs;
            else if (grp == 3) TW[t * 64 + cc] = tanhf(zs); else AL[t * 64 + cc] = zs;
        }
        __syncthreads();
        for (int idx = tid; idx < n * 64; idx += NTHR) {
            const int t = idx >> 6, c = idx & 63, ch = h * 64 + c;
            float wv = w0[ch], av = a0[ch];
#pragma unroll 8
            for (int jr = 0; jr < 64; ++jr) { wv += TW[t * 64 + jr] * W2h[jr * 64 + c]; av += AL[t * 64 + jr] * A2h[jr * 64 + c]; }
            const float w = -softplusf(-wv) - 0.5f;
            const float decay = __expf(-__expf(w));
            const float a = 1.f / (1.f + __expf(-av));
            const float kraw = Kk[t * 64 + c];
            Wd[t * 64 + c] = decay;
            KK[t * 64 + c] = kraw * k_k[ch];
            Kk[t * 64 + c] = kraw * (1.f + (a - 1.f) * k_a[ch]);
            Bb[t * 64 + c] = a;
        }
        __syncthreads();
        for (int t = wave; t < n; t += 8) {
            const float x = KK[t * 64 + lane];
            const float nrm = fmaxf(sqrtf(wave_sum(x * x)), 1e-12f);
            const float kkn = x / nrm;
            KK[t * 64 + lane] = kkn; Bb[t * 64 + lane] = kkn * Bb[t * 64 + lane];
        }
        __syncthreads();
        for (int t = 0; t < n; ++t) {
            const f32x4 kk0 = *(LAS f32x4*)(KK + t * 64 + kq * 8), kk1 = *(LAS f32x4*)(KK + t * 64 + kq * 8 + 4);
            const f32x4 w0v = *(LAS f32x4*)(Wd + t * 64 + kq * 8), w1v = *(LAS f32x4*)(Wd + t * 64 + kq * 8 + 4);
            const f32x4 b0 = *(LAS f32x4*)(Bb + t * 64 + kq * 8), b1 = *(LAS f32x4*)(Bb + t * 64 + kq * 8 + 4);
            const f32x4 k0 = *(LAS f32x4*)(Kk + t * 64 + kq * 8), k1 = *(LAS f32x4*)(Kk + t * 64 + kq * 8 + 4);
            const f32x4 r0 = *(LAS f32x4*)(Rr + t * 64 + kq * 8), r1 = *(LAS f32x4*)(Rr + t * 64 + kq * 8 + 4);
            const float vv = Vv[t * 64 + v];
            float sa = 0.f;
#pragma unroll
            for (int e = 0; e < 4; ++e) { sa += s[e] * kk0[e]; sa += s[4 + e] * kk1[e]; }
            sa += __shfl_xor(sa, 1); sa += __shfl_xor(sa, 2); sa += __shfl_xor(sa, 4);
            sa = -sa;
            float y = 0.f;
#pragma unroll
            for (int e = 0; e < 4; ++e) {
                s[e] = s[e] * w0v[e] + sa * b0[e] + vv * k0[e];
                s[4 + e] = s[4 + e] * w1v[e] + sa * b1[e] + vv * k1[e];
                y += s[e] * r0[e]; y += s[4 + e] * r1[e];
            }
            y += __shfl_xor(y, 1); y += __shfl_xor(y, 2); y += __shfl_xor(y, 4);
            if (kq == 0) Yb[t * 64 + v] = y;
        }
        __syncthreads();
        for (int t = wave; t < n; t += 8) {
            const int ch = h * 64 + lane;
            const float y = Yb[t * 64 + lane];
            const float mean = wave_sum(y) * (1.f / 64.f);
            const float d = y - mean;
            const float var = wave_sum(d * d) * (1.f / 64.f);
            const float yn = d * rsqrtf(var + 64e-5f) * lnx_g[ch] + lnx_b[ch];
            const float bonus = wave_sum(Rr[t * 64 + lane] * Kk[t * 64 + lane] * r_k[ch]) * Vv[t * 64 + lane];
            const size_t oo = (row0 + c0 + t) * DM + 384 + ch;
            P.OG[oo] = f2bf((yn + bonus) * bf2f(P.Gb[oo]));
        }
        __syncthreads();
    }
    float* so = P.out + (sample ? O_ST_S : O_ST_P) + (((size_t)bb * 6 + h) * 64 + v) * 64 + kq * 8;
#pragma unroll
    for (int e = 0; e < 8; ++e) so[e] = s[e];
    __syncthreads();
}

__device__ __forceinline__ void p0_transpose_item(const float* W, const float* gain, int K, int N, bf16_t* WT, int row_off, LAS float* scr, int item, int lane) {
    const int nblk = N / 32, kb = item / nblk, nb = item % nblk, k0 = 64 * kb, n0 = 32 * nb;
#pragma unroll 8
    for (int i = 0; i < 32; ++i) { const int kk = 2 * i + (lane >> 5); const float gk = gain ? gain[k0 + kk] : 1.f; scr[kk * 33 + (lane & 31)] = W[(size_t)(k0 + kk) * N + n0 + (lane & 31)] * gk; }
    LDS_WAIT(); asm volatile("" ::: "memory");
    const int c = lane & 7;
#pragma unroll
    for (int j = 0; j < 4; ++j) { const int n = (lane >> 3) + 8 * j; const LAS float* s = scr + (8 * c) * 33 + n;
        u32x4 o; o[0] = cvtpk(s[0 * 33], s[1 * 33]); o[1] = cvtpk(s[2 * 33], s[3 * 33]); o[2] = cvtpk(s[4 * 33], s[5 * 33]); o[3] = cvtpk(s[6 * 33], s[7 * 33]);
        *(u32x4*)(WT + (size_t)(row_off + n0 + n) * K + k0 + 8 * c) = o; }
    LDS_WAIT(); asm volatile("" ::: "memory");
}
__device__ __forceinline__ void sincos_acc(float angf, float& c, float& s) {
    const double a = (double)angf;
    const double kq = __builtin_rint(a * 0.63661977236758134308);
    const double r = (a - kq * 1.57079632679489655800) - kq * 6.12323399573676603587e-17;
    const double r2 = r * r;
    double sp = -1.0 / 1307674368000.0; sp = sp * r2 + 1.0 / 6227020800.0; sp = sp * r2 - 1.0 / 39916800.0; sp = sp * r2 + 1.0 / 362880.0; sp = sp * r2 - 1.0 / 5040.0; sp = sp * r2 + 1.0 / 120.0; sp = sp * r2 - 1.0 / 6.0; sp = sp * r2 + 1.0; sp *= r;
    double cp = 1.0 / 87178291200.0; cp = cp * r2 - 1.0 / 479001600.0; cp = cp * r2 + 1.0 / 3628800.0; cp = cp * r2 - 1.0 / 40320.0; cp = cp * r2 + 1.0 / 720.0; cp = cp * r2 - 1.0 / 24.0; cp = cp * r2 + 0.5; cp = 1.0 - cp * r2;
    const int qd = ((int)kq) & 3;
    const double sv = (qd == 0) ? sp : (qd == 1) ? cp : (qd == 2) ? -sp : -cp;
    const double cv = (qd == 0) ? cp : (qd == 1) ? -sp : (qd == 2) ? -cp : sp;
    c = (float)cv; s = (float)sv;
}
__device__ __forceinline__ void p0_prologue(const Ptrs& P, LAS unsigned char* lds, int bid, int G, int tid) {
    const int lane = tid & 63, wave = tid >> 6;
    LAS float* scr = (LAS float*)(lds + wave * 16384);
    const int gw = bid * 8 + wave, NGW = G * 8;
    constexpr int I_IN = (DM / 64) * (IN_W / 32), I_MEM = (DM / 64) * (512 / 32), I_OUT = (DM / 64) * (DM / 32);
    for (int it = gw; it < I_IN + I_MEM + I_OUT; it += NGW) {
        int r = it;
        if (r < I_IN) { p0_transpose_item(P.in[10], P.in[9], DM, IN_W, P.WT, 0, scr, r, lane); continue; } r -= I_IN;
        if (r < I_MEM) { p0_transpose_item(P.in[22], P.in[21], DM, 512, P.WT, NPAD, scr, r, lane); continue; } r -= I_MEM;
        p0_transpose_item(P.in[23], nullptr, DM, DM, P.WOT, 0, scr, r, lane);
    }
    const int gt = bid * NTHR + tid, NGT = G * NTHR;
    for (int e = gt; e < (NPAD - IN_W) * DM / 8; e += NGT) *(u32x4*)(P.WT + (size_t)IN_W * DM + (size_t)e * 8) = (u32x4){0u, 0u, 0u, 0u};
    for (int m = gw; m < MROWS; m += NGW) {
        const float* xr = (m < MP) ? P.in[0] + (size_t)m * DM : (m < MTOK) ? P.in[1] + (size_t)(m - MP) * DM : P.in[8] + (size_t)(m - MTOK) * DM;
        f32x4 v[4]; float ss = 0.f;
#pragma unroll
        for (int j = 0; j < 4; ++j) { v[j] = *(const f32x4*)(xr + (size_t)(64 * j + lane) * 4); ss += (v[j][0] * v[j][0] + v[j][1] * v[j][1]) + (v[j][2] * v[j][2] + v[j][3] * v[j][3]); }
        ss = wave_sum(ss);
        if (lane == 0) P.RINV[m] = rsqrtf(ss * (1.f / DM) + 1e-6f);
#pragma unroll
        for (int j = 0; j < 4; ++j) { u32x2 w; w[0] = cvtpk(v[j][0], v[j][1]); w[1] = cvtpk(v[j][2], v[j][3]); *(u32x2*)(P.XB + (size_t)m * DM + (size_t)(64 * j + lane) * 4) = w; }
    }
    for (int e = gt; e < NPOS * 8; e += NGT) {
        const int pos = e >> 3, i = e & 7;
        const float invf[8] = {1.0f, 0.19392274f, 0.03760603f, 0.0072926646f, 0.0014142136f, 0.0002742482f, 5.3182957e-05f, 1.0313385e-05f};
        float fi = invf[0];
#pragma unroll
        for (int k = 1; k < 8; ++k) fi = (i == k) ? invf[k] : fi;
        const float ang = (float)pos * fi; float c, s; sincos_acc(ang, c, s);
        P.ROPE[pos * 16 + i] = c; P.ROPE[pos * 16 + 8 + i] = s;
    }
    for (int e = gt; e < MTOK; e += NGT) P.SS[e] = 0.f;
}

__device__ __forceinline__ void p3_combine(const Ptrs& P, int bid, int G, int tid) {
    const int gt = bid * NTHR + tid, NGT = G * NTHR;
    for (int e = gt; e < MP * 48; e += NGT) {
        const int row = e / 48, ch = e % 48, h = ch >> 3;
        const float l0 = P.LSE[((size_t)0 * MP + row) * 6 + h], l1 = P.LSE[((size_t)1 * MP + row) * 6 + h], l2 = P.LSE[((size_t)2 * MP + row) * 6 + h];
        const float mx = fmaxf(l0, fmaxf(l1, l2)); const float e0 = __expf(l0 - mx), e1 = __expf(l1 - mx), e2 = __expf(l2 - mx); const float inv = 1.f / (e0 + e1 + e2);
        const float w0 = e0 * inv, w1 = e1 * inv, w2 = e2 * inv;
        const u32x4 a = *(const u32x4*)(P.OAP + ((size_t)0 * MP + row) * ATT_W + ch * 8), b = *(const u32x4*)(P.OAP + ((size_t)1 * MP + row) * ATT_W + ch * 8), c = *(const u32x4*)(P.OAP + ((size_t)2 * MP + row) * ATT_W + ch * 8);
        const u32x4 gg = *(const u32x4*)(P.Gb + (size_t)row * DM + ch * 8);
        u32x4 o;
#pragma unroll
        for (int k = 0; k < 4; ++k) {
            const float lo = (w0 * bflo(a[k]) + w1 * bflo(b[k]) + w2 * bflo(c[k])) * bflo(gg[k]);
            const float hi = (w0 * bfhi(a[k]) + w1 * bfhi(b[k]) + w2 * bfhi(c[k])) * bfhi(gg[k]);
            o[k] = cvtpk(lo, hi);
        }
        *(u32x4*)(P.OG + (size_t)row * DM + ch * 8) = o;
    }
}

__device__ __forceinline__ void p5_norm(const Ptrs& P, int bid, int G, int tid) {
    const int lane = tid & 63, wave = tid >> 6, gw = bid * 8 + wave, NGW = G * 8;
    const float* gf = P.in[24];
    for (int m = gw; m < MTOK; m += NGW) {
        const float rs = rsqrtf(P.SS[m] * (1.f / DM) + 1e-6f);
        float* yr = P.out + O_Y + (size_t)m * DM;
#pragma unroll
        for (int j = 0; j < 4; ++j) { const size_t c = (size_t)(64 * j + lane) * 4; const f32x4 v = *(const f32x4*)(yr + c); const f32x4 gv = *(const f32x4*)(gf + c); *(f32x4*)(yr + c) = v * rs * gv; }
    }
}

__global__ void __launch_bounds__(NTHR, 2) fwd_kernel(Params prm) {
    extern __shared__ __attribute__((aligned(16))) unsigned char lds_raw[];
    LAS unsigned char* lds = (LAS unsigned char*)lds_raw;
    const int tid = threadIdx.x, bid = blockIdx.x, G = gridDim.x;
    Ptrs P;
#pragma unroll
    for (int i = 0; i < 25; ++i) P.in[i] = prm.in[i];
    P.out = prm.out; P.ws = prm.ws;
    P.RINV = (float*)(prm.ws + WS_RINV); P.SS = (float*)(prm.ws + WS_SS); P.ROPE = (float*)(prm.ws + WS_ROPE); P.ZB = (float*)(prm.ws + WS_ZB); P.LSE = (float*)(prm.ws + WS_LSE);
    P.WT = (bf16_t*)(prm.ws + WS_WT); P.WOT = (bf16_t*)(prm.ws + WS_WOT); P.XB = (bf16_t*)(prm.ws + WS_XB); P.Qb = (bf16_t*)(prm.ws + WS_Q); P.Kb = (bf16_t*)(prm.ws + WS_K); P.Vb = (bf16_t*)(prm.ws + WS_V);
    P.QMb = (bf16_t*)(prm.ws + WS_QM); P.Gb = (bf16_t*)(prm.ws + WS_G); P.MKB = (bf16_t*)(prm.ws + WS_MKB); P.MVB = (bf16_t*)(prm.ws + WS_MVB); P.OAP = (bf16_t*)(prm.ws + WS_OAP); P.OG = (bf16_t*)(prm.ws + WS_OG);
    const int lo = prm.ph_lo, hi = prm.ph_hi;
#define IN_PH(k) (lo <= (k) && (k) < hi)
#define SEAM(k) do { if (IN_PH(k) && IN_PH((k) + 1)) { cg::this_grid().sync(); } } while (0)

    if (IN_PH(0)) { p0_prologue(P, lds, bid, G, tid); }
    SEAM(0);
    if (IN_PH(1)) {
        pg8::Gemm g{P.XB, P.WT, MROWS, NWT, DM}; Sched1 S; S.init(G, bid);
        Epi1 E{P.RINV, P.ROPE, P.Qb, P.Kb, P.Vb, P.QMb, P.Gb, P.MKB, P.MVB, P.ZB, P.out};
        pg8::gemm_phase<Epi1, Sched1, true, true>(lds, g, S, E);
    }
    SEAM(1);
    if (IN_PH(2)) {
        constexpr int N0 = N_SCAN_P, N1 = N0 + N_SCAN_S, N2 = N1 + N_DIL_UNITS, N3 = N2 + N_MEMA_UNITS, N4 = N3 + N_SDIL_ITEMS, N5 = N4 + N_SMEM_ITEMS;
#define ITEM_LOOP(LO, HI, CALL) do { int it = (LO) + ((bid - (LO)) % G + G) % G; for (; it < (HI); it += G) { const int li = it - (LO); CALL; } } while (0)
        ITEM_LOOP(0, N0, scan_item(P, lds, false, li / 6, li % 6, tid));
        ITEM_LOOP(N0, N1, scan_item(P, lds, true, li / 6, li % 6, tid));
        ITEM_LOOP(N1, N2, dil_unit(P, lds, li, tid));
        ITEM_LOOP(N2, N3, mem_unit(P, lds, li, tid));
        ITEM_LOOP(N3, N4, sdil_item(P, lds, li, tid));
        ITEM_LOOP(N4, N5, smem_item(P, lds, li, tid));
#undef ITEM_LOOP
    }
    SEAM(2);
    if (IN_PH(3)) { p3_combine(P, bid, G, tid); }
    SEAM(3);
    if (IN_PH(4)) {
        pg8::Gemm g{P.OG, P.WOT, MTOK, DM, DM}; pg8::StaticOrder S; S.init(MTOK, DM, G, bid);
        Epi2 E{P.in[0], P.in[1], P.out + O_Y, P.SS};
        pg8::gemm_phase<Epi2, pg8::StaticOrder, true, true>(lds, g, S, E);
    }
    SEAM(4);
    if (IN_PH(5)) { p5_norm(P, bid, G, tid); }
}

constexpr int N_PHASES = 6;
#ifndef MK_ONE_LAUNCH
#define MK_ONE_LAUNCH 0
#endif
extern "C" void kernel_launch(void* const* d_in, const int* in_sizes, int n_in, void* d_out, int out_size, void* d_ws, size_t ws_size, hipStream_t stream) {
    static int grid = 0;
    if (grid == 0) {
        if (n_in != 25 || out_size != (int)O_END || ws_size < WS_END) { fprintf(stderr, "kernel_launch: unexpected shapes (n_in %d, out %d, ws %zu < %zu)\n", n_in, out_size, ws_size, (size_t)WS_END); grid = -1; return; }
        int dev = 0, cus = 0, per_cu = 0;
        hipGetDevice(&dev); hipDeviceGetAttribute(&cus, hipDeviceAttributeMultiprocessorCount, dev);
        if (hipFuncSetAttribute((const void*)fwd_kernel, hipFuncAttributeMaxDynamicSharedMemorySize, LDS_BYTES) != hipSuccess) { fprintf(stderr, "kernel_launch: hipFuncSetAttribute failed\n"); grid = -1; return; }
        if (hipOccupancyMaxActiveBlocksPerMultiprocessor(&per_cu, (const void*)fwd_kernel, NTHR, LDS_BYTES) != hipSuccess || per_cu < 1) { fprintf(stderr, "kernel_launch: occupancy query says %d blocks per CU\n", per_cu); (void)hipGetLastError(); per_cu = 1; }
        grid = cus;
    }
    if (grid < 0) return;
    Params p{};
    for (int i = 0; i < 25; ++i) p.in[i] = (const float*)d_in[i];
    p.out = (float*)d_out; p.ws = (unsigned char*)d_ws;
#if MK_ONE_LAUNCH
    p.ph_lo = 0; p.ph_hi = N_PHASES; p.coop = 1;
    void* args[] = {&p};
    hipError_t e = hipLaunchCooperativeKernel((const void*)fwd_kernel, dim3(grid), dim3(NTHR), args, LDS_BYTES, stream);
    if (e != hipSuccess) fprintf(stderr, "cooperative launch failed: %s (grid %d)\n", hipGetErrorString(e), grid);
#else
    for (int ph = 0; ph < N_PHASES; ++ph) {
        p.ph_lo = ph; p.ph_hi = ph + 1; p.coop = 0;
        hipLaunchKernelGGL(fwd_kernel, dim3(grid), dim3(NTHR), LDS_BYTES, stream, p);
    }
#endif
}
```

```cpp
#include <hip/hip_runtime.h>
#include <hip/hip_cooperative_groups.h>
#include <cstdio>
#include <cstdint>
namespace cg = cooperative_groups;

#define LAS __attribute__((address_space(3)))
typedef unsigned short bf16_t;
typedef short bf16x8 __attribute__((ext_vector_type(8)));
typedef short s16x4 __attribute__((ext_vector_type(4)));
typedef float f32x4 __attribute__((ext_vector_type(4)));
typedef float f32x2 __attribute__((ext_vector_type(2)));
typedef float f32x16 __attribute__((ext_vector_type(16)));
typedef unsigned u32x4 __attribute__((ext_vector_type(4)));
typedef unsigned u32x2 __attribute__((ext_vector_type(2)));
typedef __bf16 bf16x2_t __attribute__((ext_vector_type(2)));

constexpr int DM = 1024, SEQ = 8192, NB = 2, DB = 32, DT = 8;
constexpr int MP = NB * SEQ;
constexpr int MS = DB * DT;
constexpr int MTOK = MP + MS;
constexpr int NMEM = 256, MMEM = NB * NMEM;
constexpr int MROWS = MTOK + MMEM;
constexpr int ATT_W = 384, RW = 384, MEM_W = 256, SHIFT_W = 1280, IN_W = 3712;
constexpr int NPAD = 3840;
constexpr int NWT = NPAD + 512;
constexpr int WINP = 2048;
constexpr int C_Q = 0, C_K = 384, C_V = 768, C_Z = 1152, C_QM = 2432, C_G = 2688;
constexpr size_t O_Y = 0, O_WK_P = 17039360, O_WV_P = 18612224, O_ST_P = 20185088, O_SH_P = 20234240, O_MK_P = 20236800, O_MV_P = 20367872,
                 O_WK_S = 20498944, O_WV_S = 20597248, O_ST_S = 20695552, O_SH_S = 21481984, O_END = 21522944;
constexpr size_t al256(size_t x) { return (x + 255) & ~(size_t)255; }
constexpr size_t WS_CTL = 0;
constexpr size_t WS_RINV = 1u << 20;
constexpr size_t WS_SS = al256(WS_RINV + (size_t)MROWS * 4);
constexpr size_t WS_ROPE = al256(WS_SS + (size_t)MTOK * 4);
constexpr int NPOS = 8200;
constexpr size_t WS_WT = al256(WS_ROPE + (size_t)NPOS * 16 * 4);
constexpr size_t WS_WOT = al256(WS_WT + (size_t)NWT * DM * 2);
constexpr size_t WS_XB = al256(WS_WOT + (size_t)DM * DM * 2);
constexpr size_t WS_Q = al256(WS_XB + (size_t)MROWS * DM * 2);
constexpr size_t WS_K = al256(WS_Q + (size_t)MTOK * ATT_W * 2);
constexpr size_t WS_V = al256(WS_K + (size_t)MTOK * ATT_W * 2);
constexpr size_t WS_ZB = al256(WS_V + (size_t)MTOK * ATT_W * 2);
constexpr size_t WS_QM = al256(WS_ZB + (size_t)MTOK * SHIFT_W * 4);
constexpr size_t WS_G = al256(WS_QM + (size_t)MTOK * MEM_W * 2);
constexpr size_t WS_MKB = al256(WS_G + (size_t)MTOK * DM * 2);
constexpr size_t WS_MVB = al256(WS_MKB + (size_t)MMEM * MEM_W * 2);
constexpr size_t WS_OAP = al256(WS_MVB + (size_t)MMEM * MEM_W * 2);
constexpr size_t WS_LSE = al256(WS_OAP + (size_t)3 * MP * ATT_W * 2);
constexpr size_t WS_OG = al256(WS_LSE + (size_t)3 * MP * 6 * 4);
constexpr size_t WS_END = al256(WS_OG + (size_t)MTOK * DM * 2);

constexpr int LDS_BYTES = 147456;
constexpr int NTHR = 512;

struct Params {
    const float* in[25];
    float* out;
    unsigned char* ws;
    int ph_lo, ph_hi, coop, pad;
};

__device__ __forceinline__ unsigned cvtpk(float lo, float hi) { f32x2 v = {lo, hi}; bf16x2_t b = __builtin_convertvector(v, bf16x2_t); return __builtin_bit_cast(unsigned, b); }
__device__ __forceinline__ bf16_t f2bf(float f) { return (bf16_t)(cvtpk(f, 0.f) & 0xffffu); }
__device__ __forceinline__ float bf2f(bf16_t b) { return __builtin_bit_cast(float, (unsigned)b << 16); }
__device__ __forceinline__ float bflo(unsigned w) { return __builtin_bit_cast(float, w << 16); }
__device__ __forceinline__ float bfhi(unsigned w) { return __builtin_bit_cast(float, w & 0xffff0000u); }
__device__ __forceinline__ float wave_sum(float v) {
#pragma unroll
    for (int o = 1; o < 64; o <<= 1) v += __shfl_xor(v, o);
    return v;
}
__device__ __forceinline__ float wave_max(float v) {
#pragma unroll
    for (int o = 1; o < 64; o <<= 1) v = fmaxf(v, __shfl_xor(v, o));
    return v;
}
#define LDS_WAIT() asm volatile("s_waitcnt lgkmcnt(0)" ::: "memory")

namespace pg8 {
constexpr int BM = 256, BK = 64, HALF = 128, HTB = HALF * BK * 2, STAGE_BYTES = 8 * HTB, NXCD = 8, WGM = 8;
__host__ __device__ __forceinline__ int lds_byte(int r, int c) { const int st = (r >> 4) * 2 + (c >> 5), rr = r & 15, cc = c & 31, ob = rr * 64 + cc * 2; return st * 1024 + (ob ^ (((ob >> 9) & 1) << 5)); }
__host__ __device__ __forceinline__ void stage_rc(int b, int& R, int& C) { const int st = b / 1024, sb = b % 1024, swz = sb ^ (((sb >> 9) & 1) << 5); R = (st >> 1) * 16 + swz / 64; C = (st & 1) * 32 + (swz % 64) / 2; }
__host__ __device__ __forceinline__ int perm32(int rho) { const int n = rho >> 4, i = rho & 15; return 8 * (i >> 2) + 4 * n + (i & 3); }
struct Unit { int pm, pn; };
struct Gemm { const bf16_t* A; const bf16_t* Bt; int M, N, K; };
struct StaticOrder {
    int nM, nN, nwg, G, c;
    __host__ __device__ void init(int M, int N, int G_, int c_) { nM = M / BM; nN = N / BM; nwg = nM * nN; G = G_; c = c_; }
    __host__ __device__ bool next(int i, Unit& u) const {
        const long L = (long)i * G + c; if (L >= nwg) return false;
        int wgid = (int)L; { const int q = nwg / NXCD, r = nwg % NXCD, xcd = wgid % NXCD, off = wgid / NXCD; wgid = (xcd < r ? xcd * (q + 1) : r * (q + 1) + (xcd - r) * q) + off; }
        const int nig = WGM * nN, gid = wgid / nig, fm = gid * WGM, gsz = (nM - fm) < WGM ? (nM - fm) : WGM;
        u.pm = fm + ((wgid % nig) % gsz); u.pn = (wgid % nig) / gsz; return true;
    }
    __device__ __forceinline__ void a_ready(const Unit&) const {}
    __device__ __forceinline__ void done(const Unit&) const {}
};

template <class Epi, class Sched, bool ALIGN_EPI = false, bool SP2 = false>
__device__ __forceinline__ void gemm_phase(LAS unsigned char* lds, const Gemm g, const Sched& S, const Epi& E) {
    const int tid = threadIdx.x, wid = __builtin_amdgcn_readfirstlane(tid >> 6), lane = tid & 63, wr = wid >> 2, wc = wid & 3, fr = lane & 15, fq = lane >> 4;
    const int K = g.K, nt = K / BK;
    unsigned voffA[2], voffB[2];
#pragma unroll
    for (int i = 0; i < 2; ++i) { int R, C; stage_rc(tid * 16 + i * 8192, R, C); const int Rb = Epi::PERM ? ((R & ~31) + perm32(R & 31)) : R;
        voffA[i] = (unsigned)(R * K + C) * 2u; voffB[i] = (unsigned)(Rb * K + C) * 2u; }
    const size_t kstep = (size_t)(BK * 2);
    const size_t hstep = (size_t)HALF * K * 2;
    const size_t tstep = 2 * hstep;
    const unsigned ldsw = (unsigned)wid * 1024u;
    const int aoff = lds_byte(wr * 64 + fr, fq * 8), boff = lds_byte(wc * 32 + fr, fq * 8);
#define PG8_SA(b, h) (((b) * 2 + (h)) * HTB)
#define PG8_SB(b, h) ((4 + (b) * 2 + (h)) * HTB)
#define PG8_STAGE(bufoff, gbase, voff) do { _Pragma("unroll") for (int _i = 0; _i < 2; ++_i) \
        __builtin_amdgcn_global_load_lds((const unsigned*)((const char*)(gbase) + (voff)[_i]), (LAS unsigned*)(lds + (bufoff) + ldsw + _i * 8192), 16, 0, 0); } while (0)
#define PG8_LDA(dst, b, h) do { _Pragma("unroll") for (int m = 0; m < 4; ++m) _Pragma("unroll") for (int k = 0; k < 2; ++k) dst[m][k] = *(const LAS bf16x8*)(lds + PG8_SA(b, h) + aoff + m * 2048 + k * 1024); } while (0)
#define PG8_LDB(dst, b, h) do { _Pragma("unroll") for (int n = 0; n < 2; ++n) _Pragma("unroll") for (int k = 0; k < 2; ++k) dst[n][k] = *(const LAS bf16x8*)(lds + PG8_SB(b, h) + boff + n * 2048 + k * 1024); } while (0)
#define PG8_MMA(ai, bj, At, Bt) do { __builtin_amdgcn_s_setprio(1); _Pragma("unroll") for (int m = 0; m < 4; ++m) _Pragma("unroll") for (int n = 0; n < 2; ++n) _Pragma("unroll") for (int k = 0; k < 2; ++k) \
        acc[ai][bj][m][n] = __builtin_amdgcn_mfma_f32_16x16x32_bf16(Bt[n][k], At[m][k], acc[ai][bj][m][n], 0, 0, 0); __builtin_amdgcn_s_setprio(0); } while (0)
#define PG8_WAIT_V(n) asm volatile("s_waitcnt vmcnt(" #n ")" ::: "memory")
#define PG8_WAIT_L(n) asm volatile("s_waitcnt lgkmcnt(" #n ")" ::: "memory")
#define PG8_BAR __builtin_amdgcn_s_barrier()
#define PG8_SCHED __builtin_amdgcn_sched_barrier(0)
    Unit cur, nxt; int ui = 0;
    if (!S.next(0, cur)) return;
    f32x4 acc[2][2][4][2];
#pragma unroll
    for (int a = 0; a < 2; ++a)
#pragma unroll
        for (int b = 0; b < 2; ++b)
#pragma unroll
            for (int m = 0; m < 4; ++m)
#pragma unroll
                for (int n = 0; n < 2; ++n) acc[a][b][m][n] = (f32x4){0.f, 0.f, 0.f, 0.f};
    bf16x8 At[4][2], B0[2][2], B1[2][2];
    const char* cA = (const char*)g.A + (size_t)cur.pm * tstep; const char* cB = (const char*)g.Bt + (size_t)cur.pn * tstep;
    S.a_ready(cur);
    if constexpr (SP2) {
        PG8_STAGE(PG8_SB(0, 0), cB, voffB); PG8_STAGE(PG8_SB(0, 1), cB + hstep, voffB); PG8_STAGE(PG8_SA(0, 0), cA, voffA); PG8_STAGE(PG8_SA(0, 1), cA + hstep, voffA);
        if (wr == 1) PG8_BAR;
        PG8_WAIT_V(2); PG8_BAR;
        PG8_STAGE(PG8_SB(1, 0), cB + kstep, voffB); PG8_STAGE(PG8_SA(1, 0), cA + kstep, voffA); PG8_STAGE(PG8_SB(1, 1), cB + hstep + kstep, voffB);
        PG8_WAIT_V(6); PG8_BAR;
    } else {
        PG8_STAGE(PG8_SB(0, 0), cB, voffB); PG8_STAGE(PG8_SA(0, 0), cA, voffA); PG8_STAGE(PG8_SB(0, 1), cB + hstep, voffB); PG8_STAGE(PG8_SA(0, 1), cA + hstep, voffA);
        if (wr == 1) PG8_BAR;
        PG8_WAIT_V(4); PG8_BAR;
        PG8_STAGE(PG8_SB(1, 0), cB + kstep, voffB); PG8_STAGE(PG8_SA(1, 0), cA + kstep, voffA); PG8_STAGE(PG8_SB(1, 1), cB + hstep + kstep, voffB);
        PG8_WAIT_V(6); PG8_BAR;
    }
    for (;;) {
        const bool has_next = S.next(ui + 1, nxt);
        const char* nA = has_next ? (const char*)g.A + (size_t)nxt.pm * tstep : cA; const char* nB = has_next ? (const char*)g.Bt + (size_t)nxt.pn * tstep : cB;
        for (int t = 0; t < nt; t += 2) {
            const bool last = (t == nt - 2);
            const char* a1 = cA + (size_t)(t + 1) * kstep;
            const char* a2 = last ? nA : cA + (size_t)(t + 2) * kstep; const char* b2 = last ? nB : cB + (size_t)(t + 2) * kstep;
            const char* a3 = a2 + kstep; const char* b3 = b2 + kstep;
            if (last && has_next) S.a_ready(nxt);
            if constexpr (SP2) {
            PG8_LDB(B0, 0, 0); PG8_LDB(B1, 0, 1); PG8_SCHED; PG8_LDA(At, 0, 0); PG8_STAGE(PG8_SA(1, 1), a1 + hstep, voffA);
            PG8_WAIT_V(8); PG8_WAIT_L(0); PG8_BAR; PG8_MMA(0, 0, At, B0); PG8_MMA(0, 1, At, B1); PG8_BAR; PG8_SCHED;
            PG8_LDA(At, 0, 1); PG8_STAGE(PG8_SB(0, 0), b2, voffB); PG8_STAGE(PG8_SB(0, 1), b2 + hstep, voffB); PG8_STAGE(PG8_SA(0, 0), a2, voffA);
            PG8_WAIT_V(8); PG8_WAIT_L(0); PG8_BAR; PG8_MMA(1, 0, At, B0); PG8_MMA(1, 1, At, B1); PG8_BAR; PG8_SCHED;
            PG8_LDB(B0, 1, 0); PG8_LDB(B1, 1, 1); PG8_SCHED; PG8_LDA(At, 1, 0); PG8_STAGE(PG8_SA(0, 1), a2 + hstep, voffA);
            PG8_WAIT_V(8); PG8_WAIT_L(0); PG8_BAR; PG8_MMA(0, 0, At, B0); PG8_MMA(0, 1, At, B1); PG8_BAR; PG8_SCHED;
            PG8_LDA(At, 1, 1); PG8_STAGE(PG8_SB(1, 0), b3, voffB); PG8_STAGE(PG8_SB(1, 1), b3 + hstep, voffB); PG8_STAGE(PG8_SA(1, 0), a3, voffA);
            PG8_WAIT_V(8); PG8_WAIT_L(0); PG8_BAR; PG8_MMA(1, 0, At, B0); PG8_MMA(1, 1, At, B1); PG8_BAR; PG8_SCHED;
            } else {
            PG8_LDB(B0, 0, 0); PG8_SCHED; PG8_LDA(At, 0, 0); PG8_STAGE(PG8_SA(1, 1), a1 + hstep, voffA);
            PG8_WAIT_L(8); PG8_BAR; PG8_WAIT_L(0); PG8_MMA(0, 0, At, B0); PG8_BAR; PG8_SCHED;
            PG8_LDB(B1, 0, 1); PG8_STAGE(PG8_SB(0, 0), b2, voffB);
            PG8_BAR; PG8_WAIT_L(0); PG8_MMA(0, 1, At, B1); PG8_BAR;
            PG8_LDA(At, 0, 1); PG8_STAGE(PG8_SA(0, 0), a2, voffA);
            PG8_BAR; PG8_WAIT_L(0); PG8_MMA(1, 0, At, B0); PG8_BAR; PG8_SCHED;
            PG8_STAGE(PG8_SB(0, 1), b2 + hstep, voffB);
            PG8_WAIT_V(6); PG8_BAR; PG8_MMA(1, 1, At, B1); PG8_BAR;
            PG8_LDB(B0, 1, 0); PG8_SCHED; PG8_LDA(At, 1, 0); PG8_STAGE(PG8_SA(0, 1), a2 + hstep, voffA);
            PG8_WAIT_L(8); PG8_BAR; PG8_WAIT_L(0); PG8_MMA(0, 0, At, B0); PG8_BAR; PG8_SCHED;
            PG8_LDB(B1, 1, 1); PG8_STAGE(PG8_SB(1, 0), b3, voffB);
            PG8_BAR; PG8_WAIT_L(0); PG8_MMA(0, 1, At, B1); PG8_BAR;
            PG8_LDA(At, 1, 1); PG8_STAGE(PG8_SA(1, 0), a3, voffA);
            PG8_BAR; PG8_WAIT_L(0); PG8_MMA(1, 0, At, B0); PG8_BAR; PG8_SCHED;
            PG8_STAGE(PG8_SB(1, 1), b3 + hstep, voffB);
            PG8_WAIT_V(6); PG8_BAR; PG8_MMA(1, 1, At, B1); PG8_BAR;
            }
        }
        if constexpr (ALIGN_EPI) { if (wr == 0) PG8_BAR; }
        if constexpr (!Epi::AFTER_DRAIN) { E(acc, cur, wr, wc, fr, fq); S.done(cur); }
        if (!has_next) break;
#pragma unroll
        for (int a = 0; a < 2; ++a)
#pragma unroll
            for (int b = 0; b < 2; ++b)
#pragma unroll
                for (int m = 0; m < 4; ++m)
#pragma unroll
                    for (int n = 0; n < 2; ++n) acc[a][b][m][n] = (f32x4){0.f, 0.f, 0.f, 0.f};
        cur = nxt; cA = nA; cB = nB; ++ui;
        if constexpr (ALIGN_EPI) { if (wr == 1) PG8_BAR; }
    }
    PG8_WAIT_V(0);
    if constexpr (!ALIGN_EPI) { if (wr == 0) PG8_BAR; }
    PG8_BAR;
    if constexpr (Epi::AFTER_DRAIN) { E.fused(acc, cur, wr, wc, fr, fq, lds, wid, lane); S.done(cur); }
#undef PG8_SA
#undef PG8_SB
#undef PG8_STAGE
#undef PG8_LDA
#undef PG8_LDB
#undef PG8_MMA
#undef PG8_WAIT_V
#undef PG8_WAIT_L
#undef PG8_BAR
#undef PG8_SCHED
}
}

constexpr int G1_NM = MTOK / 256, G1_NN = NPAD / 256, G1_MAIN = G1_NM * G1_NN, G1_UNITS = G1_MAIN + 4;
struct Sched1 {
    pg8::StaticOrder so;
    __device__ void init(int G, int c) { so.init(MTOK, NPAD, G, c); }
    __device__ bool next(int i, pg8::Unit& u) const {
        const long L = (long)i * so.G + so.c;
        if (L >= G1_UNITS) return false;
        if (L >= G1_MAIN) { const int e = (int)L - G1_MAIN; u.pm = G1_NM + (e >> 1); u.pn = G1_NN + (e & 1); return true; }
        return so.next(i, u);
    }
    __device__ __forceinline__ void a_ready(const pg8::Unit&) const {}
    __device__ __forceinline__ void done(const pg8::Unit&) const {}
};

struct Epi1 {
    static constexpr bool PERM = true, AFTER_DRAIN = false;
    const float* rinv; const float* rope; bf16_t *Qb, *Kb, *Vb, *QMb, *Gb, *MKB, *MVB; float* ZB; float* out;
    __device__ __forceinline__ void operator()(const f32x4 (&acc)[2][2][4][2], const pg8::Unit& u, int wr, int wc, int fr, int fq) const {
        const bool memu = u.pm >= G1_NM;
#pragma unroll
        for (int ai = 0; ai < 2; ++ai)
#pragma unroll
            for (int m = 0; m < 4; ++m) {
                const int row = u.pm * 256 + ai * 128 + wr * 64 + m * 16 + fr;
                const float rs = rinv[row];
#pragma unroll
                for (int bj = 0; bj < 2; ++bj) {
                    const int c0 = u.pn * 256 + bj * 128 + wc * 32 + 8 * fq;
                    float v[8];
#pragma unroll
                    for (int e = 0; e < 4; ++e) { v[e] = acc[ai][bj][m][0][e] * rs; v[4 + e] = acc[ai][bj][m][1][e] * rs; }
                    if (memu) {
                        const int mrow = row - MTOK, mc = c0 - NPAD;
                        float* of = out + (mc < 256 ? O_MK_P : O_MV_P) + (size_t)mrow * 256 + (mc & 255);
                        *(f32x4*)of = (f32x4){v[0], v[1], v[2], v[3]}; *(f32x4*)(of + 4) = (f32x4){v[4], v[5], v[6], v[7]};
                        bf16_t* ob = (mc < 256 ? MKB : MVB) + (size_t)mrow * 256 + (mc & 255);
                        *(u32x4*)ob = (u32x4){cvtpk(v[0], v[1]), cvtpk(v[2], v[3]), cvtpk(v[4], v[5]), cvtpk(v[6], v[7])};
                        continue;
                    }
                    const int cb = c0 >> 7;
                    const bool samp = row >= MP;
                    const int srow = row - MP;
                    if (cb < 6) {
                        if ((wc & 1) == 0) {
                            float pr[8];
#pragma unroll
                            for (int e = 0; e < 8; ++e) pr[e] = __shfl_xor(v[e], 16);
                            if (fq < 2) {
                                const int pos = samp ? (SEQ + (srow & 7)) : (row & (SEQ - 1));
                                const f32x4 c0v = *(const f32x4*)(rope + (size_t)pos * 16), c1v = *(const f32x4*)(rope + (size_t)pos * 16 + 4);
                                const f32x4 s0v = *(const f32x4*)(rope + (size_t)pos * 16 + 8), s1v = *(const f32x4*)(rope + (size_t)pos * 16 + 12);
                                const float cs[8] = {c0v[0], c0v[1], c0v[2], c0v[3], c1v[0], c1v[1], c1v[2], c1v[3]};
                                const float sn[8] = {s0v[0], s0v[1], s0v[2], s0v[3], s1v[0], s1v[1], s1v[2], s1v[3]};
                                const float sg = (fq == 0) ? -1.f : 1.f;
#pragma unroll
                                for (int e = 0; e < 8; ++e) v[e] = v[e] * cs[e] + sg * pr[e] * sn[e];
                            }
                        }
                        if (cb < 3) {
#pragma unroll
                            for (int e = 0; e < 8; ++e) v[e] *= 0.125f;
                            *(u32x4*)(Qb + (size_t)row * ATT_W + c0) = (u32x4){cvtpk(v[0], v[1]), cvtpk(v[2], v[3]), cvtpk(v[4], v[5]), cvtpk(v[6], v[7])};
                        } else {
                            const int cc = c0 - C_K;
                            *(u32x4*)(Kb + (size_t)row * ATT_W + cc) = (u32x4){cvtpk(v[0], v[1]), cvtpk(v[2], v[3]), cvtpk(v[4], v[5]), cvtpk(v[6], v[7])};
                            float* of = nullptr;
                            if (samp) of = out + O_WK_S + (size_t)srow * ATT_W + cc;
                            else { const int t = row & (SEQ - 1); if (t >= SEQ - WINP) of = out + O_WK_P + ((size_t)(row >> 13) * WINP + (t - (SEQ - WINP))) * ATT_W + cc; }
                            if (of) { *(f32x4*)of = (f32x4){v[0], v[1], v[2], v[3]}; *(f32x4*)(of + 4) = (f32x4){v[4], v[5], v[6], v[7]}; }
                        }
                    } else if (cb < 9) {
                        const int cc = c0 - C_V;
                        *(u32x4*)(Vb + (size_t)row * ATT_W + cc) = (u32x4){cvtpk(v[0], v[1]), cvtpk(v[2], v[3]), cvtpk(v[4], v[5]), cvtpk(v[6], v[7])};
                        float* of = nullptr;
                        if (samp) of = out + O_WV_S + (size_t)srow * ATT_W + cc;
                        else { const int t = row & (SEQ - 1); if (t >= SEQ - WINP) of = out + O_WV_P + ((size_t)(row >> 13) * WINP + (t - (SEQ - WINP))) * ATT_W + cc; }
                        if (of) { *(f32x4*)of = (f32x4){v[0], v[1], v[2], v[3]}; *(f32x4*)(of + 4) = (f32x4){v[4], v[5], v[6], v[7]}; }
                    } else if (cb < 19) {
                        const int cc = c0 - C_Z;
                        float* zf = ZB + (size_t)row * SHIFT_W + cc;
                        *(f32x4*)zf = (f32x4){v[0], v[1], v[2], v[3]}; *(f32x4*)(zf + 4) = (f32x4){v[4], v[5], v[6], v[7]};
                        float* of = nullptr;
                        if (samp) { if ((srow & 7) == 7) of = out + O_SH_S + (size_t)(srow >> 3) * SHIFT_W + cc; }
                        else if ((row & (SEQ - 1)) == SEQ - 1) of = out + O_SH_P + (size_t)(row >> 13) * SHIFT_W + cc;
                        if (of) { *(f32x4*)of = (f32x4){v[0], v[1], v[2], v[3]}; *(f32x4*)(of + 4) = (f32x4){v[4], v[5], v[6], v[7]}; }
                    } else if (cb < 21) {
                        const int cc = c0 - C_QM;
#pragma unroll
                        for (int e = 0; e < 8; ++e) v[e] *= 0.125f;
                        *(u32x4*)(QMb + (size_t)row * MEM_W + cc) = (u32x4){cvtpk(v[0], v[1]), cvtpk(v[2], v[3]), cvtpk(v[4], v[5]), cvtpk(v[6], v[7])};
                    } else if (cb < 29) {
                        const int cc = c0 - C_G;
#pragma unroll
                        for (int e = 0; e < 8; ++e) v[e] = v[e] / (1.f + __expf(-v[e]));
                        *(u32x4*)(Gb + (size_t)row * DM + cc) = (u32x4){cvtpk(v[0], v[1]), cvtpk(v[2], v[3]), cvtpk(v[4], v[5]), cvtpk(v[6], v[7])};
                    }
                }
            }
    }
};

struct Epi2 {
    static constexpr bool PERM = false, AFTER_DRAIN = false;
    const float* xp; const float* xs; float* Y; float* SS;
    __device__ __forceinline__ void operator()(const f32x4 (&acc)[2][2][4][2], const pg8::Unit& u, int wr, int wc, int fr, int fq) const {
#pragma unroll
        for (int ai = 0; ai < 2; ++ai)
#pragma unroll
            for (int m = 0; m < 4; ++m) {
                const int row = u.pm * 256 + ai * 128 + wr * 64 + m * 16 + fr;
                const float* xr = (row < MP) ? xp + (size_t)row * DM : xs + (size_t)(row - MP) * DM;
                float ss = 0.f;
#pragma unroll
                for (int bj = 0; bj < 2; ++bj)
#pragma unroll
                    for (int n = 0; n < 2; ++n) {
                        const int c = u.pn * 256 + bj * 128 + wc * 32 + n * 16 + 4 * fq;
                        const f32x4 xv = *(const f32x4*)(xr + c);
                        const f32x4 o = xv + acc[ai][bj][m][n];
                        ss += (o[0] * o[0] + o[1] * o[1]) + (o[2] * o[2] + o[3] * o[3]);
                        *(f32x4*)(Y + (size_t)row * DM + c) = o;
                    }
                ss += __shfl_xor(ss, 16); ss += __shfl_xor(ss, 32);
                if (fq == 0) atomicAdd(SS + row, ss);
            }
    }
};

constexpr int KS = 144, VS = 144;
constexpr float L2E = 1.4426950408889634f;
__device__ __forceinline__ int crow(int r, int hi) { return (r & 3) + 8 * (r >> 2) + 4 * hi; }
typedef short v4i16_t __attribute__((ext_vector_type(4)));
__device__ __forceinline__ s16x4 vtr(LAS const unsigned char* p) { return __builtin_bit_cast(s16x4, __builtin_amdgcn_ds_read_tr16_b64_v4i16((LAS v4i16_t*)p)); }

template <int NTG, int NG, bool BAND>
__device__ __forceinline__ void strip_attn(const bf16x8 (&qf)[4], LAS const unsigned char* Kl, LAS const unsigned char* Vl, int krow0, int lane, int kmin,
                                           f32x16 (&o)[2], float& m_out, float& l_out) {
    const int q = lane & 31, hi = lane >> 5;
    float m_run = -INFINITY, l_run = 0.f;
#pragma unroll
    for (int r = 0; r < 16; ++r) { o[0][r] = 0.f; o[1][r] = 0.f; }
#pragma unroll
    for (int g = 0; g < NG; ++g) {
        f32x16 S[NTG];
#pragma unroll
        for (int t = 0; t < NTG; ++t) {
#pragma unroll
            for (int r = 0; r < 16; ++r) S[t][r] = 0.f;
            LAS const unsigned char* kp = Kl + (size_t)(krow0 + (g * NTG + t) * 32 + q) * KS + hi * 16;
#pragma unroll
            for (int d0 = 0; d0 < 4; ++d0) {
                const bf16x8 kf = *(LAS const bf16x8*)(kp + d0 * 32);
                S[t] = __builtin_amdgcn_mfma_f32_32x32x16_bf16(kf, qf[d0], S[t], 0, 0, 0);
            }
        }
        float mx = -INFINITY;
#pragma unroll
        for (int t = 0; t < NTG; ++t)
#pragma unroll
            for (int r = 0; r < 16; ++r) {
                if (BAND) { const int ko = 32 * (g * NTG + t) + crow(r, hi); if (ko < q || ko > q + 128 || ko < kmin) S[t][r] = -INFINITY; }
                mx = fmaxf(mx, S[t][r]);
            }
        mx = fmaxf(mx, __shfl_xor(mx, 32));
        const float m_new = fmaxf(m_run, mx);
        const float alpha = __builtin_amdgcn_exp2f((m_run - m_new) * L2E);
        float ls = 0.f;
#pragma unroll
        for (int t = 0; t < NTG; ++t)
#pragma unroll
            for (int r = 0; r < 16; ++r) { const float p = __builtin_amdgcn_exp2f((S[t][r] - m_new) * L2E); S[t][r] = p; ls += p; }
        ls += __shfl_xor(ls, 32);
        l_run = l_run * alpha + ls; m_run = m_new;
        if (g > 0) {
#pragma unroll
            for (int r = 0; r < 16; ++r) { const float a = __shfl(alpha, crow(r, hi)); o[0][r] *= a; o[1][r] *= a; }
        }
#pragma unroll
        for (int t = 0; t < NTG; ++t)
#pragma unroll
            for (int s = 0; s < 2; ++s) {
                u32x4 pw; pw[0] = cvtpk(S[t][8 * s + 0], S[t][8 * s + 1]); pw[1] = cvtpk(S[t][8 * s + 2], S[t][8 * s + 3]);
                pw[2] = cvtpk(S[t][8 * s + 4], S[t][8 * s + 5]); pw[3] = cvtpk(S[t][8 * s + 6], S[t][8 * s + 7]);
                const bf16x8 pa = __builtin_bit_cast(bf16x8, pw);
                const int vrow = krow0 + (g * NTG + t) * 32 + 16 * s + 4 * hi + ((lane & 15) >> 2);
                LAS const unsigned char* vp = Vl + (size_t)vrow * VS + (16 * ((lane >> 4) & 1) + 4 * (lane & 3)) * 2;
#pragma unroll
                for (int dt = 0; dt < 2; ++dt) {
                    const s16x4 lo = vtr(vp + dt * 64), hh = vtr(vp + dt * 64 + 8 * VS);
                    const bf16x8 vb = (bf16x8){lo[0], lo[1], lo[2], lo[3], hh[0], hh[1], hh[2], hh[3]};
                    o[dt] = __builtin_amdgcn_mfma_f32_32x32x16_bf16(pa, vb, o[dt], 0, 0, 0);
                }
            }
    }
    m_out = m_run; l_out = l_run;
}

struct Ptrs {
    const float* in[25]; float* out; unsigned char* ws;
    float *RINV, *SS, *ROPE, *ZB, *LSE;
    bf16_t *WT, *WOT, *XB, *Qb, *Kb, *Vb, *QMb, *Gb, *MKB, *MVB, *OAP, *OG;
};

constexpr int N_DIL_UNITS = NB * 6 * 3 * 32;
__device__ __forceinline__ void dil_unit(const Ptrs& P, LAS unsigned char* lds, int unit, int tid) {
    const int lane = tid & 63, wave = tid >> 6;
    const int u32 = unit & 31, x = unit >> 5, di = x % 3, bh = x / 3, b = bh / 6, h = bh % 6;
    const int dil = (di == 0) ? 1 : (di == 1 ? 4 : 16), nb2 = 32 / dil, res = u32 / nb2, j = u32 % nb2;
    LAS unsigned char* Kl = lds; LAS unsigned char* Vl = lds + 384 * KS;
    const int l0 = 256 * j - 128;
#pragma unroll
    for (int i = 0; i < 6; ++i) {
        const int e = tid + NTHR * i, row = e >> 3, c = e & 7, l = l0 + row;
        u32x4 kv = (u32x4){0u, 0u, 0u, 0u}, vv = kv;
        if (l >= 0) { const size_t off = ((size_t)b * SEQ + (size_t)l * dil + res) * ATT_W + h * 64 + c * 8; kv = *(const u32x4*)(P.Kb + off); vv = *(const u32x4*)(P.Vb + off); }
        *(LAS u32x4*)(Kl + row * KS + c * 16) = kv; *(LAS u32x4*)(Vl + row * VS + c * 16) = vv;
    }
    __syncthreads();
    const int q = lane & 31, hi = lane >> 5, lq0 = 256 * j + 32 * wave;
    const size_t tokq = (size_t)b * SEQ + (size_t)(lq0 + q) * dil + res;
    bf16x8 qf[4];
#pragma unroll
    for (int d0 = 0; d0 < 4; ++d0) qf[d0] = *(const bf16x8*)(P.Qb + tokq * ATT_W + h * 64 + d0 * 16 + hi * 8);
    f32x16 o[2]; float mm, ll;
    strip_attn<5, 1, true>(qf, Kl, Vl, 32 * wave, lane, (lq0 < 128) ? 128 - lq0 : 0, o, mm, ll);
    const float linv = 1.f / ll;
#pragma unroll
    for (int r = 0; r < 16; ++r) {
        const int qq = crow(r, hi); const float li = __shfl(linv, qq);
        const size_t tok = (size_t)b * SEQ + (size_t)(lq0 + qq) * dil + res;
        bf16_t* op = P.OAP + ((size_t)di * MP + tok) * ATT_W + h * 64 + q;
        op[0] = f2bf(o[0][r] * li); op[32] = f2bf(o[1][r] * li);
    }
    if (hi == 0) P.LSE[((size_t)di * MP + tokq) * 6 + h] = mm + __logf(ll);
    __syncthreads();
}

constexpr int N_MEMA_UNITS = NB * 4 * 32;
__device__ __forceinline__ void mem_unit(const Ptrs& P, LAS unsigned char* lds, int unit, int tid) {
    const int lane = tid & 63, wave = tid >> 6;
    const int jq = unit & 31, bh = unit >> 5, b = bh >> 2, hm = bh & 3;
    LAS unsigned char* Kl = lds; LAS unsigned char* Vl = lds + 256 * KS;
#pragma unroll
    for (int i = 0; i < 4; ++i) {
        const int e = tid + NTHR * i, row = e >> 3, c = e & 7;
        const size_t off = ((size_t)b * NMEM + row) * MEM_W + hm * 64 + c * 8;
        *(LAS u32x4*)(Kl + row * KS + c * 16) = *(const u32x4*)(P.MKB + off); *(LAS u32x4*)(Vl + row * VS + c * 16) = *(const u32x4*)(P.MVB + off);
    }
    __syncthreads();
    const int q = lane & 31, hi = lane >> 5;
    const size_t tok0 = (size_t)b * SEQ + 256 * jq + 32 * wave;
    bf16x8 qf[4];
#pragma unroll
    for (int d0 = 0; d0 < 4; ++d0) qf[d0] = *(const bf16x8*)(P.QMb + (tok0 + q) * MEM_W + hm * 64 + d0 * 16 + hi * 8);
    f32x16 o[2]; float mm, ll;
    strip_attn<4, 2, false>(qf, Kl, Vl, 0, lane, 0, o, mm, ll);
    const float linv = 1.f / ll;
#pragma unroll
    for (int r = 0; r < 16; ++r) {
        const int qq = crow(r, hi); const float li = __shfl(linv, qq);
        const size_t oo = (tok0 + qq) * DM + 768 + hm * 64 + q;
        P.OG[oo] = f2bf(o[0][r] * li * bf2f(P.Gb[oo])); P.OG[oo + 32] = f2bf(o[1][r] * li * bf2f(P.Gb[oo + 32]));
    }
    __syncthreads();
}

constexpr int N_SDIL_ITEMS = DB * DT;
__device__ __forceinline__ void sdil_item(const Ptrs& P, LAS unsigned char* lds, int item, int tid) {
    const int db = item >> 3, i = item & 7, lane = tid & 63, wave = tid >> 6;
    LAS float* sc = (LAS float*)lds;
    LAS float* st = sc + 3 * 132 * 6;
    LAS float* red = st + 32;
    const int g = tid / 96, u = tid % 96, hh = u >> 4;
    const size_t srow = (size_t)MP + db * 8 + i;
    const float* ck = P.in[2] + (size_t)db * WINP * ATT_W; const float* cv = P.in[3] + (size_t)db * WINP * ATT_W;
    const float* nk = P.out + O_WK_S + (size_t)db * 8 * ATT_W; const float* nv = P.out + O_WV_S + (size_t)db * 8 * ATT_W;
    f32x4 q4 = (f32x4){0.f, 0.f, 0.f, 0.f};
    if (g < 5) { const u32x2 w = *(const u32x2*)(P.Qb + srow * ATT_W + u * 4); q4 = (f32x4){bflo(w[0]), bfhi(w[0]), bflo(w[1]), bfhi(w[1])}; }
    for (int di = 0; di < 3; ++di) {
        const int dil = (di == 0) ? 1 : (di == 1 ? 4 : 16);
        for (int jj = g; jj < 129 + 4; jj += 5) {
            float d = 0.f;
            if (g < 5 && jj < 129) { const int idx = WINP + i - dil * jj; const float* kr = (idx >= WINP) ? nk + (size_t)(idx - WINP) * ATT_W : ck + (size_t)idx * ATT_W;
                const f32x4 k4 = *(const f32x4*)(kr + u * 4); d = (k4[0] * q4[0] + k4[1] * q4[1]) + (k4[2] * q4[2] + k4[3] * q4[3]); }
            d += __shfl_xor(d, 1); d += __shfl_xor(d, 2); d += __shfl_xor(d, 4); d += __shfl_xor(d, 8);
            if (g < 5 && jj < 129 && (u & 15) == 0) sc[(di * 132 + jj) * 6 + hh] = d;
        }
    }
    __syncthreads();
    LAS float* stm = st + 32 + 5 * 384;
    for (int pr = wave; pr < 18; pr += 8) {
        const int di = pr / 6, h2 = pr % 6;
        float v0 = sc[(di * 132 + lane) * 6 + h2], v1 = sc[(di * 132 + 64 + lane) * 6 + h2], v2 = (lane == 0) ? sc[(di * 132 + 128) * 6 + h2] : -INFINITY;
        const float mx = wave_max(fmaxf(fmaxf(v0, v1), v2));
        v0 = __expf(v0 - mx); v1 = __expf(v1 - mx); v2 = (lane == 0) ? __expf(v2 - mx) : 0.f;
        const float sm = wave_sum(v0 + v1 + v2);
        sc[(di * 132 + lane) * 6 + h2] = v0; sc[(di * 132 + 64 + lane) * 6 + h2] = v1; if (lane == 0) { sc[(di * 132 + 128) * 6 + h2] = v2; stm[pr] = mx; stm[18 + pr] = sm; }
    }
    __syncthreads();
    if (tid < 6) {
        const float l0 = stm[tid] + __logf(stm[18 + tid]), l1 = stm[6 + tid] + __logf(stm[24 + tid]), l2 = stm[12 + tid] + __logf(stm[30 + tid]);
        const float mx = fmaxf(l0, fmaxf(l1, l2)); const float e0 = __expf(l0 - mx), e1 = __expf(l1 - mx), e2 = __expf(l2 - mx); const float inv = 1.f / (e0 + e1 + e2);
        st[tid] = e0 * inv / stm[18 + tid]; st[6 + tid] = e1 * inv / stm[24 + tid]; st[12 + tid] = e2 * inv / stm[30 + tid];
    }
    __syncthreads();
    if (g < 5) {
        f32x4 a = (f32x4){0.f, 0.f, 0.f, 0.f};
        for (int di = 0; di < 3; ++di) {
            const int dil = (di == 0) ? 1 : (di == 1 ? 4 : 16); const float cf = st[di * 6 + hh];
            for (int jj = g; jj < 129; jj += 5) { const int idx = WINP + i - dil * jj; const float* vr = (idx >= WINP) ? nv + (size_t)(idx - WINP) * ATT_W : cv + (size_t)idx * ATT_W;
                const f32x4 v4 = *(const f32x4*)(vr + u * 4); const float pw = sc[(di * 132 + jj) * 6 + hh] * cf; a += v4 * pw; }
        }
        *(LAS f32x4*)(red + g * 384 + u * 4) = a;
    }
    __syncthreads();
    if (tid < 96) {
        f32x4 a = *(LAS f32x4*)(red + tid * 4);
#pragma unroll
        for (int k = 1; k < 5; ++k) a += *(LAS f32x4*)(red + k * 384 + tid * 4);
        const u32x2 gw = *(const u32x2*)(P.Gb + srow * DM + tid * 4);
        u32x2 w; w[0] = cvtpk(a[0] * bflo(gw[0]), a[1] * bfhi(gw[0])); w[1] = cvtpk(a[2] * bflo(gw[1]), a[3] * bfhi(gw[1]));
        *(u32x2*)(P.OG + srow * DM + tid * 4) = w;
    }
    __syncthreads();
}

constexpr int N_SMEM_ITEMS = DB * 4;
__device__ __forceinline__ void smem_item(const Ptrs& P, LAS unsigned char* lds, int item, int tid) {
    const int db = item >> 2, hm = item & 3, lane = tid & 63, wave = tid >> 6;
    LAS float* qs = (LAS float*)lds;
    LAS float* sc = qs + 512;
    LAS float* li = sc + 2048;
    { const int qi = tid >> 6, d = tid & 63; qs[tid] = bf2f(P.QMb[((size_t)MP + db * 8 + qi) * MEM_W + hm * 64 + d]); }
    __syncthreads();
    {
        const int m = tid & 255, qh = tid >> 8;
        const float* kr = P.in[6] + (((size_t)db * NMEM + m) * 4 + hm) * 64;
        float d0 = 0.f, d1 = 0.f, d2 = 0.f, d3 = 0.f;
#pragma unroll 4
        for (int c = 0; c < 16; ++c) {
            const f32x4 k4 = *(const f32x4*)(kr + c * 4);
            const f32x4 a0 = *(LAS f32x4*)(qs + (qh * 4 + 0) * 64 + c * 4), a1 = *(LAS f32x4*)(qs + (qh * 4 + 1) * 64 + c * 4), a2 = *(LAS f32x4*)(qs + (qh * 4 + 2) * 64 + c * 4), a3 = *(LAS f32x4*)(qs + (qh * 4 + 3) * 64 + c * 4);
            d0 += (k4[0] * a0[0] + k4[1] * a0[1]) + (k4[2] * a0[2] + k4[3] * a0[3]); d1 += (k4[0] * a1[0] + k4[1] * a1[1]) + (k4[2] * a1[2] + k4[3] * a1[3]);
            d2 += (k4[0] * a2[0] + k4[1] * a2[1]) + (k4[2] * a2[2] + k4[3] * a2[3]); d3 += (k4[0] * a3[0] + k4[1] * a3[1]) + (k4[2] * a3[2] + k4[3] * a3[3]);
        }
        sc[(qh * 4 + 0) * 256 + m] = d0; sc[(qh * 4 + 1) * 256 + m] = d1; sc[(qh * 4 + 2) * 256 + m] = d2; sc[(qh * 4 + 3) * 256 + m] = d3;
    }
    __syncthreads();
    {
        float v[4]; float mx = -INFINITY;
#pragma unroll
        for (int k = 0; k < 4; ++k) { v[k] = sc[wave * 256 + k * 64 + lane]; mx = fmaxf(mx, v[k]); }
        mx = wave_max(mx); float sm = 0.f;
#pragma unroll
        for (int k = 0; k < 4; ++k) { v[k] = __expf(v[k] - mx); sm += v[k]; sc[wave * 256 + k * 64 + lane] = v[k]; }
        sm = wave_sum(sm); if (lane == 0) li[wave] = 1.f / sm;
    }
    __syncthreads();
    {
        const int qi = tid >> 6, d = tid & 63;
        const float* vr = P.in[7] + (((size_t)db * NMEM) * 4 + hm) * 64 + d;
        float a = 0.f;
#pragma unroll 8
        for (int m = 0; m < 256; ++m) a += sc[qi * 256 + m] * vr[(size_t)m * 256];
        const size_t oo = ((size_t)MP + db * 8 + qi) * DM + 768 + hm * 64 + d;
        P.OG[oo] = f2bf(a * li[qi] * bf2f(P.Gb[oo]));
    }
    __syncthreads();
}

constexpr int N_SCAN_P = NB * 6, N_SCAN_S = DB * 6;
constexpr int CH = 32;
__device__ __forceinline__ float softplusf(float x) { return fmaxf(x, 0.f) + log1pf(__expf(-fabsf(x))); }
__device__ __forceinline__ void scan_item(const Ptrs& P, LAS unsigned char* lds, bool sample, int bb, int h, int tid) {
    const int lane = tid & 63, wave = tid >> 6;
    const int T = sample ? DT : SEQ;
    const size_t row0 = sample ? (size_t)MP + bb * DT : (size_t)bb * SEQ;
    LAS float* W2h = (LAS float*)lds;
    LAS float* A2h = W2h + 4096;
    LAS float* Rr = A2h + 4096;
    LAS float* Kk = Rr + CH * 64;
    LAS float* Vv = Kk + CH * 64;
    LAS float* Wd = Vv + CH * 64;
    LAS float* KK = Wd + CH * 64;
    LAS float* Bb = KK + CH * 64;
    LAS float* TW = Bb + CH * 64;
    LAS float* AL = TW + CH * 64;
    LAS float* Yb = AL + CH * 64;
    const float* mu = P.in[11]; const float* w0 = P.in[12]; const float* w2 = P.in[13]; const float* a0 = P.in[14]; const float* a2 = P.in[15];
    const float* k_k = P.in[16]; const float* k_a = P.in[17]; const float* r_k = P.in[18]; const float* lnx_g = P.in[19]; const float* lnx_b = P.in[20];
    for (int e = tid; e < 4096; e += NTHR) { const int jr = e >> 6, c = e & 63; W2h[e] = w2[(size_t)jr * RW + h * 64 + c]; A2h[e] = a2[(size_t)jr * RW + h * 64 + c]; }
    const int v = tid >> 3, kq = tid & 7;
    float s[8];
    if (sample) {
        const float* sp = P.in[4] + (((size_t)bb * 6 + h) * 64 + v) * 64 + kq * 8;
#pragma unroll
        for (int e = 0; e < 8; ++e) s[e] = sp[e];
    } else {
#pragma unroll
        for (int e = 0; e < 8; ++e) s[e] = 0.f;
    }
    const float* shift0 = P.in[5] + (size_t)bb * SHIFT_W;
    __syncthreads();
    for (int c0 = 0; c0 < T; c0 += CH) {
        const int n = (T - c0) < CH ? (T - c0) : CH;
        for (int idx = tid; idx < n * 320; idx += NTHR) {
            const int t = idx / 320, ci = idx % 320, grp = ci >> 6, cc = ci & 63;
            const int col = (grp < 3) ? grp * RW + h * 64 + cc : 3 * RW + (grp - 3) * 64 + cc;
            const size_t row = row0 + c0 + t;
            const float z = P.ZB[row * SHIFT_W + col];
            const float zp = (c0 + t == 0) ? (sample ? shift0[col] : 0.f) : P.ZB[(row - 1) * SHIFT_W + col];
            const float zs = z + (zp - z) * mu[col];
            if (grp == 0) Rr[t * 64 + cc] = zs; else if (grp == 1) Kk[t * 64 + cc] = zs; else if (grp == 2) Vv[t * 64 + cc] = zs;
            else if (grp == 3) TW[t * 64 + cc] = tanhf(zs); else AL[t * 64 + cc] = zs;
        }
        __syncthreads();
        for (int idx = tid; idx < n * 64; idx += NTHR) {
            const int t = idx >> 6, c = idx & 63, ch = h * 64 + c;
            float wv = w0[ch], av = a0[ch];
#pragma unroll 8
            for (int jr = 0; jr < 64; ++jr) { wv += TW[t * 64 + jr] * W2h[jr * 64 + c]; av += AL[t * 64 + jr] * A2h[jr * 64 + c]; }
            const float w = -softplusf(-wv) - 0.5f;
            const float decay = __expf(-__expf(w));
            const float a = 1.f / (1.f + __expf(-av));
            const float kraw = Kk[t * 64 + c];
            Wd[t * 64 + c] = decay;
            KK[t * 64 + c] = kraw * k_k[ch];
            Kk[t * 64 + c] = kraw * (1.f + (a - 1.f) * k_a[ch]);
            Bb[t * 64 + c] = a;
        }
        __syncthreads();
        for (int t = wave; t < n; t += 8) {
            const float x = KK[t * 64 + lane];
            const float nrm = fmaxf(sqrtf(wave_sum(x * x)), 1e-12f);
            const float kkn = x / nrm;
            KK[t * 64 + lane] = kkn; Bb[t * 64 + lane] = kkn * Bb[t * 64 + lane];
        }
        __syncthreads();
        for (int t = 0; t < n; ++t) {
            const f32x4 kk0 = *(LAS f32x4*)(KK + t * 64 + kq * 8), kk1 = *(LAS f32x4*)(KK + t * 64 + kq * 8 + 4);
            const f32x4 w0v = *(LAS f32x4*)(Wd + t * 64 + kq * 8), w1v = *(LAS f32x4*)(Wd + t * 64 + kq * 8 + 4);
            const f32x4 b0 = *(LAS f32x4*)(Bb + t * 64 + kq * 8), b1 = *(LAS f32x4*)(Bb + t * 64 + kq * 8 + 4);
            const f32x4 k0 = *(LAS f32x4*)(Kk + t * 64 + kq * 8), k1 = *(LAS f32x4*)(Kk + t * 64 + kq * 8 + 4);
            const f32x4 r0 = *(LAS f32x4*)(Rr + t * 64 + kq * 8), r1 = *(LAS f32x4*)(Rr + t * 64 + kq * 8 + 4);
            const float vv = Vv[t * 64 + v];
            float sa = 0.f;
#pragma unroll
            for (int e = 0; e < 4; ++e) { sa += s[e] * kk0[e]; sa += s[4 + e] * kk1[e]; }
            sa += __shfl_xor(sa, 1); sa += __shfl_xor(sa, 2); sa += __shfl_xor(sa, 4);
            sa = -sa;
            float y = 0.f;
#pragma unroll
            for (int e = 0; e < 4; ++e) {
                s[e] = s[e] * w0v[e] + sa * b0[e] + vv * k0[e];
                s[4 + e] = s[4 + e] * w1v[e] + sa * b1[e] + vv * k1[e];
                y += s[e] * r0[e]; y += s[4 + e] * r1[e];
            }
            y += __shfl_xor(y, 1); y += __shfl_xor(y, 2); y += __shfl_xor(y, 4);
            if (kq == 0) Yb[t * 64 + v] = y;
        }
        __syncthreads();
        for (int t = wave; t < n; t += 8) {
            const int ch = h * 64 + lane;
            const float y = Yb[t * 64 + lane];
            const float mean = wave_sum(y) * (1.f / 64.f);
            const float d = y - mean;
            const float var = wave_sum(d * d) * (1.f / 64.f);
            const float yn = d * rsqrtf(var + 64e-5f) * lnx_g[ch] + lnx_b[ch];
            const float bonus = wave_sum(Rr[t * 64 + lane] * Kk[t * 64 + lane] * r_k[ch]) * Vv[t * 64 + lane];
            const size_t oo = (row0 + c0 + t) * DM + 384 + ch;
            P.OG[oo] = f2bf((yn + bonus) * bf2f(P.Gb[oo]));
        }
        __syncthreads();
    }
    float* so = P.out + (sample ? O_ST_S : O_ST_P) + (((size_t)bb * 6 + h) * 64 + v) * 64 + kq * 8;
#pragma unroll
    for (int e = 0; e < 8; ++e) so[e] = s[e];
    __syncthreads();
}

__device__ __forceinline__ void p0_transpose_item(const float* W, const float* gain, int K, int N, bf16_t* WT, int row_off, LAS float* scr, int item, int lane) {
    const int nblk = N / 32, kb = item / nblk, nb = item % nblk, k0 = 64 * kb, n0 = 32 * nb;
#pragma unroll 8
    for (int i = 0; i < 32; ++i) { const int kk = 2 * i + (lane >> 5); const float gk = gain ? gain[k0 + kk] : 1.f; scr[kk * 33 + (lane & 31)] = W[(size_t)(k0 + kk) * N + n0 + (lane & 31)] * gk; }
    LDS_WAIT(); asm volatile("" ::: "memory");
    const int c = lane & 7;
#pragma unroll
    for (int j = 0; j < 4; ++j) { const int n = (lane >> 3) + 8 * j; const LAS float* s = scr + (8 * c) * 33 + n;
        u32x4 o; o[0] = cvtpk(s[0 * 33], s[1 * 33]); o[1] = cvtpk(s[2 * 33], s[3 * 33]); o[2] = cvtpk(s[4 * 33], s[5 * 33]); o[3] = cvtpk(s[6 * 33], s[7 * 33]);
        *(u32x4*)(WT + (size_t)(row_off + n0 + n) * K + k0 + 8 * c) = o; }
    LDS_WAIT(); asm volatile("" ::: "memory");
}
__device__ __forceinline__ void sincos_acc(float angf, float& c, float& s) {
    const double a = (double)angf;
    const double kq = __builtin_rint(a * 0.63661977236758134308);
    const double r = (a - kq * 1.57079632679489655800) - kq * 6.12323399573676603587e-17;
    const double r2 = r * r;
    double sp = -1.0 / 1307674368000.0; sp = sp * r2 + 1.0 / 6227020800.0; sp = sp * r2 - 1.0 / 39916800.0; sp = sp * r2 + 1.0 / 362880.0; sp = sp * r2 - 1.0 / 5040.0; sp = sp * r2 + 1.0 / 120.0; sp = sp * r2 - 1.0 / 6.0; sp = sp * r2 + 1.0; sp *= r;
    double cp = 1.0 / 87178291200.0; cp = cp * r2 - 1.0 / 479001600.0; cp = cp * r2 + 1.0 / 3628800.0; cp = cp * r2 - 1.0 / 40320.0; cp = cp * r2 + 1.0 / 720.0; cp = cp * r2 - 1.0 / 24.0; cp = cp * r2 + 0.5; cp = 1.0 - cp * r2;
    const int qd = ((int)kq) & 3;
    const double sv = (qd == 0) ? sp : (qd == 1) ? cp : (qd == 2) ? -sp : -cp;
    const double cv = (qd == 0) ? cp : (qd == 1) ? -sp : (qd == 2) ? -cp : sp;
    c = (float)cv; s = (float)sv;
}
__device__ __forceinline__ void p0_prologue(const Ptrs& P, LAS unsigned char* lds, int bid, int G, int tid) {
    const int lane = tid & 63, wave = tid >> 6;
    LAS float* scr = (LAS float*)(lds + wave * 16384);
    const int gw = bid * 8 + wave, NGW = G * 8;
    constexpr int I_IN = (DM / 64) * (IN_W / 32), I_MEM = (DM / 64) * (512 / 32), I_OUT = (DM / 64) * (DM / 32);
    for (int it = gw; it < I_IN + I_MEM + I_OUT; it += NGW) {
        int r = it;
        if (r < I_IN) { p0_transpose_item(P.in[10], P.in[9], DM, IN_W, P.WT, 0, scr, r, lane); continue; } r -= I_IN;
        if (r < I_MEM) { p0_transpose_item(P.in[22], P.in[21], DM, 512, P.WT, NPAD, scr, r, lane); continue; } r -= I_MEM;
        p0_transpose_item(P.in[23], nullptr, DM, DM, P.WOT, 0, scr, r, lane);
    }
    const int gt = bid * NTHR + tid, NGT = G * NTHR;
    for (int e = gt; e < (NPAD - IN_W) * DM / 8; e += NGT) *(u32x4*)(P.WT + (size_t)IN_W * DM + (size_t)e * 8) = (u32x4){0u, 0u, 0u, 0u};
    for (int m = gw; m < MROWS; m += NGW) {
        const float* xr = (m < MP) ? P.in[0] + (size_t)m * DM : (m < MTOK) ? P.in[1] + (size_t)(m - MP) * DM : P.in[8] + (size_t)(m - MTOK) * DM;
        f32x4 v[4]; float ss = 0.f;
#pragma unroll
        for (int j = 0; j < 4; ++j) { v[j] = *(const f32x4*)(xr + (size_t)(64 * j + lane) * 4); ss += (v[j][0] * v[j][0] + v[j][1] * v[j][1]) + (v[j][2] * v[j][2] + v[j][3] * v[j][3]); }
        ss = wave_sum(ss);
        if (lane == 0) P.RINV[m] = rsqrtf(ss * (1.f / DM) + 1e-6f);
#pragma unroll
        for (int j = 0; j < 4; ++j) { u32x2 w; w[0] = cvtpk(v[j][0], v[j][1]); w[1] = cvtpk(v[j][2], v[j][3]); *(u32x2*)(P.XB + (size_t)m * DM + (size_t)(64 * j + lane) * 4) = w; }
    }
    for (int e = gt; e < NPOS * 8; e += NGT) {
        const int pos = e >> 3, i = e & 7;
        const float invf[8] = {1.0f, 0.19392274f, 0.03760603f, 0.0072926646f, 0.0014142136f, 0.0002742482f, 5.3182957e-05f, 1.0313385e-05f};
        float fi = invf[0];
#pragma unroll
        for (int k = 1; k < 8; ++k) fi = (i == k) ? invf[k] : fi;
        const float ang = (float)pos * fi; float c, s; sincos_acc(ang, c, s);
        P.ROPE[pos * 16 + i] = c; P.ROPE[pos * 16 + 8 + i] = s;
    }
    for (int e = gt; e < MTOK; e += NGT) P.SS[e] = 0.f;
}

__device__ __forceinline__ void p3_combine(const Ptrs& P, int bid, int G, int tid) {
    const int gt = bid * NTHR + tid, NGT = G * NTHR;
    for (int e = gt; e < MP * 48; e += NGT) {
        const int row = e / 48, ch = e % 48, h = ch >> 3;
        const float l0 = P.LSE[((size_t)0 * MP + row) * 6 + h], l1 = P.LSE[((size_t)1 * MP + row) * 6 + h], l2 = P.LSE[((size_t)2 * MP + row) * 6 + h];
        const float mx = fmaxf(l0, fmaxf(l1, l2)); const float e0 = __expf(l0 - mx), e1 = __expf(l1 - mx), e2 = __expf(l2 - mx); const float inv = 1.f / (e0 + e1 + e2);
        const float w0 = e0 * inv, w1 = e1 * inv, w2 = e2 * inv;
        const u32x4 a = *(const u32x4*)(P.OAP + ((size_t)0 * MP + row) * ATT_W + ch * 8), b = *(const u32x4*)(P.OAP + ((size_t)1 * MP + row) * ATT_W + ch * 8), c = *(const u32x4*)(P.OAP + ((size_t)2 * MP + row) * ATT_W + ch * 8);
        const u32x4 gg = *(const u32x4*)(P.Gb + (size_t)row * DM + ch * 8);
        u32x4 o;
#pragma unroll
        for (int k = 0; k < 4; ++k) {
            const float lo = (w0 * bflo(a[k]) + w1 * bflo(b[k]) + w2 * bflo(c[k])) * bflo(gg[k]);
            const float hi = (w0 * bfhi(a[k]) + w1 * bfhi(b[k]) + w2 * bfhi(c[k])) * bfhi(gg[k]);
            o[k] = cvtpk(lo, hi);
        }
        *(u32x4*)(P.OG + (size_t)row * DM + ch * 8) = o;
    }
}

__device__ __forceinline__ void p5_norm(const Ptrs& P, int bid, int G, int tid) {
    const int lane = tid & 63, wave = tid >> 6, gw = bid * 8 + wave, NGW = G * 8;
    const float* gf = P.in[24];
    for (int m = gw; m < MTOK; m += NGW) {
        const float rs = rsqrtf(P.SS[m] * (1.f / DM) + 1e-6f);
        float* yr = P.out + O_Y + (size_t)m * DM;
#pragma unroll
        for (int j = 0; j < 4; ++j) { const size_t c = (size_t)(64 * j + lane) * 4; const f32x4 v = *(const f32x4*)(yr + c); const f32x4 gv = *(const f32x4*)(gf + c); *(f32x4*)(yr + c) = v * rs * gv; }
    }
}

__global__ void __launch_bounds__(NTHR, 2) fwd_kernel(Params prm) {
    extern __shared__ __attribute__((aligned(16))) unsigned char lds_raw[];
    LAS unsigned char* lds = (LAS unsigned char*)lds_raw;
    const int tid = threadIdx.x, bid = blockIdx.x, G = gridDim.x;
    Ptrs P;
#pragma unroll
    for (int i = 0; i < 25; ++i) P.in[i] = prm.in[i];
    P.out = prm.out; P.ws = prm.ws;
    P.RINV = (float*)(prm.ws + WS_RINV); P.SS = (float*)(prm.ws + WS_SS); P.ROPE = (float*)(prm.ws + WS_ROPE); P.ZB = (float*)(prm.ws + WS_ZB); P.LSE = (float*)(prm.ws + WS_LSE);
    P.WT = (bf16_t*)(prm.ws + WS_WT); P.WOT = (bf16_t*)(prm.ws + WS_WOT); P.XB = (bf16_t*)(prm.ws + WS_XB); P.Qb = (bf16_t*)(prm.ws + WS_Q); P.Kb = (bf16_t*)(prm.ws + WS_K); P.Vb = (bf16_t*)(prm.ws + WS_V);
    P.QMb = (bf16_t*)(prm.ws + WS_QM); P.Gb = (bf16_t*)(prm.ws + WS_G); P.MKB = (bf16_t*)(prm.ws + WS_MKB); P.MVB = (bf16_t*)(prm.ws + WS_MVB); P.OAP = (bf16_t*)(prm.ws + WS_OAP); P.OG = (bf16_t*)(prm.ws + WS_OG);
    const int lo = prm.ph_lo, hi = prm.ph_hi;
#define IN_PH(k) (lo <= (k) && (k) < hi)
#define SEAM(k) do { if (IN_PH(k) && IN_PH((k) + 1)) { cg::this_grid().sync(); } } while (0)

    if (IN_PH(0)) { p0_prologue(P, lds, bid, G, tid); }
    SEAM(0);
    if (IN_PH(1)) {
        pg8::Gemm g{P.XB, P.WT, MROWS, NWT, DM}; Sched1 S; S.init(G, bid);
        Epi1 E{P.RINV, P.ROPE, P.Qb, P.Kb, P.Vb, P.QMb, P.Gb, P.MKB, P.MVB, P.ZB, P.out};
        pg8::gemm_phase<Epi1, Sched1, true, true>(lds, g, S, E);
    }
    SEAM(1);
    if (IN_PH(2)) {
        constexpr int N0 = N_SCAN_P, N1 = N0 + N_SCAN_S, N2 = N1 + N_DIL_UNITS, N3 = N2 + N_MEMA_UNITS, N4 = N3 + N_SDIL_ITEMS, N5 = N4 + N_SMEM_ITEMS;
#define ITEM_LOOP(LO, HI, CALL) do { int it = (LO) + ((bid - (LO)) % G + G) % G; for (; it < (HI); it += G) { const int li = it - (LO); CALL; } } while (0)
        ITEM_LOOP(0, N0, scan_item(P, lds, false, li / 6, li % 6, tid));
        ITEM_LOOP(N0, N1, scan_item(P, lds, true, li / 6, li % 6, tid));
        ITEM_LOOP(N1, N2, dil_unit(P, lds, li, tid));
        ITEM_LOOP(N2, N3, mem_unit(P, lds, li, tid));
        ITEM_LOOP(N3, N4, sdil_item(P, lds, li, tid));
        ITEM_LOOP(N4, N5, smem_item(P, lds, li, tid));
#undef ITEM_LOOP
    }
    SEAM(2);
    if (IN_PH(3)) { p3_combine(P, bid, G, tid); }
    SEAM(3);
    if (IN_PH(4)) {
        pg8::Gemm g{P.OG, P.WOT, MTOK, DM, DM}; pg8::StaticOrder S; S.init(MTOK, DM, G, bid);
        Epi2 E{P.in[0], P.in[1], P.out + O_Y, P.SS};
        pg8::gemm_phase<Epi2, pg8::StaticOrder, true, true>(lds, g, S, E);
    }
    SEAM(4);
    if (IN_PH(5)) { p5_norm(P, bid, G, tid); }
}

constexpr int N_PHASES = 6;
#ifndef MK_ONE_LAUNCH
#define MK_ONE_LAUNCH 1
#endif
extern "C" void kernel_launch(void* const* d_in, const int* in_sizes, int n_in, void* d_out, int out_size, void* d_ws, size_t ws_size, hipStream_t stream) {
    static int grid = 0;
    if (grid == 0) {
        if (n_in != 25 || out_size != (int)O_END || ws_size < WS_END) { fprintf(stderr, "kernel_launch: unexpected shapes (n_in %d, out %d, ws %zu < %zu)\n", n_in, out_size, ws_size, (size_t)WS_END); grid = -1; return; }
        int dev = 0, cus = 0, per_cu = 0;
        (void)hipGetDevice(&dev); (void)hipDeviceGetAttribute(&cus, hipDeviceAttributeMultiprocessorCount, dev);
        if (hipFuncSetAttribute((const void*)fwd_kernel, hipFuncAttributeMaxDynamicSharedMemorySize, LDS_BYTES) != hipSuccess) { fprintf(stderr, "kernel_launch: hipFuncSetAttribute failed\n"); grid = -1; return; }
        if (hipOccupancyMaxActiveBlocksPerMultiprocessor(&per_cu, (const void*)fwd_kernel, NTHR, LDS_BYTES) != hipSuccess || per_cu < 1) { fprintf(stderr, "kernel_launch: occupancy query says %d blocks per CU\n", per_cu); (void)hipGetLastError(); per_cu = 1; }
        grid = cus;
    }
    if (grid < 0) return;
    Params p{};
    for (int i = 0; i < 25; ++i) p.in[i] = (const float*)d_in[i];
    p.out = (float*)d_out; p.ws = (unsigned char*)d_ws;
#if MK_ONE_LAUNCH
    p.ph_lo = 0; p.ph_hi = N_PHASES; p.coop = 1;
    void* args[] = {&p};
    hipError_t e = hipLaunchCooperativeKernel((const void*)fwd_kernel, dim3(grid), dim3(NTHR), args, LDS_BYTES, stream);
    if (e != hipSuccess) fprintf(stderr, "cooperative launch failed: %s (grid %d)\n", hipGetErrorString(e), grid);
#else
    for (int ph = 0; ph < N_PHASES; ++ph) {
        p.ph_lo = ph; p.ph_hi = ph + 1; p.coop = 0;
        hipLaunchKernelGGL(fwd_kernel, dim3(grid), dim3(NTHR), LDS_BYTES, stream, p);
    }
#endif
}
```

```cpp
#include <hip/hip_runtime.h>
#include <hip/hip_cooperative_groups.h>
#include <cstdio>
#include <cstdint>
namespace cg = cooperative_groups;

#define LAS __attribute__((address_space(3)))
typedef unsigned short bf16_t;
typedef short bf16x8 __attribute__((ext_vector_type(8)));
typedef short s16x4 __attribute__((ext_vector_type(4)));
typedef float f32x4 __attribute__((ext_vector_type(4)));
typedef float f32x2 __attribute__((ext_vector_type(2)));
typedef float f32x16 __attribute__((ext_vector_type(16)));
typedef unsigned u32x4 __attribute__((ext_vector_type(4)));
typedef unsigned u32x2 __attribute__((ext_vector_type(2)));
typedef __bf16 bf16x2_t __attribute__((ext_vector_type(2)));

constexpr int DM = 1024, SEQ = 8192, NB = 2, DB = 32, DT = 8;
constexpr int MP = NB * SEQ;
constexpr int MS = DB * DT;
constexpr int MTOK = MP + MS;
constexpr int NMEM = 256, MMEM = NB * NMEM;
constexpr int MROWS = MTOK + MMEM;
constexpr int ATT_W = 384, RW = 384, MEM_W = 256, SHIFT_W = 1280, IN_W = 3712;
constexpr int NPAD = 3840;
constexpr int NWT = NPAD + 512;
constexpr int WINP = 2048;
constexpr int C_Q = 0, C_K = 384, C_V = 768, C_Z = 1152, C_QM = 2432, C_G = 2688;
constexpr size_t O_Y = 0, O_WK_P = 17039360, O_WV_P = 18612224, O_ST_P = 20185088, O_SH_P = 20234240, O_MK_P = 20236800, O_MV_P = 20367872,
                 O_WK_S = 20498944, O_WV_S = 20597248, O_ST_S = 20695552, O_SH_S = 21481984, O_END = 21522944;
constexpr size_t al256(size_t x) { return (x + 255) & ~(size_t)255; }
constexpr size_t WS_CTL = 0;
constexpr size_t WS_RINV = 1u << 20;
constexpr size_t WS_SS = al256(WS_RINV + (size_t)MROWS * 4);
constexpr size_t WS_ROPE = al256(WS_SS + (size_t)MTOK * 4);
constexpr int NPOS = 8200;
constexpr size_t WS_WT = al256(WS_ROPE + (size_t)NPOS * 16 * 4);
constexpr size_t WS_WOT = al256(WS_WT + (size_t)NWT * DM * 2);
constexpr size_t WS_XB = al256(WS_WOT + (size_t)DM * DM * 2);
constexpr size_t WS_Q = al256(WS_XB + (size_t)MROWS * DM * 2);
constexpr size_t WS_K = al256(WS_Q + (size_t)MTOK * ATT_W * 2);
constexpr size_t WS_V = al256(WS_K + (size_t)MTOK * ATT_W * 2);
constexpr size_t WS_ZB = al256(WS_V + (size_t)MTOK * ATT_W * 2);
constexpr size_t WS_QM = al256(WS_ZB + (size_t)MTOK * SHIFT_W * 4);
constexpr size_t WS_G = al256(WS_QM + (size_t)MTOK * MEM_W * 2);
constexpr size_t WS_MKB = al256(WS_G + (size_t)MTOK * DM * 2);
constexpr size_t WS_MVB = al256(WS_MKB + (size_t)MMEM * MEM_W * 2);
constexpr size_t WS_OAP = al256(WS_MVB + (size_t)MMEM * MEM_W * 2);
constexpr size_t WS_LSE = al256(WS_OAP + (size_t)3 * MP * ATT_W * 2);
constexpr size_t WS_OG = al256(WS_LSE + (size_t)3 * MP * 6 * 4);
constexpr size_t WS_END = al256(WS_OG + (size_t)MTOK * DM * 2);

constexpr int LDS_BYTES = 147456;
constexpr int NTHR = 512;

struct Params {
    const float* in[25];
    float* out;
    unsigned char* ws;
    int ph_lo, ph_hi, coop, pad;
};

__device__ __forceinline__ unsigned cvtpk(float lo, float hi) { f32x2 v = {lo, hi}; bf16x2_t b = __builtin_convertvector(v, bf16x2_t); return __builtin_bit_cast(unsigned, b); }
__device__ __forceinline__ bf16_t f2bf(float f) { return (bf16_t)(cvtpk(f, 0.f) & 0xffffu); }
__device__ __forceinline__ float bf2f(bf16_t b) { return __builtin_bit_cast(float, (unsigned)b << 16); }
__device__ __forceinline__ float bflo(unsigned w) { return __builtin_bit_cast(float, w << 16); }
__device__ __forceinline__ float bfhi(unsigned w) { return __builtin_bit_cast(float, w & 0xffff0000u); }
__device__ __forceinline__ float wave_sum(float v) {
#pragma unroll
    for (int o = 1; o < 64; o <<= 1) v += __shfl_xor(v, o);
    return v;
}
__device__ __forceinline__ float wave_max(float v) {
#pragma unroll
    for (int o = 1; o < 64; o <<= 1) v = fmaxf(v, __shfl_xor(v, o));
    return v;
}
template <int CTRL> __device__ __forceinline__ float dpp_f(float v) { return __builtin_bit_cast(float, __builtin_amdgcn_update_dpp(0, __builtin_bit_cast(int, v), CTRL, 0xf, 0xf, true)); }
__device__ __forceinline__ float sum8(float v) { v += dpp_f<0xB1>(v); v += dpp_f<0x4E>(v); v += dpp_f<0x141>(v); return v; }
#define LDS_WAIT() asm volatile("s_waitcnt lgkmcnt(0)" ::: "memory")

namespace pg8 {
constexpr int BM = 256, BK = 64, HALF = 128, HTB = HALF * BK * 2, STAGE_BYTES = 8 * HTB, NXCD = 8, WGM = 8;
__host__ __device__ __forceinline__ int lds_byte(int r, int c) { const int st = (r >> 4) * 2 + (c >> 5), rr = r & 15, cc = c & 31, ob = rr * 64 + cc * 2; return st * 1024 + (ob ^ (((ob >> 9) & 1) << 5)); }
__host__ __device__ __forceinline__ void stage_rc(int b, int& R, int& C) { const int st = b / 1024, sb = b % 1024, swz = sb ^ (((sb >> 9) & 1) << 5); R = (st >> 1) * 16 + swz / 64; C = (st & 1) * 32 + (swz % 64) / 2; }
__host__ __device__ __forceinline__ int perm32(int rho) { const int n = rho >> 4, i = rho & 15; return 8 * (i >> 2) + 4 * n + (i & 3); }
struct Unit { int pm, pn; };
struct Gemm { const bf16_t* A; const bf16_t* Bt; int M, N, K; };
struct StaticOrder {
    int nM, nN, nwg, G, c;
    __host__ __device__ void init(int M, int N, int G_, int c_) { nM = M / BM; nN = N / BM; nwg = nM * nN; G = G_; c = c_; }
    __host__ __device__ bool next(int i, Unit& u) const {
        const long L = (long)i * G + c; if (L >= nwg) return false;
        int wgid = (int)L; { const int q = nwg / NXCD, r = nwg % NXCD, xcd = wgid % NXCD, off = wgid / NXCD; wgid = (xcd < r ? xcd * (q + 1) : r * (q + 1) + (xcd - r) * q) + off; }
        const int nig = WGM * nN, gid = wgid / nig, fm = gid * WGM, gsz = (nM - fm) < WGM ? (nM - fm) : WGM;
        u.pm = fm + ((wgid % nig) % gsz); u.pn = (wgid % nig) / gsz; return true;
    }
    __device__ __forceinline__ void a_ready(const Unit&) const {}
    __device__ __forceinline__ void done(const Unit&) const {}
};

template <class Epi, class Sched, bool ALIGN_EPI = false, bool SP2 = false>
__device__ __forceinline__ void gemm_phase(LAS unsigned char* lds, const Gemm g, const Sched& S, const Epi& E) {
    const int tid = threadIdx.x, wid = __builtin_amdgcn_readfirstlane(tid >> 6), lane = tid & 63, wr = wid >> 2, wc = wid & 3, fr = lane & 15, fq = lane >> 4;
    const int K = g.K, nt = K / BK;
    unsigned voffA[2], voffB[2];
#pragma unroll
    for (int i = 0; i < 2; ++i) { int R, C; stage_rc(tid * 16 + i * 8192, R, C); const int Rb = Epi::PERM ? ((R & ~31) + perm32(R & 31)) : R;
        voffA[i] = (unsigned)(R * K + C) * 2u; voffB[i] = (unsigned)(Rb * K + C) * 2u; }
    const size_t kstep = (size_t)(BK * 2);
    const size_t hstep = (size_t)HALF * K * 2;
    const size_t tstep = 2 * hstep;
    const unsigned ldsw = (unsigned)wid * 1024u;
    const int aoff = lds_byte(wr * 64 + fr, fq * 8), boff = lds_byte(wc * 32 + fr, fq * 8);
#define PG8_SA(b, h) (((b) * 2 + (h)) * HTB)
#define PG8_SB(b, h) ((4 + (b) * 2 + (h)) * HTB)
#define PG8_STAGE(bufoff, gbase, voff) do { _Pragma("unroll") for (int _i = 0; _i < 2; ++_i) \
        __builtin_amdgcn_global_load_lds((const unsigned*)((const char*)(gbase) + (voff)[_i]), (LAS unsigned*)(lds + (bufoff) + ldsw + _i * 8192), 16, 0, 0); } while (0)
#define PG8_LDA(dst, b, h) do { _Pragma("unroll") for (int m = 0; m < 4; ++m) _Pragma("unroll") for (int k = 0; k < 2; ++k) dst[m][k] = *(const LAS bf16x8*)(lds + PG8_SA(b, h) + aoff + m * 2048 + k * 1024); } while (0)
#define PG8_LDB(dst, b, h) do { _Pragma("unroll") for (int n = 0; n < 2; ++n) _Pragma("unroll") for (int k = 0; k < 2; ++k) dst[n][k] = *(const LAS bf16x8*)(lds + PG8_SB(b, h) + boff + n * 2048 + k * 1024); } while (0)
#define PG8_MMA(ai, bj, At, Bt) do { __builtin_amdgcn_s_setprio(1); _Pragma("unroll") for (int m = 0; m < 4; ++m) _Pragma("unroll") for (int n = 0; n < 2; ++n) _Pragma("unroll") for (int k = 0; k < 2; ++k) \
        acc[ai][bj][m][n] = __builtin_amdgcn_mfma_f32_16x16x32_bf16(Bt[n][k], At[m][k], acc[ai][bj][m][n], 0, 0, 0); __builtin_amdgcn_s_setprio(0); } while (0)
#define PG8_WAIT_V(n) asm volatile("s_waitcnt vmcnt(" #n ")" ::: "memory")
#define PG8_WAIT_L(n) asm volatile("s_waitcnt lgkmcnt(" #n ")" ::: "memory")
#define PG8_BAR __builtin_amdgcn_s_barrier()
#define PG8_SCHED __builtin_amdgcn_sched_barrier(0)
    Unit cur, nxt; int ui = 0;
    if (!S.next(0, cur)) return;
    f32x4 acc[2][2][4][2];
#pragma unroll
    for (int a = 0; a < 2; ++a)
#pragma unroll
        for (int b = 0; b < 2; ++b)
#pragma unroll
            for (int m = 0; m < 4; ++m)
#pragma unroll
                for (int n = 0; n < 2; ++n) acc[a][b][m][n] = (f32x4){0.f, 0.f, 0.f, 0.f};
    bf16x8 At[4][2], B0[2][2], B1[2][2];
    const char* cA = (const char*)g.A + (size_t)cur.pm * tstep; const char* cB = (const char*)g.Bt + (size_t)cur.pn * tstep;
    S.a_ready(cur);
    if constexpr (SP2) {
        PG8_STAGE(PG8_SB(0, 0), cB, voffB); PG8_STAGE(PG8_SB(0, 1), cB + hstep, voffB); PG8_STAGE(PG8_SA(0, 0), cA, voffA); PG8_STAGE(PG8_SA(0, 1), cA + hstep, voffA);
        if (wr == 1) PG8_BAR;
        PG8_WAIT_V(2); PG8_BAR;
        PG8_STAGE(PG8_SB(1, 0), cB + kstep, voffB); PG8_STAGE(PG8_SA(1, 0), cA + kstep, voffA); PG8_STAGE(PG8_SB(1, 1), cB + hstep + kstep, voffB);
        PG8_WAIT_V(6); PG8_BAR;
    } else {
        PG8_STAGE(PG8_SB(0, 0), cB, voffB); PG8_STAGE(PG8_SA(0, 0), cA, voffA); PG8_STAGE(PG8_SB(0, 1), cB + hstep, voffB); PG8_STAGE(PG8_SA(0, 1), cA + hstep, voffA);
        if (wr == 1) PG8_BAR;
        PG8_WAIT_V(4); PG8_BAR;
        PG8_STAGE(PG8_SB(1, 0), cB + kstep, voffB); PG8_STAGE(PG8_SA(1, 0), cA + kstep, voffA); PG8_STAGE(PG8_SB(1, 1), cB + hstep + kstep, voffB);
        PG8_WAIT_V(6); PG8_BAR;
    }
    for (;;) {
        const bool has_next = S.next(ui + 1, nxt);
        const char* nA = has_next ? (const char*)g.A + (size_t)nxt.pm * tstep : cA; const char* nB = has_next ? (const char*)g.Bt + (size_t)nxt.pn * tstep : cB;
        for (int t = 0; t < nt; t += 2) {
            const bool last = (t == nt - 2);
            const char* a1 = cA + (size_t)(t + 1) * kstep;
            const char* a2 = last ? nA : cA + (size_t)(t + 2) * kstep; const char* b2 = last ? nB : cB + (size_t)(t + 2) * kstep;
            const char* a3 = a2 + kstep; const char* b3 = b2 + kstep;
            if (last && has_next) S.a_ready(nxt);
            if constexpr (SP2) {
            PG8_LDB(B0, 0, 0); PG8_LDB(B1, 0, 1); PG8_SCHED; PG8_LDA(At, 0, 0); PG8_STAGE(PG8_SA(1, 1), a1 + hstep, voffA);
            PG8_WAIT_V(8); PG8_WAIT_L(0); PG8_BAR; PG8_MMA(0, 0, At, B0); PG8_MMA(0, 1, At, B1); PG8_BAR; PG8_SCHED;
            PG8_LDA(At, 0, 1); PG8_STAGE(PG8_SB(0, 0), b2, voffB); PG8_STAGE(PG8_SB(0, 1), b2 + hstep, voffB); PG8_STAGE(PG8_SA(0, 0), a2, voffA);
            PG8_WAIT_V(8); PG8_WAIT_L(0); PG8_BAR; PG8_MMA(1, 0, At, B0); PG8_MMA(1, 1, At, B1); PG8_BAR; PG8_SCHED;
            PG8_LDB(B0, 1, 0); PG8_LDB(B1, 1, 1); PG8_SCHED; PG8_LDA(At, 1, 0); PG8_STAGE(PG8_SA(0, 1), a2 + hstep, voffA);
            PG8_WAIT_V(8); PG8_WAIT_L(0); PG8_BAR; PG8_MMA(0, 0, At, B0); PG8_MMA(0, 1, At, B1); PG8_BAR; PG8_SCHED;
            PG8_LDA(At, 1, 1); PG8_STAGE(PG8_SB(1, 0), b3, voffB); PG8_STAGE(PG8_SB(1, 1), b3 + hstep, voffB); PG8_STAGE(PG8_SA(1, 0), a3, voffA);
            PG8_WAIT_V(8); PG8_WAIT_L(0); PG8_BAR; PG8_MMA(1, 0, At, B0); PG8_MMA(1, 1, At, B1); PG8_BAR; PG8_SCHED;
            } else {
            PG8_LDB(B0, 0, 0); PG8_SCHED; PG8_LDA(At, 0, 0); PG8_STAGE(PG8_SA(1, 1), a1 + hstep, voffA);
            PG8_WAIT_L(8); PG8_BAR; PG8_WAIT_L(0); PG8_MMA(0, 0, At, B0); PG8_BAR; PG8_SCHED;
            PG8_LDB(B1, 0, 1); PG8_STAGE(PG8_SB(0, 0), b2, voffB);
            PG8_BAR; PG8_WAIT_L(0); PG8_MMA(0, 1, At, B1); PG8_BAR;
            PG8_LDA(At, 0, 1); PG8_STAGE(PG8_SA(0, 0), a2, voffA);
            PG8_BAR; PG8_WAIT_L(0); PG8_MMA(1, 0, At, B0); PG8_BAR; PG8_SCHED;
            PG8_STAGE(PG8_SB(0, 1), b2 + hstep, voffB);
            PG8_WAIT_V(6); PG8_BAR; PG8_MMA(1, 1, At, B1); PG8_BAR;
            PG8_LDB(B0, 1, 0); PG8_SCHED; PG8_LDA(At, 1, 0); PG8_STAGE(PG8_SA(0, 1), a2 + hstep, voffA);
            PG8_WAIT_L(8); PG8_BAR; PG8_WAIT_L(0); PG8_MMA(0, 0, At, B0); PG8_BAR; PG8_SCHED;
            PG8_LDB(B1, 1, 1); PG8_STAGE(PG8_SB(1, 0), b3, voffB);
            PG8_BAR; PG8_WAIT_L(0); PG8_MMA(0, 1, At, B1); PG8_BAR;
            PG8_LDA(At, 1, 1); PG8_STAGE(PG8_SA(1, 0), a3, voffA);
            PG8_BAR; PG8_WAIT_L(0); PG8_MMA(1, 0, At, B0); PG8_BAR; PG8_SCHED;
            PG8_STAGE(PG8_SB(1, 1), b3 + hstep, voffB);
            PG8_WAIT_V(6); PG8_BAR; PG8_MMA(1, 1, At, B1); PG8_BAR;
            }
        }
        if constexpr (ALIGN_EPI) { if (wr == 0) PG8_BAR; }
        if constexpr (!Epi::AFTER_DRAIN) { E(acc, cur, wr, wc, fr, fq); S.done(cur); }
        if (!has_next) break;
#pragma unroll
        for (int a = 0; a < 2; ++a)
#pragma unroll
            for (int b = 0; b < 2; ++b)
#pragma unroll
                for (int m = 0; m < 4; ++m)
#pragma unroll
                    for (int n = 0; n < 2; ++n) acc[a][b][m][n] = (f32x4){0.f, 0.f, 0.f, 0.f};
        cur = nxt; cA = nA; cB = nB; ++ui;
        if constexpr (ALIGN_EPI) { if (wr == 1) PG8_BAR; }
    }
    PG8_WAIT_V(0);
    if constexpr (!ALIGN_EPI) { if (wr == 0) PG8_BAR; }
    PG8_BAR;
    if constexpr (Epi::AFTER_DRAIN) { E.fused(acc, cur, wr, wc, fr, fq, lds, wid, lane); S.done(cur); }
#undef PG8_SA
#undef PG8_SB
#undef PG8_STAGE
#undef PG8_LDA
#undef PG8_LDB
#undef PG8_MMA
#undef PG8_WAIT_V
#undef PG8_WAIT_L
#undef PG8_BAR
#undef PG8_SCHED
}
}

constexpr int G1_NM = MTOK / 256, G1_NN = NPAD / 256, G1_MAIN = G1_NM * G1_NN, G1_UNITS = G1_MAIN + 4;
struct Sched1 {
    pg8::StaticOrder so;
    __device__ void init(int G, int c) { so.init(MTOK, NPAD, G, c); }
    __device__ bool next(int i, pg8::Unit& u) const {
        const long L = (long)i * so.G + so.c;
        if (L >= G1_UNITS) return false;
        if (L >= G1_MAIN) { const int e = (int)L - G1_MAIN; u.pm = G1_NM + (e >> 1); u.pn = G1_NN + (e & 1); return true; }
        return so.next(i, u);
    }
    __device__ __forceinline__ void a_ready(const pg8::Unit&) const {}
    __device__ __forceinline__ void done(const pg8::Unit&) const {}
};

struct Epi1 {
    static constexpr bool PERM = true, AFTER_DRAIN = false;
    const float* rinv; const float* rope; bf16_t *Qb, *Kb, *Vb, *QMb, *Gb, *MKB, *MVB; float* ZB; float* out;
    __device__ __forceinline__ void operator()(const f32x4 (&acc)[2][2][4][2], const pg8::Unit& u, int wr, int wc, int fr, int fq) const {
        const bool memu = u.pm >= G1_NM;
#pragma unroll
        for (int ai = 0; ai < 2; ++ai)
#pragma unroll
            for (int m = 0; m < 4; ++m) {
                const int row = u.pm * 256 + ai * 128 + wr * 64 + m * 16 + fr;
                const float rs = rinv[row];
#pragma unroll
                for (int bj = 0; bj < 2; ++bj) {
                    const int c0 = u.pn * 256 + bj * 128 + wc * 32 + 8 * fq;
                    float v[8];
#pragma unroll
                    for (int e = 0; e < 4; ++e) { v[e] = acc[ai][bj][m][0][e] * rs; v[4 + e] = acc[ai][bj][m][1][e] * rs; }
                    if (memu) {
                        const int mrow = row - MTOK, mc = c0 - NPAD;
                        float* of = out + (mc < 256 ? O_MK_P : O_MV_P) + (size_t)mrow * 256 + (mc & 255);
                        *(f32x4*)of = (f32x4){v[0], v[1], v[2], v[3]}; *(f32x4*)(of + 4) = (f32x4){v[4], v[5], v[6], v[7]};
                        bf16_t* ob = (mc < 256 ? MKB : MVB) + (size_t)mrow * 256 + (mc & 255);
                        *(u32x4*)ob = (u32x4){cvtpk(v[0], v[1]), cvtpk(v[2], v[3]), cvtpk(v[4], v[5]), cvtpk(v[6], v[7])};
                        continue;
                    }
                    const int cb = c0 >> 7;
                    const bool samp = row >= MP;
                    const int srow = row - MP;
                    if (cb < 6) {
                        if ((wc & 1) == 0) {
                            float pr[8];
#pragma unroll
                            for (int e = 0; e < 8; ++e) pr[e] = __shfl_xor(v[e], 16);
                            if (fq < 2) {
                                const int pos = samp ? (SEQ + (srow & 7)) : (row & (SEQ - 1));
                                const f32x4 c0v = *(const f32x4*)(rope + (size_t)pos * 16), c1v = *(const f32x4*)(rope + (size_t)pos * 16 + 4);
                                const f32x4 s0v = *(const f32x4*)(rope + (size_t)pos * 16 + 8), s1v = *(const f32x4*)(rope + (size_t)pos * 16 + 12);
                                const float cs[8] = {c0v[0], c0v[1], c0v[2], c0v[3], c1v[0], c1v[1], c1v[2], c1v[3]};
                                const float sn[8] = {s0v[0], s0v[1], s0v[2], s0v[3], s1v[0], s1v[1], s1v[2], s1v[3]};
                                const float sg = (fq == 0) ? -1.f : 1.f;
#pragma unroll
                                for (int e = 0; e < 8; ++e) v[e] = v[e] * cs[e] + sg * pr[e] * sn[e];
                            }
                        }
                        if (cb < 3) {
#pragma unroll
                            for (int e = 0; e < 8; ++e) v[e] *= 0.125f;
                            *(u32x4*)(Qb + (size_t)row * ATT_W + c0) = (u32x4){cvtpk(v[0], v[1]), cvtpk(v[2], v[3]), cvtpk(v[4], v[5]), cvtpk(v[6], v[7])};
                        } else {
                            const int cc = c0 - C_K;
                            *(u32x4*)(Kb + (size_t)row * ATT_W + cc) = (u32x4){cvtpk(v[0], v[1]), cvtpk(v[2], v[3]), cvtpk(v[4], v[5]), cvtpk(v[6], v[7])};
                            float* of = nullptr;
                            if (samp) of = out + O_WK_S + (size_t)srow * ATT_W + cc;
                            else { const int t = row & (SEQ - 1); if (t >= SEQ - WINP) of = out + O_WK_P + ((size_t)(row >> 13) * WINP + (t - (SEQ - WINP))) * ATT_W + cc; }
                            if (of) { *(f32x4*)of = (f32x4){v[0], v[1], v[2], v[3]}; *(f32x4*)(of + 4) = (f32x4){v[4], v[5], v[6], v[7]}; }
                        }
                    } else if (cb < 9) {
                        const int cc = c0 - C_V;
                        *(u32x4*)(Vb + (size_t)row * ATT_W + cc) = (u32x4){cvtpk(v[0], v[1]), cvtpk(v[2], v[3]), cvtpk(v[4], v[5]), cvtpk(v[6], v[7])};
                        float* of = nullptr;
                        if (samp) of = out + O_WV_S + (size_t)srow * ATT_W + cc;
                        else { const int t = row & (SEQ - 1); if (t >= SEQ - WINP) of = out + O_WV_P + ((size_t)(row >> 13) * WINP + (t - (SEQ - WINP))) * ATT_W + cc; }
                        if (of) { *(f32x4*)of = (f32x4){v[0], v[1], v[2], v[3]}; *(f32x4*)(of + 4) = (f32x4){v[4], v[5], v[6], v[7]}; }
                    } else if (cb < 19) {
                        const int cc = c0 - C_Z;
                        float* zf = ZB + (size_t)row * SHIFT_W + cc;
                        *(f32x4*)zf = (f32x4){v[0], v[1], v[2], v[3]}; *(f32x4*)(zf + 4) = (f32x4){v[4], v[5], v[6], v[7]};
                        float* of = nullptr;
                        if (samp) { if ((srow & 7) == 7) of = out + O_SH_S + (size_t)(srow >> 3) * SHIFT_W + cc; }
                        else if ((row & (SEQ - 1)) == SEQ - 1) of = out + O_SH_P + (size_t)(row >> 13) * SHIFT_W + cc;
                        if (of) { *(f32x4*)of = (f32x4){v[0], v[1], v[2], v[3]}; *(f32x4*)(of + 4) = (f32x4){v[4], v[5], v[6], v[7]}; }
                    } else if (cb < 21) {
                        const int cc = c0 - C_QM;
#pragma unroll
                        for (int e = 0; e < 8; ++e) v[e] *= 0.125f;
                        *(u32x4*)(QMb + (size_t)row * MEM_W + cc) = (u32x4){cvtpk(v[0], v[1]), cvtpk(v[2], v[3]), cvtpk(v[4], v[5]), cvtpk(v[6], v[7])};
                    } else if (cb < 29) {
                        const int cc = c0 - C_G;
#pragma unroll
                        for (int e = 0; e < 8; ++e) v[e] = v[e] / (1.f + __expf(-v[e]));
                        *(u32x4*)(Gb + (size_t)row * DM + cc) = (u32x4){cvtpk(v[0], v[1]), cvtpk(v[2], v[3]), cvtpk(v[4], v[5]), cvtpk(v[6], v[7])};
                    }
                }
            }
    }
};

struct Epi2 {
    static constexpr bool PERM = false, AFTER_DRAIN = false;
    const float* xp; const float* xs; float* Y; float* SS;
    __device__ __forceinline__ void operator()(const f32x4 (&acc)[2][2][4][2], const pg8::Unit& u, int wr, int wc, int fr, int fq) const {
#pragma unroll
        for (int ai = 0; ai < 2; ++ai)
#pragma unroll
            for (int m = 0; m < 4; ++m) {
                const int row = u.pm * 256 + ai * 128 + wr * 64 + m * 16 + fr;
                const float* xr = (row < MP) ? xp + (size_t)row * DM : xs + (size_t)(row - MP) * DM;
                float ss = 0.f;
#pragma unroll
                for (int bj = 0; bj < 2; ++bj)
#pragma unroll
                    for (int n = 0; n < 2; ++n) {
                        const int c = u.pn * 256 + bj * 128 + wc * 32 + n * 16 + 4 * fq;
                        const f32x4 xv = *(const f32x4*)(xr + c);
                        const f32x4 o = xv + acc[ai][bj][m][n];
                        ss += (o[0] * o[0] + o[1] * o[1]) + (o[2] * o[2] + o[3] * o[3]);
                        *(f32x4*)(Y + (size_t)row * DM + c) = o;
                    }
                ss += __shfl_xor(ss, 16); ss += __shfl_xor(ss, 32);
                if (fq == 0) atomicAdd(SS + row, ss);
            }
    }
};

constexpr int KS = 144, VS = 144;
constexpr float L2E = 1.4426950408889634f;
__device__ __forceinline__ int crow(int r, int hi) { return (r & 3) + 8 * (r >> 2) + 4 * hi; }
typedef short v4i16_t __attribute__((ext_vector_type(4)));
__device__ __forceinline__ s16x4 vtr(LAS const unsigned char* p) { return __builtin_bit_cast(s16x4, __builtin_amdgcn_ds_read_tr16_b64_v4i16((LAS v4i16_t*)p)); }

template <int NTG, int NG, bool BAND>
__device__ __forceinline__ void strip_attn(const bf16x8 (&qf)[4], LAS const unsigned char* Kl, LAS const unsigned char* Vl, int krow0, int lane, int kmin,
                                           f32x16 (&o)[2], float& m_out, float& l_out) {
    const int q = lane & 31, hi = lane >> 5;
    float m_run = -INFINITY, l_run = 0.f;
#pragma unroll
    for (int r = 0; r < 16; ++r) { o[0][r] = 0.f; o[1][r] = 0.f; }
#pragma unroll
    for (int g = 0; g < NG; ++g) {
        f32x16 S[NTG];
#pragma unroll
        for (int t = 0; t < NTG; ++t) {
#pragma unroll
            for (int r = 0; r < 16; ++r) S[t][r] = 0.f;
            LAS const unsigned char* kp = Kl + (size_t)(krow0 + (g * NTG + t) * 32 + q) * KS + hi * 16;
#pragma unroll
            for (int d0 = 0; d0 < 4; ++d0) {
                const bf16x8 kf = *(LAS const bf16x8*)(kp + d0 * 32);
                S[t] = __builtin_amdgcn_mfma_f32_32x32x16_bf16(kf, qf[d0], S[t], 0, 0, 0);
            }
        }
        float mx = -INFINITY;
#pragma unroll
        for (int t = 0; t < NTG; ++t)
#pragma unroll
            for (int r = 0; r < 16; ++r) {
                if (BAND) { const int ko = 32 * (g * NTG + t) + crow(r, hi); if (ko < q || ko > q + 128 || ko < kmin) S[t][r] = -INFINITY; }
                mx = fmaxf(mx, S[t][r]);
            }
        mx = fmaxf(mx, __shfl_xor(mx, 32));
        const float m_new = fmaxf(m_run, mx);
        const float alpha = __builtin_amdgcn_exp2f((m_run - m_new) * L2E);
        float ls = 0.f;
#pragma unroll
        for (int t = 0; t < NTG; ++t)
#pragma unroll
            for (int r = 0; r < 16; ++r) { const float p = __builtin_amdgcn_exp2f((S[t][r] - m_new) * L2E); S[t][r] = p; ls += p; }
        ls += __shfl_xor(ls, 32);
        l_run = l_run * alpha + ls; m_run = m_new;
        if (g > 0) {
#pragma unroll
            for (int r = 0; r < 16; ++r) { const float a = __shfl(alpha, crow(r, hi)); o[0][r] *= a; o[1][r] *= a; }
        }
#pragma unroll
        for (int t = 0; t < NTG; ++t)
#pragma unroll
            for (int s = 0; s < 2; ++s) {
                u32x4 pw; pw[0] = cvtpk(S[t][8 * s + 0], S[t][8 * s + 1]); pw[1] = cvtpk(S[t][8 * s + 2], S[t][8 * s + 3]);
                pw[2] = cvtpk(S[t][8 * s + 4], S[t][8 * s + 5]); pw[3] = cvtpk(S[t][8 * s + 6], S[t][8 * s + 7]);
                const bf16x8 pa = __builtin_bit_cast(bf16x8, pw);
                const int vrow = krow0 + (g * NTG + t) * 32 + 16 * s + 4 * hi + ((lane & 15) >> 2);
                LAS const unsigned char* vp = Vl + (size_t)vrow * VS + (16 * ((lane >> 4) & 1) + 4 * (lane & 3)) * 2;
#pragma unroll
                for (int dt = 0; dt < 2; ++dt) {
                    const s16x4 lo = vtr(vp + dt * 64), hh = vtr(vp + dt * 64 + 8 * VS);
                    const bf16x8 vb = (bf16x8){lo[0], lo[1], lo[2], lo[3], hh[0], hh[1], hh[2], hh[3]};
                    o[dt] = __builtin_amdgcn_mfma_f32_32x32x16_bf16(pa, vb, o[dt], 0, 0, 0);
                }
            }
    }
    m_out = m_run; l_out = l_run;
}

struct Ptrs {
    const float* in[25]; float* out; unsigned char* ws;
    float *RINV, *SS, *ROPE, *ZB, *LSE;
    bf16_t *WT, *WOT, *XB, *Qb, *Kb, *Vb, *QMb, *Gb, *MKB, *MVB, *OAP, *OG;
};

constexpr int N_DIL_UNITS = NB * 6 * 3 * 32;
__device__ __forceinline__ void dil_unit(const Ptrs& P, LAS unsigned char* lds, int unit, int tid) {
    const int lane = tid & 63, wave = tid >> 6;
    const int u32 = unit & 31, x = unit >> 5, di = x % 3, bh = x / 3, b = bh / 6, h = bh % 6;
    const int dil = (di == 0) ? 1 : (di == 1 ? 4 : 16), nb2 = 32 / dil, res = u32 / nb2, j = u32 % nb2;
    LAS unsigned char* Kl = lds; LAS unsigned char* Vl = lds + 384 * KS;
    const int l0 = 256 * j - 128;
#pragma unroll
    for (int i = 0; i < 6; ++i) {
        const int e = tid + NTHR * i, row = e >> 3, c = e & 7, l = l0 + row;
        u32x4 kv = (u32x4){0u, 0u, 0u, 0u}, vv = kv;
        if (l >= 0) { const size_t off = ((size_t)b * SEQ + (size_t)l * dil + res) * ATT_W + h * 64 + c * 8; kv = *(const u32x4*)(P.Kb + off); vv = *(const u32x4*)(P.Vb + off); }
        *(LAS u32x4*)(Kl + row * KS + c * 16) = kv; *(LAS u32x4*)(Vl + row * VS + c * 16) = vv;
    }
    __syncthreads();
    const int q = lane & 31, hi = lane >> 5, lq0 = 256 * j + 32 * wave;
    const size_t tokq = (size_t)b * SEQ + (size_t)(lq0 + q) * dil + res;
    bf16x8 qf[4];
#pragma unroll
    for (int d0 = 0; d0 < 4; ++d0) qf[d0] = *(const bf16x8*)(P.Qb + tokq * ATT_W + h * 64 + d0 * 16 + hi * 8);
    f32x16 o[2]; float mm, ll;
    strip_attn<5, 1, true>(qf, Kl, Vl, 32 * wave, lane, (lq0 < 128) ? 128 - lq0 : 0, o, mm, ll);
    const float linv = 1.f / ll;
#pragma unroll
    for (int r = 0; r < 16; ++r) {
        const int qq = crow(r, hi); const float li = __shfl(linv, qq);
        const size_t tok = (size_t)b * SEQ + (size_t)(lq0 + qq) * dil + res;
        bf16_t* op = P.OAP + ((size_t)di * MP + tok) * ATT_W + h * 64 + q;
        op[0] = f2bf(o[0][r] * li); op[32] = f2bf(o[1][r] * li);
    }
    if (hi == 0) P.LSE[((size_t)di * MP + tokq) * 6 + h] = mm + __logf(ll);
    __syncthreads();
}

constexpr int N_MEMA_UNITS = NB * 4 * 32;
__device__ __forceinline__ void mem_unit(const Ptrs& P, LAS unsigned char* lds, int unit, int tid) {
    const int lane = tid & 63, wave = tid >> 6;
    const int jq = unit & 31, bh = unit >> 5, b = bh >> 2, hm = bh & 3;
    LAS unsigned char* Kl = lds; LAS unsigned char* Vl = lds + 256 * KS;
#pragma unroll
    for (int i = 0; i < 4; ++i) {
        const int e = tid + NTHR * i, row = e >> 3, c = e & 7;
        const size_t off = ((size_t)b * NMEM + row) * MEM_W + hm * 64 + c * 8;
        *(LAS u32x4*)(Kl + row * KS + c * 16) = *(const u32x4*)(P.MKB + off); *(LAS u32x4*)(Vl + row * VS + c * 16) = *(const u32x4*)(P.MVB + off);
    }
    __syncthreads();
    const int q = lane & 31, hi = lane >> 5;
    const size_t tok0 = (size_t)b * SEQ + 256 * jq + 32 * wave;
    bf16x8 qf[4];
#pragma unroll
    for (int d0 = 0; d0 < 4; ++d0) qf[d0] = *(const bf16x8*)(P.QMb + (tok0 + q) * MEM_W + hm * 64 + d0 * 16 + hi * 8);
    f32x16 o[2]; float mm, ll;
    strip_attn<4, 2, false>(qf, Kl, Vl, 0, lane, 0, o, mm, ll);
    const float linv = 1.f / ll;
#pragma unroll
    for (int r = 0; r < 16; ++r) {
        const int qq = crow(r, hi); const float li = __shfl(linv, qq);
        const size_t oo = (tok0 + qq) * DM + 768 + hm * 64 + q;
        P.OG[oo] = f2bf(o[0][r] * li * bf2f(P.Gb[oo])); P.OG[oo + 32] = f2bf(o[1][r] * li * bf2f(P.Gb[oo + 32]));
    }
    __syncthreads();
}

constexpr int N_SDIL_ITEMS = DB * DT;
__device__ __forceinline__ void sdil_item(const Ptrs& P, LAS unsigned char* lds, int item, int tid) {
    const int db = item >> 3, i = item & 7, lane = tid & 63, wave = tid >> 6;
    LAS float* sc = (LAS float*)lds;
    LAS float* st = sc + 3 * 132 * 6;
    LAS float* red = st + 32;
    const int g = tid / 96, u = tid % 96, hh = u >> 4;
    const size_t srow = (size_t)MP + db * 8 + i;
    const float* ck = P.in[2] + (size_t)db * WINP * ATT_W; const float* cv = P.in[3] + (size_t)db * WINP * ATT_W;
    const float* nk = P.out + O_WK_S + (size_t)db * 8 * ATT_W; const float* nv = P.out + O_WV_S + (size_t)db * 8 * ATT_W;
    f32x4 q4 = (f32x4){0.f, 0.f, 0.f, 0.f};
    if (g < 5) { const u32x2 w = *(const u32x2*)(P.Qb + srow * ATT_W + u * 4); q4 = (f32x4){bflo(w[0]), bfhi(w[0]), bflo(w[1]), bfhi(w[1])}; }
    for (int di = 0; di < 3; ++di) {
        const int dil = (di == 0) ? 1 : (di == 1 ? 4 : 16);
        for (int jj = g; jj < 129 + 4; jj += 5) {
            float d = 0.f;
            if (g < 5 && jj < 129) { const int idx = WINP + i - dil * jj; const float* kr = (idx >= WINP) ? nk + (size_t)(idx - WINP) * ATT_W : ck + (size_t)idx * ATT_W;
                const f32x4 k4 = *(const f32x4*)(kr + u * 4); d = (k4[0] * q4[0] + k4[1] * q4[1]) + (k4[2] * q4[2] + k4[3] * q4[3]); }
            d += __shfl_xor(d, 1); d += __shfl_xor(d, 2); d += __shfl_xor(d, 4); d += __shfl_xor(d, 8);
            if (g < 5 && jj < 129 && (u & 15) == 0) sc[(di * 132 + jj) * 6 + hh] = d;
        }
    }
    __syncthreads();
    LAS float* stm = st + 32 + 5 * 384;
    for (int pr = wave; pr < 18; pr += 8) {
        const int di = pr / 6, h2 = pr % 6;
        float v0 = sc[(di * 132 + lane) * 6 + h2], v1 = sc[(di * 132 + 64 + lane) * 6 + h2], v2 = (lane == 0) ? sc[(di * 132 + 128) * 6 + h2] : -INFINITY;
        const float mx = wave_max(fmaxf(fmaxf(v0, v1), v2));
        v0 = __expf(v0 - mx); v1 = __expf(v1 - mx); v2 = (lane == 0) ? __expf(v2 - mx) : 0.f;
        const float sm = wave_sum(v0 + v1 + v2);
        sc[(di * 132 + lane) * 6 + h2] = v0; sc[(di * 132 + 64 + lane) * 6 + h2] = v1; if (lane == 0) { sc[(di * 132 + 128) * 6 + h2] = v2; stm[pr] = mx; stm[18 + pr] = sm; }
    }
    __syncthreads();
    if (tid < 6) {
        const float l0 = stm[tid] + __logf(stm[18 + tid]), l1 = stm[6 + tid] + __logf(stm[24 + tid]), l2 = stm[12 + tid] + __logf(stm[30 + tid]);
        const float mx = fmaxf(l0, fmaxf(l1, l2)); const float e0 = __expf(l0 - mx), e1 = __expf(l1 - mx), e2 = __expf(l2 - mx); const float inv = 1.f / (e0 + e1 + e2);
        st[tid] = e0 * inv / stm[18 + tid]; st[6 + tid] = e1 * inv / stm[24 + tid]; st[12 + tid] = e2 * inv / stm[30 + tid];
    }
    __syncthreads();
    if (g < 5) {
        f32x4 a = (f32x4){0.f, 0.f, 0.f, 0.f};
        for (int di = 0; di < 3; ++di) {
            const int dil = (di == 0) ? 1 : (di == 1 ? 4 : 16); const float cf = st[di * 6 + hh];
            for (int jj = g; jj < 129; jj += 5) { const int idx = WINP + i - dil * jj; const float* vr = (idx >= WINP) ? nv + (size_t)(idx - WINP) * ATT_W : cv + (size_t)idx * ATT_W;
                const f32x4 v4 = *(const f32x4*)(vr + u * 4); const float pw = sc[(di * 132 + jj) * 6 + hh] * cf; a += v4 * pw; }
        }
        *(LAS f32x4*)(red + g * 384 + u * 4) = a;
    }
    __syncthreads();
    if (tid < 96) {
        f32x4 a = *(LAS f32x4*)(red + tid * 4);
#pragma unroll
        for (int k = 1; k < 5; ++k) a += *(LAS f32x4*)(red + k * 384 + tid * 4);
        const u32x2 gw = *(const u32x2*)(P.Gb + srow * DM + tid * 4);
        u32x2 w; w[0] = cvtpk(a[0] * bflo(gw[0]), a[1] * bfhi(gw[0])); w[1] = cvtpk(a[2] * bflo(gw[1]), a[3] * bfhi(gw[1]));
        *(u32x2*)(P.OG + srow * DM + tid * 4) = w;
    }
    __syncthreads();
}

constexpr int N_SMEM_ITEMS = DB * 4;
__device__ __forceinline__ void smem_item(const Ptrs& P, LAS unsigned char* lds, int item, int tid) {
    const int db = item >> 2, hm = item & 3, lane = tid & 63, wave = tid >> 6;
    LAS float* qs = (LAS float*)lds;
    LAS float* sc = qs + 512;
    LAS float* li = sc + 2048;
    { const int qi = tid >> 6, d = tid & 63; qs[tid] = bf2f(P.QMb[((size_t)MP + db * 8 + qi) * MEM_W + hm * 64 + d]); }
    __syncthreads();
    {
        const int m = tid & 255, qh = tid >> 8;
        const float* kr = P.in[6] + (((size_t)db * NMEM + m) * 4 + hm) * 64;
        float d0 = 0.f, d1 = 0.f, d2 = 0.f, d3 = 0.f;
#pragma unroll 4
        for (int c = 0; c < 16; ++c) {
            const f32x4 k4 = *(const f32x4*)(kr + c * 4);
            const f32x4 a0 = *(LAS f32x4*)(qs + (qh * 4 + 0) * 64 + c * 4), a1 = *(LAS f32x4*)(qs + (qh * 4 + 1) * 64 + c * 4), a2 = *(LAS f32x4*)(qs + (qh * 4 + 2) * 64 + c * 4), a3 = *(LAS f32x4*)(qs + (qh * 4 + 3) * 64 + c * 4);
            d0 += (k4[0] * a0[0] + k4[1] * a0[1]) + (k4[2] * a0[2] + k4[3] * a0[3]); d1 += (k4[0] * a1[0] + k4[1] * a1[1]) + (k4[2] * a1[2] + k4[3] * a1[3]);
            d2 += (k4[0] * a2[0] + k4[1] * a2[1]) + (k4[2] * a2[2] + k4[3] * a2[3]); d3 += (k4[0] * a3[0] + k4[1] * a3[1]) + (k4[2] * a3[2] + k4[3] * a3[3]);
        }
        sc[(qh * 4 + 0) * 256 + m] = d0; sc[(qh * 4 + 1) * 256 + m] = d1; sc[(qh * 4 + 2) * 256 + m] = d2; sc[(qh * 4 + 3) * 256 + m] = d3;
    }
    __syncthreads();
    {
        float v[4]; float mx = -INFINITY;
#pragma unroll
        for (int k = 0; k < 4; ++k) { v[k] = sc[wave * 256 + k * 64 + lane]; mx = fmaxf(mx, v[k]); }
        mx = wave_max(mx); float sm = 0.f;
#pragma unroll
        for (int k = 0; k < 4; ++k) { v[k] = __expf(v[k] - mx); sm += v[k]; sc[wave * 256 + k * 64 + lane] = v[k]; }
        sm = wave_sum(sm); if (lane == 0) li[wave] = 1.f / sm;
    }
    __syncthreads();
    {
        const int qi = tid >> 6, d = tid & 63;
        const float* vr = P.in[7] + (((size_t)db * NMEM) * 4 + hm) * 64 + d;
        float a = 0.f;
#pragma unroll 8
        for (int m = 0; m < 256; ++m) a += sc[qi * 256 + m] * vr[(size_t)m * 256];
        const size_t oo = ((size_t)MP + db * 8 + qi) * DM + 768 + hm * 64 + d;
        P.OG[oo] = f2bf(a * li[qi] * bf2f(P.Gb[oo]));
    }
    __syncthreads();
}

constexpr int N_SCAN_P = NB * 6, N_SCAN_S = DB * 6;
constexpr int CH = 32;
__device__ __forceinline__ float softplusf(float x) { return fmaxf(x, 0.f) + log1pf(__expf(-fabsf(x))); }
__device__ __forceinline__ void scan_item(const Ptrs& P, LAS unsigned char* lds, bool sample, int bb, int h, int tid) {
    const int lane = tid & 63, wave = tid >> 6;
    const int T = sample ? DT : SEQ;
    const size_t row0 = sample ? (size_t)MP + bb * DT : (size_t)bb * SEQ;
    LAS float* W2h = (LAS float*)lds;
    LAS float* A2h = W2h + 4096;
    LAS float* Rr = A2h + 4096;
    LAS float* Kk = Rr + CH * 64;
    LAS float* Vv = Kk + CH * 64;
    LAS float* Wd = Vv + CH * 64;
    LAS float* KK = Wd + CH * 64;
    LAS float* Bb = KK + CH * 64;
    LAS float* TW = Bb + CH * 64;
    LAS float* AL = TW + CH * 64;
    LAS float* Yb = AL + CH * 64;
    const float* mu = P.in[11]; const float* w0 = P.in[12]; const float* w2 = P.in[13]; const float* a0 = P.in[14]; const float* a2 = P.in[15];
    const float* k_k = P.in[16]; const float* k_a = P.in[17]; const float* r_k = P.in[18]; const float* lnx_g = P.in[19]; const float* lnx_b = P.in[20];
    for (int e = tid; e < 4096; e += NTHR) { const int jr = e >> 6, c = e & 63; W2h[e] = w2[(size_t)jr * RW + h * 64 + c]; A2h[e] = a2[(size_t)jr * RW + h * 64 + c]; }
    const int v = tid >> 3, kq = tid & 7;
    float s[8];
    if (sample) {
        const float* sp = P.in[4] + (((size_t)bb * 6 + h) * 64 + v) * 64 + kq * 8;
#pragma unroll
        for (int e = 0; e < 8; ++e) s[e] = sp[e];
    } else {
#pragma unroll
        for (int e = 0; e < 8; ++e) s[e] = 0.f;
    }
    const float* shift0 = P.in[5] + (size_t)bb * SHIFT_W;
    __syncthreads();
    for (int c0 = 0; c0 < T; c0 += CH) {
        const int n = (T - c0) < CH ? (T - c0) : CH;
        {
            float zv[20], zpv[20];
#pragma unroll
            for (int ti = 0; ti < 4; ++ti)
#pragma unroll
                for (int grp = 0; grp < 5; ++grp) {
                    const int t = wave + 8 * ti, col = (grp < 3) ? grp * RW + h * 64 + lane : 3 * RW + (grp - 3) * 64 + lane;
                    const size_t row = row0 + c0 + t;
                    float z = 0.f, zp = 0.f;
                    if (t < n) { z = P.ZB[row * SHIFT_W + col]; zp = (c0 + t == 0) ? (sample ? shift0[col] : 0.f) : P.ZB[(row - 1) * SHIFT_W + col]; }
                    zv[ti * 5 + grp] = z; zpv[ti * 5 + grp] = zp;
                }
#pragma unroll
            for (int ti = 0; ti < 4; ++ti)
#pragma unroll
                for (int grp = 0; grp < 5; ++grp) {
                    const int t = wave + 8 * ti, col = (grp < 3) ? grp * RW + h * 64 + lane : 3 * RW + (grp - 3) * 64 + lane;
                    const float zs = zv[ti * 5 + grp] + (zpv[ti * 5 + grp] - zv[ti * 5 + grp]) * mu[col];
                    if (t < n) {
                        if (grp == 0) Rr[t * 64 + lane] = zs; else if (grp == 1) Kk[t * 64 + lane] = zs; else if (grp == 2) Vv[t * 64 + lane] = zs;
                        else if (grp == 3) TW[t * 64 + lane] = tanhf(zs); else AL[t * 64 + lane] = zs;
                    }
                }
        }
        __syncthreads();
        for (int idx = tid; idx < n * 64; idx += NTHR) {
            const int t = idx >> 6, c = idx & 63, ch = h * 64 + c;
            float wv = w0[ch], av = a0[ch];
#pragma unroll 8
            for (int jr = 0; jr < 64; ++jr) { wv += TW[t * 64 + jr] * W2h[jr * 64 + c]; av += AL[t * 64 + jr] * A2h[jr * 64 + c]; }
            const float w = -softplusf(-wv) - 0.5f;
            const float decay = __expf(-__expf(w));
            const float a = 1.f / (1.f + __expf(-av));
            const float kraw = Kk[t * 64 + c];
            Wd[t * 64 + c] = decay;
            KK[t * 64 + c] = kraw * k_k[ch];
            Kk[t * 64 + c] = kraw * (1.f + (a - 1.f) * k_a[ch]);
            Bb[t * 64 + c] = a;
        }
        __syncthreads();
        for (int t = wave; t < n; t += 8) {
            const float x = KK[t * 64 + lane];
            const float nrm = fmaxf(sqrtf(wave_sum(x * x)), 1e-12f);
            const float kkn = x / nrm;
            KK[t * 64 + lane] = kkn; Bb[t * 64 + lane] = kkn * Bb[t * 64 + lane];
        }
        __syncthreads();
        for (int t = 0; t < n; ++t) {
            const f32x4 kk0 = *(LAS f32x4*)(KK + t * 64 + kq * 8), kk1 = *(LAS f32x4*)(KK + t * 64 + kq * 8 + 4);
            const f32x4 w0v = *(LAS f32x4*)(Wd + t * 64 + kq * 8), w1v = *(LAS f32x4*)(Wd + t * 64 + kq * 8 + 4);
            const f32x4 b0 = *(LAS f32x4*)(Bb + t * 64 + kq * 8), b1 = *(LAS f32x4*)(Bb + t * 64 + kq * 8 + 4);
            const f32x4 k0 = *(LAS f32x4*)(Kk + t * 64 + kq * 8), k1 = *(LAS f32x4*)(Kk + t * 64 + kq * 8 + 4);
            const f32x4 r0 = *(LAS f32x4*)(Rr + t * 64 + kq * 8), r1 = *(LAS f32x4*)(Rr + t * 64 + kq * 8 + 4);
            const float vv = Vv[t * 64 + v];
            float sa = 0.f;
#pragma unroll
            for (int e = 0; e < 4; ++e) { sa += s[e] * kk0[e]; sa += s[4 + e] * kk1[e]; }
            sa = -sum8(sa);
            float y = 0.f;
#pragma unroll
            for (int e = 0; e < 4; ++e) {
                s[e] = s[e] * w0v[e] + sa * b0[e] + vv * k0[e];
                s[4 + e] = s[4 + e] * w1v[e] + sa * b1[e] + vv * k1[e];
                y += s[e] * r0[e]; y += s[4 + e] * r1[e];
            }
            y = sum8(y);
            if (kq == 0) Yb[t * 64 + v] = y;
        }
        __syncthreads();
        for (int t = wave; t < n; t += 8) {
            const int ch = h * 64 + lane;
            const float y = Yb[t * 64 + lane];
            const float mean = wave_sum(y) * (1.f / 64.f);
            const float d = y - mean;
            const float var = wave_sum(d * d) * (1.f / 64.f);
            const float yn = d * rsqrtf(var + 64e-5f) * lnx_g[ch] + lnx_b[ch];
            const float bonus = wave_sum(Rr[t * 64 + lane] * Kk[t * 64 + lane] * r_k[ch]) * Vv[t * 64 + lane];
            const size_t oo = (row0 + c0 + t) * DM + 384 + ch;
            P.OG[oo] = f2bf((yn + bonus) * bf2f(P.Gb[oo]));
        }
        __syncthreads();
    }
    if (sample) {
        float* so = P.out + O_ST_S + (((size_t)bb * 6 + h) * 64 + v) * 64 + kq * 8;
#pragma unroll
        for (int e = 0; e < 8; ++e) so[e] = s[e];
    }
    __syncthreads();
}

constexpr int NCH = SEQ / 64, N_L_ITEMS = NB * 6 * NCH;
constexpr size_t WS_MF = WS_END;
constexpr size_t WS_NF = WS_MF + (size_t)N_L_ITEMS * 8192;
constexpr size_t WS_QF = WS_NF + (size_t)N_L_ITEMS * 16384;
constexpr size_t WS_YF = WS_QF + (size_t)N_L_ITEMS * 8192;
constexpr size_t WS_SF = WS_YF + (size_t)N_L_ITEMS * 16384;
constexpr size_t WS_RHO = WS_SF + (size_t)N_L_ITEMS * 8192;
constexpr size_t WS_END2 = al256(WS_RHO + (size_t)N_L_ITEMS * 256);
constexpr int TS = 144;
constexpr int FS = 272;
#define MFMA32(a, b, c) __builtin_amdgcn_mfma_f32_32x32x16_bf16((a), (b), (c), 0, 0, 0)
__device__ __forceinline__ bf16x8 rowfrag(LAS const unsigned char* tile, int row, int s, int h) { return *(LAS const bf16x8*)(tile + row * TS + (16 * s + 8 * h) * 2); }
__device__ __forceinline__ bf16x8 colfrag(LAS const unsigned char* tile, int f0, int s, int lane) {
    LAS const unsigned char* p = tile + (16 * s + 8 * (lane >> 5) + ((lane & 15) >> 2)) * TS + (f0 + 16 * ((lane >> 4) & 1) + 4 * (lane & 3)) * 2;
    const s16x4 lo = vtr(p), hh = vtr(p + 4 * TS);
    return (bf16x8){lo[0], lo[1], lo[2], lo[3], hh[0], hh[1], hh[2], hh[3]};
}
__device__ __forceinline__ f32x16 zero16() { f32x16 z; _Pragma("unroll") for (int r = 0; r < 16; ++r) z[r] = 0.f; return z; }

__device__ __forceinline__ void passL_item(const Params& prm, LAS unsigned char* lds, int item, int tid) {
    const int lane = tid & 63, wave = tid >> 6, hi = lane >> 5, l31 = lane & 31;
    const int seq = item >> 7, c = item & 127, b = seq / 6, h = seq % 6;
    const size_t row0 = (size_t)b * SEQ + 64 * c;
    const float* ZB = (const float*)(prm.ws + WS_ZB);
    LAS unsigned char* F_R = lds; LAS unsigned char* F_K = lds + 17408; LAS unsigned char* F_KK = lds + 34816; LAS unsigned char* F_B = lds + 52224; LAS unsigned char* F_LD = lds + 69632;
    LAS unsigned char* T_TW = lds + 87040; LAS unsigned char* T_AL = lds + 96256; LAS unsigned char* T_W2 = lds + 105472; LAS unsigned char* T_A2 = lds + 114688;
    LAS float* SEG = (LAS float*)(lds + 133120);
    LAS unsigned char* T_V = lds + 135168; LAS float* GCs = (LAS float*)(lds + 144384);
    LAS unsigned char* T_At = lds; LAS unsigned char* T_Bt = lds + 9216; LAS unsigned char* T_Kt = lds + 18432; LAS unsigned char* T_Rt = lds + 27648; LAS unsigned char* T_Bh = lds + 36864; LAS unsigned char* T_Kh = lds + 46080;
    LAS unsigned char* T_Aak = lds + 55296; LAS unsigned char* T_Arb = lds + 64512; LAS unsigned char* T_Ark = lds + 73728;
    LAS unsigned char* ATm = lds + 82944;
    LAS unsigned char* RHST = lds + 100352;
    LAS unsigned char* XsT = lds + 9216;
    {
        const float* mu = prm.in[11];
#pragma unroll
        for (int half = 0; half < 2; ++half) {
            float zv[20], zpv[20];
#pragma unroll
            for (int ti = 0; ti < 4; ++ti)
#pragma unroll
                for (int grp = 0; grp < 5; ++grp) {
                    const int t = wave + 8 * (half * 4 + ti), col = (grp < 3) ? grp * RW + h * 64 + lane : 3 * RW + (grp - 3) * 64 + lane;
                    const size_t row = row0 + t;
                    zv[ti * 5 + grp] = ZB[row * SHIFT_W + col];
                    zpv[ti * 5 + grp] = (c == 0 && t == 0) ? 0.f : ZB[(row - 1) * SHIFT_W + col];
                }
#pragma unroll
            for (int ti = 0; ti < 4; ++ti)
#pragma unroll
                for (int grp = 0; grp < 5; ++grp) {
                    const int t = wave + 8 * (half * 4 + ti), col = (grp < 3) ? grp * RW + h * 64 + lane : 3 * RW + (grp - 3) * 64 + lane;
                    const float zs = zv[ti * 5 + grp] + (zpv[ti * 5 + grp] - zv[ti * 5 + grp]) * mu[col];
                    if (grp == 0) *(LAS float*)(F_R + t * FS + lane * 4) = zs;
                    else if (grp == 1) *(LAS float*)(F_K + t * FS + lane * 4) = zs;
                    else if (grp == 2) *(LAS bf16_t*)(T_V + t * TS + lane * 2) = f2bf(zs);
                    else if (grp == 3) *(LAS bf16_t*)(T_TW + t * TS + lane * 2) = f2bf(tanhf(zs));
                    else *(LAS bf16_t*)(T_AL + t * TS + lane * 2) = f2bf(zs);
                }
        }
        const float* w2 = prm.in[13]; const float* a2 = prm.in[15];
#pragma unroll
        for (int i = 0; i < 8; ++i) { const int e = tid + NTHR * i, jr = e >> 6, cc = e & 63;
            *(LAS bf16_t*)(T_W2 + cc * TS + jr * 2) = f2bf(w2[(size_t)jr * RW + h * 64 + cc]); *(LAS bf16_t*)(T_A2 + cc * TS + jr * 2) = f2bf(a2[(size_t)jr * RW + h * 64 + cc]); }
    }
    __syncthreads();
    if (wave < 4) {
        const int t = 16 * wave + (lane & 15), g = lane >> 4;
        f32x4 accW[4], accA[4];
#pragma unroll
        for (int ct = 0; ct < 4; ++ct) { accW[ct] = (f32x4){0.f, 0.f, 0.f, 0.f}; accA[ct] = accW[ct]; }
#pragma unroll
        for (int ks = 0; ks < 2; ++ks) {
            const bf16x8 bw = *(LAS const bf16x8*)(T_TW + t * TS + (32 * ks + 8 * g) * 2), ba = *(LAS const bf16x8*)(T_AL + t * TS + (32 * ks + 8 * g) * 2);
#pragma unroll
            for (int ct = 0; ct < 4; ++ct) {
                const bf16x8 aw = *(LAS const bf16x8*)(T_W2 + (16 * ct + (lane & 15)) * TS + (32 * ks + 8 * g) * 2), aa = *(LAS const bf16x8*)(T_A2 + (16 * ct + (lane & 15)) * TS + (32 * ks + 8 * g) * 2);
                accW[ct] = __builtin_amdgcn_mfma_f32_16x16x32_bf16(aw, bw, accW[ct], 0, 0, 0);
                accA[ct] = __builtin_amdgcn_mfma_f32_16x16x32_bf16(aa, ba, accA[ct], 0, 0, 0);
            }
        }
        const float* w0 = prm.in[12]; const float* a0 = prm.in[14]; const float* k_k = prm.in[16]; const float* k_a = prm.in[17]; const float* r_k = prm.in[18];
        float ssq = 0.f, rho = 0.f; f32x4 kkv[4], av[4];
#pragma unroll
        for (int ct = 0; ct < 4; ++ct) {
            const int c4 = 16 * ct + 4 * g, ch = h * 64 + c4;
            const f32x4 kraw = *(LAS const f32x4*)(F_K + t * FS + c4 * 4), rr = *(LAS const f32x4*)(F_R + t * FS + c4 * 4);
            const f32x4 w0v = *(const f32x4*)(w0 + ch), a0v = *(const f32x4*)(a0 + ch), kkc = *(const f32x4*)(k_k + ch), kac = *(const f32x4*)(k_a + ch), rkc = *(const f32x4*)(r_k + ch);
            f32x4 ld, kp;
#pragma unroll
            for (int e = 0; e < 4; ++e) {
                const float wv = w0v[e] + accW[ct][e];
                const float w = -softplusf(-wv) - 0.5f;
                ld[e] = -__expf(w);
                const float a = 1.f / (1.f + __expf(-(a0v[e] + accA[ct][e])));
                av[ct][e] = a;
                kkv[ct][e] = kraw[e] * kkc[e];
                kp[e] = kraw[e] * (1.f + (a - 1.f) * kac[e]);
                ssq += kkv[ct][e] * kkv[ct][e];
                rho += rr[e] * kp[e] * rkc[e];
            }
            *(LAS f32x4*)(F_LD + t * FS + c4 * 4) = ld; *(LAS f32x4*)(F_K + t * FS + c4 * 4) = kp;
        }
        ssq += __shfl_xor(ssq, 16); ssq += __shfl_xor(ssq, 32); rho += __shfl_xor(rho, 16); rho += __shfl_xor(rho, 32);
        const float inv = 1.f / fmaxf(sqrtf(ssq), 1e-12f);
#pragma unroll
        for (int ct = 0; ct < 4; ++ct) {
            const int c4 = 16 * ct + 4 * g; f32x4 kk, bb;
#pragma unroll
            for (int e = 0; e < 4; ++e) { kk[e] = kkv[ct][e] * inv; bb[e] = kk[e] * av[ct][e]; }
            *(LAS f32x4*)(F_KK + t * FS + c4 * 4) = kk; *(LAS f32x4*)(F_B + t * FS + c4 * 4) = bb;
        }
        if (g == 0) ((float*)(prm.ws + WS_RHO))[(size_t)item * 64 + t] = rho;
    }
    __syncthreads();
    {
        const int cch = tid & 63, seg = tid >> 6;
        float L[8], kk[8], bb[8], kp[8], rr[8];
        float run = 0.f;
#pragma unroll
        for (int i = 0; i < 8; ++i) { const int t = 8 * seg + i; run += *(LAS const float*)(F_LD + t * FS + cch * 4); L[i] = run;
            kk[i] = *(LAS const float*)(F_KK + t * FS + cch * 4); bb[i] = *(LAS const float*)(F_B + t * FS + cch * 4); kp[i] = *(LAS const float*)(F_K + t * FS + cch * 4); rr[i] = *(LAS const float*)(F_R + t * FS + cch * 4); }
        SEG[seg * 64 + cch] = run;
        __syncthreads();
        float off = 0.f, tot = 0.f;
#pragma unroll
        for (int sgi = 0; sgi < 8; ++sgi) { const float v = SEG[sgi * 64 + cch]; tot += v; if (sgi < seg) off += v; }
        __syncthreads();
        f32x4 at0, at1;
#pragma unroll
        for (int i = 0; i < 8; ++i) {
            const int t = 8 * seg + i;
            const float Lc = off + L[i], Lp = (i == 0) ? off : off + L[i - 1];
            const float ep = __expf(Lp), em = __expf(-Lc), el = __expf(Lc), eh = __expf(tot - Lc);
            const float at = -kk[i] * ep;
            if (i < 4) at0[i] = at; else at1[i - 4] = at;
            *(LAS bf16_t*)(T_At + t * TS + cch * 2) = f2bf(at);
            *(LAS bf16_t*)(T_Bt + t * TS + cch * 2) = f2bf(bb[i] * em);
            *(LAS bf16_t*)(T_Kt + t * TS + cch * 2) = f2bf(kp[i] * em);
            *(LAS bf16_t*)(T_Rt + t * TS + cch * 2) = f2bf(rr[i] * el);
            *(LAS bf16_t*)(T_Bh + t * TS + cch * 2) = f2bf(bb[i] * eh);
            *(LAS bf16_t*)(T_Kh + t * TS + cch * 2) = f2bf(kp[i] * eh);
        }
#pragma unroll
        for (int i = 0; i < 8; ++i) *(LAS float*)(RHST + cch * FS + ((i & 3) * 16 + 2 * seg + (i >> 2)) * 4) = (i < 4) ? at0[i & 3] : at1[i & 3];
        if (seg == 0) GCs[cch] = __expf(tot);
    }
    __syncthreads();
#pragma unroll
    for (int rep = 0; rep < 2; ++rep) {
        const int slot = wave + 8 * rep, prod = slot >> 2, tile = slot & 3;
        if (prod == 0) {
            const int tt = tile >> 1, it = tile & 1;
            if (!(tt == 0 && it == 1)) {
                f32x16 d = zero16();
#pragma unroll
                for (int s4 = 0; s4 < 4; ++s4) d = MFMA32(rowfrag(T_At, 32 * tt + l31, s4, hi), rowfrag(T_Bt, 32 * it + l31, s4, hi), d);
#pragma unroll
                for (int rg = 0; rg < 4; ++rg)
#pragma unroll
                    for (int e = 0; e < 4; ++e) *(LAS float*)(ATm + (32 * it + l31) * FS + (e * 16 + 8 * tt + 2 * rg + hi) * 4) = d[4 * rg + e];
            }
        } else {
            const int it = tile >> 1, tt = tile & 1;
            LAS const unsigned char* TA = (prod == 2) ? T_Bt : T_Kt; LAS const unsigned char* TB = (prod == 1) ? T_At : T_Rt;
            LAS unsigned char* TO = (prod == 1) ? T_Aak : (prod == 2) ? T_Arb : T_Ark;
            f32x16 d = zero16();
            if (!(it == 1 && tt == 0)) {
#pragma unroll
                for (int s4 = 0; s4 < 4; ++s4) d = MFMA32(rowfrag(TA, 32 * it + l31, s4, hi), rowfrag(TB, 32 * tt + l31, s4, hi), d);
            }
            const int tg = 32 * tt + l31;
#pragma unroll
            for (int rg = 0; rg < 4; ++rg) {
                float v4[4];
#pragma unroll
                for (int e = 0; e < 4; ++e) { const int ig = 32 * it + 8 * rg + 4 * hi + e; const bool keep = (prod == 1) ? (ig < tg) : (ig <= tg); v4[e] = keep ? d[4 * rg + e] : 0.f; }
                *(LAS u32x2*)(TO + tg * TS + (32 * it + 8 * rg + 4 * hi) * 2) = (u32x2){cvtpk(v4[0], v4[1]), cvtpk(v4[2], v4[3])};
            }
        }
    }
    __syncthreads();
    if (wave < 4) {
        const int tt = wave >> 1, vt = wave & 1;
        f32x16 d = zero16();
#pragma unroll
        for (int s4 = 0; s4 < 4; ++s4) d = MFMA32(rowfrag(T_Aak, 32 * tt + l31, s4, hi), colfrag(T_V, 32 * vt, s4, lane), d);
#pragma unroll
        for (int rg = 0; rg < 4; ++rg)
#pragma unroll
            for (int e = 0; e < 4; ++e) *(LAS float*)(RHST + (64 + 32 * vt + l31) * FS + (e * 16 + 8 * tt + 2 * rg + hi) * 4) = d[4 * rg + e];
    }
    __syncthreads();
    {
        const int col = tid >> 2, j = tid & 3;
        float acc[16];
#pragma unroll
        for (int q = 0; q < 4; ++q) { const f32x4 v = *(LAS const f32x4*)(RHST + col * FS + (j * 16 + 4 * q) * 4); acc[4 * q] = v[0]; acc[4 * q + 1] = v[1]; acc[4 * q + 2] = v[2]; acc[4 * q + 3] = v[3]; }
        LAS const unsigned char* atp = ATm + j * 64;
#pragma unroll
        for (int i = 0; i < 63; ++i) {
            constexpr int dummy = 0; (void)dummy;
            const int jo = i & 3, mo = i >> 2;
            const float x = (jo == 0) ? dpp_f<0x00>(acc[mo]) : (jo == 1) ? dpp_f<0x55>(acc[mo]) : (jo == 2) ? dpp_f<0xAA>(acc[mo]) : dpp_f<0xFF>(acc[mo]);
#pragma unroll
            for (int q = mo / 4; q < 4; ++q) {
                const f32x4 a4 = *(LAS const f32x4*)(atp + i * FS + q * 16);
#pragma unroll
                for (int e = 0; e < 4; ++e) { const int m = 4 * q + e;
                    if (m > mo) acc[m] += a4[e] * x;
                    else if (m == mo) acc[m] += ((j > jo) ? a4[e] : 0.f) * x; }
            }
        }
#pragma unroll
        for (int m = 0; m < 16; ++m) *(LAS bf16_t*)(XsT + col * TS + (4 * m + j) * 2) = f2bf(acc[m]);
    }
    __syncthreads();
    {
        const int tile = wave & 3, ta = tile >> 1, tb = tile & 1;
        if (wave < 4) {
            f32x16 d = zero16();
#pragma unroll
            for (int s4 = 0; s4 < 4; ++s4) d = MFMA32(rowfrag(XsT, 32 * ta + l31, s4, hi), colfrag(T_Bh, 32 * tb, s4, lane), d);
            if (ta == tb) { const float gc = GCs[32 * tb + l31];
#pragma unroll
                for (int r = 0; r < 16; ++r) if (crow(r, hi) == l31) d[r] += gc; }
            u32x4* mf = (u32x4*)(prm.ws + WS_MF + (size_t)item * 8192) + ((ta * 2 + tb) * 2) * 64 + lane;
#pragma unroll
            for (int s2 = 0; s2 < 2; ++s2) mf[s2 * 64] = (u32x4){cvtpk(d[8 * s2], d[8 * s2 + 1]), cvtpk(d[8 * s2 + 2], d[8 * s2 + 3]), cvtpk(d[8 * s2 + 4], d[8 * s2 + 5]), cvtpk(d[8 * s2 + 6], d[8 * s2 + 7])};
            f32x16 n = zero16();
#pragma unroll
            for (int s4 = 0; s4 < 4; ++s4) n = MFMA32(colfrag(T_Bh, 32 * ta, s4, lane), rowfrag(XsT, 64 + 32 * tb + l31, s4, hi), n);
#pragma unroll
            for (int s4 = 0; s4 < 4; ++s4) n = MFMA32(colfrag(T_Kh, 32 * ta, s4, lane), colfrag(T_V, 32 * tb, s4, lane), n);
            f32x4* nf = (f32x4*)(prm.ws + WS_NF + (size_t)item * 16384) + ((tb * 2 + ta) * 64 + lane) * 4;
#pragma unroll
            for (int rg = 0; rg < 4; ++rg) nf[rg] = (f32x4){n[4 * rg], n[4 * rg + 1], n[4 * rg + 2], n[4 * rg + 3]};
        } else {
            f32x16 d;
#pragma unroll
            for (int rg = 0; rg < 4; ++rg) { const u32x2 w = *(LAS const u32x2*)(T_Rt + (32 * tb + l31) * TS + (32 * ta + 8 * rg + 4 * hi) * 2);
                d[4 * rg] = bflo(w[0]); d[4 * rg + 1] = bfhi(w[0]); d[4 * rg + 2] = bflo(w[1]); d[4 * rg + 3] = bfhi(w[1]); }
#pragma unroll
            for (int s4 = 0; s4 < 4; ++s4) d = MFMA32(rowfrag(XsT, 32 * ta + l31, s4, hi), rowfrag(T_Arb, 32 * tb + l31, s4, hi), d);
            u32x4* qf = (u32x4*)(prm.ws + WS_QF + (size_t)item * 8192) + ((ta * 2 + tb) * 2) * 64 + lane;
#pragma unroll
            for (int s2 = 0; s2 < 2; ++s2) qf[s2 * 64] = (u32x4){cvtpk(d[8 * s2], d[8 * s2 + 1]), cvtpk(d[8 * s2 + 2], d[8 * s2 + 3]), cvtpk(d[8 * s2 + 4], d[8 * s2 + 5]), cvtpk(d[8 * s2 + 6], d[8 * s2 + 7])};
            f32x16 y = zero16();
#pragma unroll
            for (int s4 = 0; s4 < 4; ++s4) y = MFMA32(rowfrag(XsT, 64 + 32 * ta + l31, s4, hi), rowfrag(T_Arb, 32 * tb + l31, s4, hi), y);
#pragma unroll
            for (int s4 = 0; s4 < 4; ++s4) y = MFMA32(colfrag(T_V, 32 * ta, s4, lane), rowfrag(T_Ark, 32 * tb + l31, s4, hi), y);
            f32x4* yf = (f32x4*)(prm.ws + WS_YF + (size_t)item * 16384) + ((ta * 2 + tb) * 64 + lane) * 4;
#pragma unroll
            for (int rg = 0; rg < 4; ++rg) yf[rg] = (f32x4){y[4 * rg], y[4 * rg + 1], y[4 * rg + 2], y[4 * rg + 3]};
        }
    }
    __syncthreads();
}

constexpr int N_S_BLOCKS = NB * 6 * 2;
__device__ __forceinline__ void passS_block(const Params& prm, LAS unsigned char* lds, int sblk, int tid) {
    const int lane = tid & 63, wave = tid >> 6;
    const int seq = sblk >> 1, vh = sblk & 1;
    const size_t item0 = (size_t)seq * NCH;
    const int ltid = tid - 64;
    const unsigned char* mbase = prm.ws + WS_MF + item0 * 8192;
    const unsigned char* nbase = prm.ws + WS_NF + item0 * 16384 + (size_t)vh * 8192;
    u32x4 hold[8][3];
#define PS_SRC(chunk, piece) (((piece) < 512) ? (const u32x4*)(mbase + (size_t)(chunk) * 8192) + (piece) : (const u32x4*)(nbase + (size_t)(chunk) * 16384) + ((piece) - 512))
#define PS_ISSUE(chunk, buf) do { if ((chunk) < NCH) { hold[buf][0] = *PS_SRC(chunk, ltid); hold[buf][1] = *PS_SRC(chunk, ltid + 448); if (ltid < 128) hold[buf][2] = *PS_SRC(chunk, ltid + 896); } } while (0)
#define PS_COMMIT(chunk, buf) do { if ((chunk) < NCH) { LAS unsigned char* slot_ = lds + ((chunk) & 7) * 16384; *(LAS u32x4*)(slot_ + ltid * 16) = hold[buf][0]; *(LAS u32x4*)(slot_ + (ltid + 448) * 16) = hold[buf][1]; \
        if (ltid < 128) *(LAS u32x4*)(slot_ + (ltid + 896) * 16) = hold[buf][2]; } } while (0)
    f32x16 acc[2]; acc[0] = zero16(); acc[1] = zero16();
    if (wave >= 1) {
        PS_ISSUE(0, 0); PS_ISSUE(1, 1); PS_COMMIT(0, 0); PS_COMMIT(1, 1);
        PS_ISSUE(2, 2); PS_ISSUE(3, 3); PS_ISSUE(4, 4); PS_ISSUE(5, 5); PS_ISSUE(6, 6); PS_ISSUE(7, 7); PS_ISSUE(8, 0); PS_ISSUE(9, 1);
    }
    __syncthreads();
    for (int c8 = 0; c8 < NCH; c8 += 8) {
#pragma unroll
        for (int par = 0; par < 8; ++par) {
            const int cc = c8 + par;
            if (wave == 0) {
                LAS const unsigned char* slot = lds + par * 16384;
                bf16x8 xb[2][2];
#pragma unroll
                for (int kt = 0; kt < 2; ++kt)
#pragma unroll
                    for (int s2 = 0; s2 < 2; ++s2) { const u32x4 w = (u32x4){cvtpk(acc[kt][8 * s2], acc[kt][8 * s2 + 1]), cvtpk(acc[kt][8 * s2 + 2], acc[kt][8 * s2 + 3]), cvtpk(acc[kt][8 * s2 + 4], acc[kt][8 * s2 + 5]), cvtpk(acc[kt][8 * s2 + 6], acc[kt][8 * s2 + 7])};
                        xb[kt][s2] = __builtin_bit_cast(bf16x8, w);
                        ((u32x4*)(prm.ws + WS_SF + (item0 + cc) * 8192))[((vh * 2 + kt) * 2 + s2) * 64 + lane] = w; }
                f32x16 nacc[2];
#pragma unroll
                for (int i = 0; i < 2; ++i) {
#pragma unroll
                    for (int rg = 0; rg < 4; ++rg) { const f32x4 v = *(LAS const f32x4*)(slot + 8192 + (i * 64 + lane) * 64 + rg * 16); nacc[i][4 * rg] = v[0]; nacc[i][4 * rg + 1] = v[1]; nacc[i][4 * rg + 2] = v[2]; nacc[i][4 * rg + 3] = v[3]; }
#pragma unroll
                    for (int kt = 0; kt < 2; ++kt)
#pragma unroll
                        for (int s2 = 0; s2 < 2; ++s2) { const bf16x8 mf = *(LAS const bf16x8*)(slot + (((kt * 2 + i) * 2 + s2) * 64 + lane) * 16); nacc[i] = MFMA32(mf, xb[kt][s2], nacc[i]); }
                }
                acc[0] = nacc[0]; acc[1] = nacc[1];
            } else {
                PS_COMMIT(cc + 2, (par + 2) & 7); PS_ISSUE(cc + 10, (par + 2) & 7);
            }
            __syncthreads();
        }
    }
#undef PS_SRC
#undef PS_ISSUE
#undef PS_COMMIT
    if (wave == 0) {
        float* so = prm.out + O_ST_P + ((size_t)seq * 64 + 32 * vh + (lane & 31)) * 64;
#pragma unroll
        for (int kt = 0; kt < 2; ++kt)
#pragma unroll
            for (int rg = 0; rg < 4; ++rg) *(f32x4*)(so + 32 * kt + 8 * rg + 4 * (lane >> 5)) = (f32x4){acc[kt][4 * rg], acc[kt][4 * rg + 1], acc[kt][4 * rg + 2], acc[kt][4 * rg + 3]};
    }
    __syncthreads();
}

__device__ __forceinline__ void passO_pair(const Params& prm, int item, int tt, int lane) {
    const int hi = lane >> 5, l31 = lane & 31;
    const int seq = item >> 7, c = item & 127, b = seq / 6, h = seq % 6;
    const u32x4* sf = (const u32x4*)(prm.ws + WS_SF + (size_t)item * 8192);
    const u32x4* qf = (const u32x4*)(prm.ws + WS_QF + (size_t)item * 8192);
    const f32x4* yf = (const f32x4*)(prm.ws + WS_YF + (size_t)item * 16384);
    bf16x8 qb[2][2];
#pragma unroll
    for (int kt = 0; kt < 2; ++kt)
#pragma unroll
        for (int s2 = 0; s2 < 2; ++s2) qb[kt][s2] = __builtin_bit_cast(bf16x8, qf[((kt * 2 + tt) * 2 + s2) * 64 + lane]);
    f32x16 y[2];
#pragma unroll
    for (int vt = 0; vt < 2; ++vt) {
#pragma unroll
        for (int rg = 0; rg < 4; ++rg) { const f32x4 v = yf[((vt * 2 + tt) * 64 + lane) * 4 + rg]; y[vt][4 * rg] = v[0]; y[vt][4 * rg + 1] = v[1]; y[vt][4 * rg + 2] = v[2]; y[vt][4 * rg + 3] = v[3]; }
#pragma unroll
        for (int kt = 0; kt < 2; ++kt)
#pragma unroll
            for (int s2 = 0; s2 < 2; ++s2) y[vt] = MFMA32(__builtin_bit_cast(bf16x8, sf[((vt * 2 + kt) * 2 + s2) * 64 + lane]), qb[kt][s2], y[vt]);
    }
    float sm = 0.f;
#pragma unroll
    for (int vt = 0; vt < 2; ++vt)
#pragma unroll
        for (int r = 0; r < 16; ++r) sm += y[vt][r];
    sm += __shfl_xor(sm, 32);
    const float mean = sm * (1.f / 64.f);
    float sq = 0.f;
#pragma unroll
    for (int vt = 0; vt < 2; ++vt)
#pragma unroll
        for (int r = 0; r < 16; ++r) { const float d = y[vt][r] - mean; sq += d * d; }
    sq += __shfl_xor(sq, 32);
    const float rstd = rsqrtf(sq * (1.f / 64.f) + 64e-5f);
    const int t = 64 * c + 32 * tt + l31;
    const size_t row = (size_t)b * SEQ + t;
    const float rho = ((const float*)(prm.ws + WS_RHO))[(size_t)item * 64 + 32 * tt + l31];
    const float* ZB = (const float*)(prm.ws + WS_ZB);
    const float* mu = prm.in[11]; const float* lg = prm.in[19]; const float* lb = prm.in[20];
    const bf16_t* Gb = (const bf16_t*)(prm.ws + WS_G); bf16_t* OG = (bf16_t*)(prm.ws + WS_OG);
#pragma unroll
    for (int vt = 0; vt < 2; ++vt)
#pragma unroll
        for (int rg = 0; rg < 4; ++rg) {
            const int v0 = 32 * vt + 8 * rg + 4 * hi, ch = h * 64 + v0;
            const f32x4 z = *(const f32x4*)(ZB + row * SHIFT_W + 2 * RW + ch);
            f32x4 zp = (f32x4){0.f, 0.f, 0.f, 0.f};
            if (t > 0) zp = *(const f32x4*)(ZB + (row - 1) * SHIFT_W + 2 * RW + ch);
            const f32x4 muv = *(const f32x4*)(mu + 2 * RW + ch), gv = *(const f32x4*)(lg + ch), bv = *(const f32x4*)(lb + ch);
            const u32x2 gw = *(const u32x2*)(Gb + row * DM + 384 + ch);
            const float gg[4] = {bflo(gw[0]), bfhi(gw[0]), bflo(gw[1]), bfhi(gw[1])};
            float o[4];
#pragma unroll
            for (int e = 0; e < 4; ++e) { const float vv = z[e] + (zp[e] - z[e]) * muv[e]; o[e] = ((y[vt][4 * rg + e] - mean) * rstd * gv[e] + bv[e] + rho * vv) * gg[e]; }
            *(u32x2*)(OG + row * DM + 384 + ch) = (u32x2){cvtpk(o[0], o[1]), cvtpk(o[2], o[3])};
        }
}

__device__ __forceinline__ void p0_transpose_item(const float* W, const float* gain, int K, int N, bf16_t* WT, int row_off, LAS float* scr, int item, int lane) {
    const int nblk = N / 32, kb = item / nblk, nb = item % nblk, k0 = 64 * kb, n0 = 32 * nb;
#pragma unroll 8
    for (int i = 0; i < 32; ++i) { const int kk = 2 * i + (lane >> 5); const float gk = gain ? gain[k0 + kk] : 1.f; scr[kk * 33 + (lane & 31)] = W[(size_t)(k0 + kk) * N + n0 + (lane & 31)] * gk; }
    LDS_WAIT(); asm volatile("" ::: "memory");
    const int c = lane & 7;
#pragma unroll
    for (int j = 0; j < 4; ++j) { const int n = (lane >> 3) + 8 * j; const LAS float* s = scr + (8 * c) * 33 + n;
        u32x4 o; o[0] = cvtpk(s[0 * 33], s[1 * 33]); o[1] = cvtpk(s[2 * 33], s[3 * 33]); o[2] = cvtpk(s[4 * 33], s[5 * 33]); o[3] = cvtpk(s[6 * 33], s[7 * 33]);
        *(u32x4*)(WT + (size_t)(row_off + n0 + n) * K + k0 + 8 * c) = o; }
    LDS_WAIT(); asm volatile("" ::: "memory");
}
__device__ __forceinline__ void sincos_acc(float angf, float& c, float& s) {
    const double a = (double)angf;
    const double kq = __builtin_rint(a * 0.63661977236758134308);
    const double r = (a - kq * 1.57079632679489655800) - kq * 6.12323399573676603587e-17;
    const double r2 = r * r;
    double sp = -1.0 / 1307674368000.0; sp = sp * r2 + 1.0 / 6227020800.0; sp = sp * r2 - 1.0 / 39916800.0; sp = sp * r2 + 1.0 / 362880.0; sp = sp * r2 - 1.0 / 5040.0; sp = sp * r2 + 1.0 / 120.0; sp = sp * r2 - 1.0 / 6.0; sp = sp * r2 + 1.0; sp *= r;
    double cp = 1.0 / 87178291200.0; cp = cp * r2 - 1.0 / 479001600.0; cp = cp * r2 + 1.0 / 3628800.0; cp = cp * r2 - 1.0 / 40320.0; cp = cp * r2 + 1.0 / 720.0; cp = cp * r2 - 1.0 / 24.0; cp = cp * r2 + 0.5; cp = 1.0 - cp * r2;
    const int qd = ((int)kq) & 3;
    const double sv = (qd == 0) ? sp : (qd == 1) ? cp : (qd == 2) ? -sp : -cp;
    const double cv = (qd == 0) ? cp : (qd == 1) ? -sp : (qd == 2) ? -cp : sp;
    c = (float)cv; s = (float)sv;
}
__device__ __forceinline__ void p0_prologue(const Ptrs& P, LAS unsigned char* lds, int bid, int G, int tid) {
    const int lane = tid & 63, wave = tid >> 6;
    LAS float* scr = (LAS float*)(lds + wave * 16384);
    const int gw = bid * 8 + wave, NGW = G * 8;
    constexpr int I_IN = (DM / 64) * (IN_W / 32), I_MEM = (DM / 64) * (512 / 32), I_OUT = (DM / 64) * (DM / 32);
    for (int it = gw; it < I_IN + I_MEM + I_OUT; it += NGW) {
        int r = it;
        if (r < I_IN) { p0_transpose_item(P.in[10], P.in[9], DM, IN_W, P.WT, 0, scr, r, lane); continue; } r -= I_IN;
        if (r < I_MEM) { p0_transpose_item(P.in[22], P.in[21], DM, 512, P.WT, NPAD, scr, r, lane); continue; } r -= I_MEM;
        p0_transpose_item(P.in[23], nullptr, DM, DM, P.WOT, 0, scr, r, lane);
    }
    const int gt = bid * NTHR + tid, NGT = G * NTHR;
    for (int e = gt; e < (NPAD - IN_W) * DM / 8; e += NGT) *(u32x4*)(P.WT + (size_t)IN_W * DM + (size_t)e * 8) = (u32x4){0u, 0u, 0u, 0u};
    for (int m = gw; m < MROWS; m += NGW) {
        const float* xr = (m < MP) ? P.in[0] + (size_t)m * DM : (m < MTOK) ? P.in[1] + (size_t)(m - MP) * DM : P.in[8] + (size_t)(m - MTOK) * DM;
        f32x4 v[4]; float ss = 0.f;
#pragma unroll
        for (int j = 0; j < 4; ++j) { v[j] = *(const f32x4*)(xr + (size_t)(64 * j + lane) * 4); ss += (v[j][0] * v[j][0] + v[j][1] * v[j][1]) + (v[j][2] * v[j][2] + v[j][3] * v[j][3]); }
        ss = wave_sum(ss);
        if (lane == 0) P.RINV[m] = rsqrtf(ss * (1.f / DM) + 1e-6f);
#pragma unroll
        for (int j = 0; j < 4; ++j) { u32x2 w; w[0] = cvtpk(v[j][0], v[j][1]); w[1] = cvtpk(v[j][2], v[j][3]); *(u32x2*)(P.XB + (size_t)m * DM + (size_t)(64 * j + lane) * 4) = w; }
    }
    for (int e = gt; e < NPOS * 8; e += NGT) {
        const int pos = e >> 3, i = e & 7;
        const float invf[8] = {1.0f, 0.19392274f, 0.03760603f, 0.0072926646f, 0.0014142136f, 0.0002742482f, 5.3182957e-05f, 1.0313385e-05f};
        float fi = invf[0];
#pragma unroll
        for (int k = 1; k < 8; ++k) fi = (i == k) ? invf[k] : fi;
        const float ang = (float)pos * fi; float c, s; sincos_acc(ang, c, s);
        P.ROPE[pos * 16 + i] = c; P.ROPE[pos * 16 + 8 + i] = s;
    }
    for (int e = gt; e < MTOK; e += NGT) P.SS[e] = 0.f;
}

__device__ __forceinline__ void p3_combine(const Ptrs& P, int bid, int G, int tid) {
    const int gt = bid * NTHR + tid, NGT = G * NTHR;
    for (int e = gt; e < MP * 48; e += NGT) {
        const int row = e / 48, ch = e % 48, h = ch >> 3;
        const float l0 = P.LSE[((size_t)0 * MP + row) * 6 + h], l1 = P.LSE[((size_t)1 * MP + row) * 6 + h], l2 = P.LSE[((size_t)2 * MP + row) * 6 + h];
        const float mx = fmaxf(l0, fmaxf(l1, l2)); const float e0 = __expf(l0 - mx), e1 = __expf(l1 - mx), e2 = __expf(l2 - mx); const float inv = 1.f / (e0 + e1 + e2);
        const float w0 = e0 * inv, w1 = e1 * inv, w2 = e2 * inv;
        const u32x4 a = *(const u32x4*)(P.OAP + ((size_t)0 * MP + row) * ATT_W + ch * 8), b = *(const u32x4*)(P.OAP + ((size_t)1 * MP + row) * ATT_W + ch * 8), c = *(const u32x4*)(P.OAP + ((size_t)2 * MP + row) * ATT_W + ch * 8);
        const u32x4 gg = *(const u32x4*)(P.Gb + (size_t)row * DM + ch * 8);
        u32x4 o;
#pragma unroll
        for (int k = 0; k < 4; ++k) {
            const float lo = (w0 * bflo(a[k]) + w1 * bflo(b[k]) + w2 * bflo(c[k])) * bflo(gg[k]);
            const float hi = (w0 * bfhi(a[k]) + w1 * bfhi(b[k]) + w2 * bfhi(c[k])) * bfhi(gg[k]);
            o[k] = cvtpk(lo, hi);
        }
        *(u32x4*)(P.OG + (size_t)row * DM + ch * 8) = o;
    }
}

__device__ __forceinline__ void p5_norm(const Ptrs& P, int bid, int G, int tid) {
    const int lane = tid & 63, wave = tid >> 6, gw = bid * 8 + wave, NGW = G * 8;
    const float* gf = P.in[24];
    for (int m = gw; m < MTOK; m += NGW) {
        const float rs = rsqrtf(P.SS[m] * (1.f / DM) + 1e-6f);
        float* yr = P.out + O_Y + (size_t)m * DM;
#pragma unroll
        for (int j = 0; j < 4; ++j) { const size_t c = (size_t)(64 * j + lane) * 4; const f32x4 v = *(const f32x4*)(yr + c); const f32x4 gv = *(const f32x4*)(gf + c); *(f32x4*)(yr + c) = v * rs * gv; }
    }
}

__global__ void __launch_bounds__(NTHR, 2) fwd_kernel(Params prm) {
    extern __shared__ __attribute__((aligned(16))) unsigned char lds_raw[];
    LAS unsigned char* lds = (LAS unsigned char*)lds_raw;
    const int tid = threadIdx.x, bid = blockIdx.x, G = gridDim.x;
    Ptrs P;
#pragma unroll
    for (int i = 0; i < 25; ++i) P.in[i] = prm.in[i];
    P.out = prm.out; P.ws = prm.ws;
    P.RINV = (float*)(prm.ws + WS_RINV); P.SS = (float*)(prm.ws + WS_SS); P.ROPE = (float*)(prm.ws + WS_ROPE); P.ZB = (float*)(prm.ws + WS_ZB); P.LSE = (float*)(prm.ws + WS_LSE);
    P.WT = (bf16_t*)(prm.ws + WS_WT); P.WOT = (bf16_t*)(prm.ws + WS_WOT); P.XB = (bf16_t*)(prm.ws + WS_XB); P.Qb = (bf16_t*)(prm.ws + WS_Q); P.Kb = (bf16_t*)(prm.ws + WS_K); P.Vb = (bf16_t*)(prm.ws + WS_V);
    P.QMb = (bf16_t*)(prm.ws + WS_QM); P.Gb = (bf16_t*)(prm.ws + WS_G); P.MKB = (bf16_t*)(prm.ws + WS_MKB); P.MVB = (bf16_t*)(prm.ws + WS_MVB); P.OAP = (bf16_t*)(prm.ws + WS_OAP); P.OG = (bf16_t*)(prm.ws + WS_OG);
    const int lo = prm.ph_lo, hi = prm.ph_hi;
#define IN_PH(k) (lo <= (k) && (k) < hi)
#define SEAM(k) do { if (IN_PH(k) && IN_PH((k) + 1)) { cg::this_grid().sync(); } } while (0)

    if (IN_PH(0)) { p0_prologue(P, lds, bid, G, tid); }
    SEAM(0);
    if (IN_PH(1)) {
        pg8::Gemm g{P.XB, P.WT, MROWS, NWT, DM}; Sched1 S; S.init(G, bid);
        Epi1 E{P.RINV, P.ROPE, P.Qb, P.Kb, P.Vb, P.QMb, P.Gb, P.MKB, P.MVB, P.ZB, P.out};
        pg8::gemm_phase<Epi1, Sched1, true, true>(lds, g, S, E);
    }
    SEAM(1);
#define ITEM_LOOP(LO, HI, B0, GG, CALL) do { int it = (LO) + (((B0) - (LO)) % (GG) + (GG)) % (GG); for (; it < (HI); it += (GG)) { const int li = it - (LO); CALL; } } while (0)
    if (IN_PH(2)) {
        constexpr int N0 = N_L_ITEMS, N1 = N0 + N_SCAN_S;
        ITEM_LOOP(0, N0, bid, G, passL_item(prm, lds, li, tid));
        ITEM_LOOP(N0, N1, bid, G, scan_item(P, lds, true, li / 6, li % 6, tid));
    }
    SEAM(2);
    if (IN_PH(3)) {
        if (bid < N_S_BLOCKS) passS_block(prm, lds, bid, tid);
        else {
            constexpr int N1 = N_DIL_UNITS, N2 = N1 + N_MEMA_UNITS, N3 = N2 + N_SDIL_ITEMS, N4 = N3 + N_SMEM_ITEMS;
            const int b0 = bid - N_S_BLOCKS, gg = G - N_S_BLOCKS;
            ITEM_LOOP(0, N1, b0, gg, dil_unit(P, lds, li, tid));
            ITEM_LOOP(N1, N2, b0, gg, mem_unit(P, lds, li, tid));
            ITEM_LOOP(N2, N3, b0, gg, sdil_item(P, lds, li, tid));
            ITEM_LOOP(N3, N4, b0, gg, smem_item(P, lds, li, tid));
        }
    }
    SEAM(3);
    if (IN_PH(4)) {
        for (int pr = bid * 8 + (tid >> 6); pr < 2 * N_L_ITEMS; pr += G * 8) passO_pair(prm, pr >> 1, pr & 1, tid & 63);
        p3_combine(P, bid, G, tid);
    }
    SEAM(4);
    if (IN_PH(5)) {
        pg8::Gemm g{P.OG, P.WOT, MTOK, DM, DM}; pg8::StaticOrder S; S.init(MTOK, DM, G, bid);
        Epi2 E{P.in[0], P.in[1], P.out + O_Y, P.SS};
        pg8::gemm_phase<Epi2, pg8::StaticOrder, true, true>(lds, g, S, E);
    }
    SEAM(5);
    if (IN_PH(6)) { p5_norm(P, bid, G, tid); }
}

constexpr int N_PHASES = 7;
#ifndef MK_ONE_LAUNCH
#define MK_ONE_LAUNCH 1
#endif
extern "C" void kernel_launch(void* const* d_in, const int* in_sizes, int n_in, void* d_out, int out_size, void* d_ws, size_t ws_size, hipStream_t stream) {
    static int grid = 0;
    if (grid == 0) {
        if (n_in != 25 || out_size != (int)O_END || ws_size < WS_END2) { fprintf(stderr, "kernel_launch: unexpected shapes (n_in %d, out %d, ws %zu < %zu)\n", n_in, out_size, ws_size, (size_t)WS_END2); grid = -1; return; }
        int dev = 0, cus = 0, per_cu = 0;
        (void)hipGetDevice(&dev); (void)hipDeviceGetAttribute(&cus, hipDeviceAttributeMultiprocessorCount, dev);
        if (hipFuncSetAttribute((const void*)fwd_kernel, hipFuncAttributeMaxDynamicSharedMemorySize, LDS_BYTES) != hipSuccess) { fprintf(stderr, "kernel_launch: hipFuncSetAttribute failed\n"); grid = -1; return; }
        if (hipOccupancyMaxActiveBlocksPerMultiprocessor(&per_cu, (const void*)fwd_kernel, NTHR, LDS_BYTES) != hipSuccess || per_cu < 1) { fprintf(stderr, "kernel_launch: occupancy query says %d blocks per CU\n", per_cu); (void)hipGetLastError(); per_cu = 1; }
        grid = cus;
    }
    if (grid < 0) return;
    Params p{};
    for (int i = 0; i < 25; ++i) p.in[i] = (const float*)d_in[i];
    p.out = (float*)d_out; p.ws = (unsigned char*)d_ws;
#if MK_ONE_LAUNCH
    p.ph_lo = 0; p.ph_hi = N_PHASES; p.coop = 1;
    void* args[] = {&p};
    hipError_t e = hipLaunchCooperativeKernel((const void*)fwd_kernel, dim3(grid), dim3(NTHR), args, LDS_BYTES, stream);
    if (e != hipSuccess) fprintf(stderr, "cooperative launch failed: %s (grid %d)\n", hipGetErrorString(e), grid);
#else
    for (int ph = 0; ph < N_PHASES; ++ph) {
        p.ph_lo = ph; p.ph_hi = ph + 1; p.coop = 0;
        hipLaunchKernelGGL(fwd_kernel, dim3(grid), dim3(NTHR), LDS_BYTES, stream, p);
    }
#endif
}
```

```cpp
#include <hip/hip_runtime.h>
#include <hip/hip_cooperative_groups.h>
#include <cstdio>
#include <cstdint>
namespace cg = cooperative_groups;

#define LAS __attribute__((address_space(3)))
typedef unsigned short bf16_t;
typedef short bf16x8 __attribute__((ext_vector_type(8)));
typedef short s16x4 __attribute__((ext_vector_type(4)));
typedef float f32x4 __attribute__((ext_vector_type(4)));
typedef float f32x2 __attribute__((ext_vector_type(2)));
typedef float f32x16 __attribute__((ext_vector_type(16)));
typedef unsigned u32x4 __attribute__((ext_vector_type(4)));
typedef unsigned u32x2 __attribute__((ext_vector_type(2)));
typedef __bf16 bf16x2_t __attribute__((ext_vector_type(2)));

constexpr int DM = 1024, SEQ = 8192, NB = 2, DB = 32, DT = 8;
constexpr int MP = NB * SEQ;
constexpr int MS = DB * DT;
constexpr int MTOK = MP + MS;
constexpr int NMEM = 256, MMEM = NB * NMEM;
constexpr int MROWS = MTOK + MMEM;
constexpr int ATT_W = 384, RW = 384, MEM_W = 256, SHIFT_W = 1280, IN_W = 3712;
constexpr int NPAD = 3840;
constexpr int NWT = NPAD + 512;
constexpr int WINP = 2048;
constexpr int C_Q = 0, C_K = 384, C_V = 768, C_Z = 1152, C_QM = 2432, C_G = 2688;
constexpr size_t O_Y = 0, O_WK_P = 17039360, O_WV_P = 18612224, O_ST_P = 20185088, O_SH_P = 20234240, O_MK_P = 20236800, O_MV_P = 20367872,
                 O_WK_S = 20498944, O_WV_S = 20597248, O_ST_S = 20695552, O_SH_S = 21481984, O_END = 21522944;
constexpr size_t al256(size_t x) { return (x + 255) & ~(size_t)255; }
constexpr size_t WS_CTL = 0;
constexpr size_t WS_RINV = 1u << 20;
constexpr size_t WS_SS = al256(WS_RINV + (size_t)MROWS * 4);
constexpr size_t WS_ROPE = al256(WS_SS + (size_t)MTOK * 4);
constexpr int NPOS = 8200;
constexpr size_t WS_WT = al256(WS_ROPE + (size_t)NPOS * 16 * 4);
constexpr size_t WS_WOT = al256(WS_WT + (size_t)NWT * DM * 2);
constexpr size_t WS_XB = al256(WS_WOT + (size_t)DM * DM * 2);
constexpr size_t WS_Q = al256(WS_XB + (size_t)MROWS * DM * 2);
constexpr size_t WS_K = al256(WS_Q + (size_t)MTOK * ATT_W * 2);
constexpr size_t WS_V = al256(WS_K + (size_t)MTOK * ATT_W * 2);
constexpr size_t WS_ZB = al256(WS_V + (size_t)MTOK * ATT_W * 2);
constexpr size_t WS_QM = al256(WS_ZB + (size_t)MTOK * SHIFT_W * 4);
constexpr size_t WS_G = al256(WS_QM + (size_t)MTOK * MEM_W * 2);
constexpr size_t WS_MKB = al256(WS_G + (size_t)MTOK * DM * 2);
constexpr size_t WS_MVB = al256(WS_MKB + (size_t)MMEM * MEM_W * 2);
constexpr size_t WS_OAP = al256(WS_MVB + (size_t)MMEM * MEM_W * 2);
constexpr size_t WS_LSE = al256(WS_OAP + (size_t)3 * MP * ATT_W * 2);
constexpr size_t WS_OG = al256(WS_LSE + (size_t)3 * MP * 6 * 4);
constexpr size_t WS_END = al256(WS_OG + (size_t)MTOK * DM * 2);

constexpr int LDS_BYTES = 147456;
constexpr int NTHR = 512;

struct Params {
    const float* in[25];
    float* out;
    unsigned char* ws;
    int ph_lo, ph_hi, coop, pad;
};

__device__ __forceinline__ unsigned cvtpk(float lo, float hi) { f32x2 v = {lo, hi}; bf16x2_t b = __builtin_convertvector(v, bf16x2_t); return __builtin_bit_cast(unsigned, b); }
__device__ __forceinline__ bf16_t f2bf(float f) { return (bf16_t)(cvtpk(f, 0.f) & 0xffffu); }
__device__ __forceinline__ float bf2f(bf16_t b) { return __builtin_bit_cast(float, (unsigned)b << 16); }
__device__ __forceinline__ float bflo(unsigned w) { return __builtin_bit_cast(float, w << 16); }
__device__ __forceinline__ float bfhi(unsigned w) { return __builtin_bit_cast(float, w & 0xffff0000u); }
__device__ __forceinline__ float wave_sum(float v) {
#pragma unroll
    for (int o = 1; o < 64; o <<= 1) v += __shfl_xor(v, o);
    return v;
}
__device__ __forceinline__ float wave_max(float v) {
#pragma unroll
    for (int o = 1; o < 64; o <<= 1) v = fmaxf(v, __shfl_xor(v, o));
    return v;
}
template <int CTRL> __device__ __forceinline__ float dpp_f(float v) { return __builtin_bit_cast(float, __builtin_amdgcn_update_dpp(0, __builtin_bit_cast(int, v), CTRL, 0xf, 0xf, true)); }
__device__ __forceinline__ float sum8(float v) { v += dpp_f<0xB1>(v); v += dpp_f<0x4E>(v); v += dpp_f<0x141>(v); return v; }
#define LDS_WAIT() asm volatile("s_waitcnt lgkmcnt(0)" ::: "memory")

namespace pg8 {
constexpr int BM = 256, BK = 64, HALF = 128, HTB = HALF * BK * 2, STAGE_BYTES = 8 * HTB, NXCD = 8, WGM = 8;
__host__ __device__ __forceinline__ int lds_byte(int r, int c) { const int st = (r >> 4) * 2 + (c >> 5), rr = r & 15, cc = c & 31, ob = rr * 64 + cc * 2; return st * 1024 + (ob ^ (((ob >> 9) & 1) << 5)); }
__host__ __device__ __forceinline__ void stage_rc(int b, int& R, int& C) { const int st = b / 1024, sb = b % 1024, swz = sb ^ (((sb >> 9) & 1) << 5); R = (st >> 1) * 16 + swz / 64; C = (st & 1) * 32 + (swz % 64) / 2; }
__host__ __device__ __forceinline__ int perm32(int rho) { const int n = rho >> 4, i = rho & 15; return 8 * (i >> 2) + 4 * n + (i & 3); }
struct Unit { int pm, pn; };
struct Gemm { const bf16_t* A; const bf16_t* Bt; int M, N, K; };
struct StaticOrder {
    int nM, nN, nwg, G, c;
    __host__ __device__ void init(int M, int N, int G_, int c_) { nM = M / BM; nN = N / BM; nwg = nM * nN; G = G_; c = c_; }
    __host__ __device__ bool next(int i, Unit& u) const {
        const long L = (long)i * G + c; if (L >= nwg) return false;
        int wgid = (int)L; { const int q = nwg / NXCD, r = nwg % NXCD, xcd = wgid % NXCD, off = wgid / NXCD; wgid = (xcd < r ? xcd * (q + 1) : r * (q + 1) + (xcd - r) * q) + off; }
        const int nig = WGM * nN, gid = wgid / nig, fm = gid * WGM, gsz = (nM - fm) < WGM ? (nM - fm) : WGM;
        u.pm = fm + ((wgid % nig) % gsz); u.pn = (wgid % nig) / gsz; return true;
    }
    __device__ __forceinline__ void a_ready(const Unit&) const {}
    __device__ __forceinline__ void done(const Unit&) const {}
};

template <class Epi, class Sched, bool ALIGN_EPI = false, bool SP2 = false>
__device__ __forceinline__ void gemm_phase(LAS unsigned char* lds, const Gemm g, const Sched& S, const Epi& E) {
    const int tid = threadIdx.x, wid = __builtin_amdgcn_readfirstlane(tid >> 6), lane = tid & 63, wr = wid >> 2, wc = wid & 3, fr = lane & 15, fq = lane >> 4;
    const int K = g.K, nt = K / BK;
    unsigned voffA[2], voffB[2];
#pragma unroll
    for (int i = 0; i < 2; ++i) { int R, C; stage_rc(tid * 16 + i * 8192, R, C); const int Rb = Epi::PERM ? ((R & ~31) + perm32(R & 31)) : R;
        voffA[i] = (unsigned)(R * K + C) * 2u; voffB[i] = (unsigned)(Rb * K + C) * 2u; }
    const size_t kstep = (size_t)(BK * 2);
    const size_t hstep = (size_t)HALF * K * 2;
    const size_t tstep = 2 * hstep;
    const unsigned ldsw = (unsigned)wid * 1024u;
    const int aoff = lds_byte(wr * 64 + fr, fq * 8), boff = lds_byte(wc * 32 + fr, fq * 8);
#define PG8_SA(b, h) (((b) * 2 + (h)) * HTB)
#define PG8_SB(b, h) ((4 + (b) * 2 + (h)) * HTB)
#define PG8_STAGE(bufoff, gbase, voff) do { _Pragma("unroll") for (int _i = 0; _i < 2; ++_i) \
        __builtin_amdgcn_global_load_lds((const unsigned*)((const char*)(gbase) + (voff)[_i]), (LAS unsigned*)(lds + (bufoff) + ldsw + _i * 8192), 16, 0, 0); } while (0)
#define PG8_LDA(dst, b, h) do { _Pragma("unroll") for (int m = 0; m < 4; ++m) _Pragma("unroll") for (int k = 0; k < 2; ++k) dst[m][k] = *(const LAS bf16x8*)(lds + PG8_SA(b, h) + aoff + m * 2048 + k * 1024); } while (0)
#define PG8_LDB(dst, b, h) do { _Pragma("unroll") for (int n = 0; n < 2; ++n) _Pragma("unroll") for (int k = 0; k < 2; ++k) dst[n][k] = *(const LAS bf16x8*)(lds + PG8_SB(b, h) + boff + n * 2048 + k * 1024); } while (0)
#define PG8_MMA(ai, bj, At, Bt) do { __builtin_amdgcn_s_setprio(1); _Pragma("unroll") for (int m = 0; m < 4; ++m) _Pragma("unroll") for (int n = 0; n < 2; ++n) _Pragma("unroll") for (int k = 0; k < 2; ++k) \
        acc[ai][bj][m][n] = __builtin_amdgcn_mfma_f32_16x16x32_bf16(Bt[n][k], At[m][k], acc[ai][bj][m][n], 0, 0, 0); __builtin_amdgcn_s_setprio(0); } while (0)
#define PG8_WAIT_V(n) asm volatile("s_waitcnt vmcnt(" #n ")" ::: "memory")
#define PG8_WAIT_L(n) asm volatile("s_waitcnt lgkmcnt(" #n ")" ::: "memory")
#define PG8_BAR __builtin_amdgcn_s_barrier()
#define PG8_SCHED __builtin_amdgcn_sched_barrier(0)
    Unit cur, nxt; int ui = 0;
    if (!S.next(0, cur)) return;
    f32x4 acc[2][2][4][2];
#pragma unroll
    for (int a = 0; a < 2; ++a)
#pragma unroll
        for (int b = 0; b < 2; ++b)
#pragma unroll
            for (int m = 0; m < 4; ++m)
#pragma unroll
                for (int n = 0; n < 2; ++n) acc[a][b][m][n] = (f32x4){0.f, 0.f, 0.f, 0.f};
    bf16x8 At[4][2], B0[2][2], B1[2][2];
    const char* cA = (const char*)g.A + (size_t)cur.pm * tstep; const char* cB = (const char*)g.Bt + (size_t)cur.pn * tstep;
    S.a_ready(cur);
    if constexpr (SP2) {
        PG8_STAGE(PG8_SB(0, 0), cB, voffB); PG8_STAGE(PG8_SB(0, 1), cB + hstep, voffB); PG8_STAGE(PG8_SA(0, 0), cA, voffA); PG8_STAGE(PG8_SA(0, 1), cA + hstep, voffA);
        if (wr == 1) PG8_BAR;
        PG8_WAIT_V(2); PG8_BAR;
        PG8_STAGE(PG8_SB(1, 0), cB + kstep, voffB); PG8_STAGE(PG8_SA(1, 0), cA + kstep, voffA); PG8_STAGE(PG8_SB(1, 1), cB + hstep + kstep, voffB);
        PG8_WAIT_V(6); PG8_BAR;
    } else {
        PG8_STAGE(PG8_SB(0, 0), cB, voffB); PG8_STAGE(PG8_SA(0, 0), cA, voffA); PG8_STAGE(PG8_SB(0, 1), cB + hstep, voffB); PG8_STAGE(PG8_SA(0, 1), cA + hstep, voffA);
        if (wr == 1) PG8_BAR;
        PG8_WAIT_V(4); PG8_BAR;
        PG8_STAGE(PG8_SB(1, 0), cB + kstep, voffB); PG8_STAGE(PG8_SA(1, 0), cA + kstep, voffA); PG8_STAGE(PG8_SB(1, 1), cB + hstep + kstep, voffB);
        PG8_WAIT_V(6); PG8_BAR;
    }
    for (;;) {
        const bool has_next = S.next(ui + 1, nxt);
        const char* nA = has_next ? (const char*)g.A + (size_t)nxt.pm * tstep : cA; const char* nB = has_next ? (const char*)g.Bt + (size_t)nxt.pn * tstep : cB;
        for (int t = 0; t < nt; t += 2) {
            const bool last = (t == nt - 2);
            const char* a1 = cA + (size_t)(t + 1) * kstep;
            const char* a2 = last ? nA : cA + (size_t)(t + 2) * kstep; const char* b2 = last ? nB : cB + (size_t)(t + 2) * kstep;
            const char* a3 = a2 + kstep; const char* b3 = b2 + kstep;
            if (last && has_next) S.a_ready(nxt);
            if constexpr (SP2) {
            PG8_LDB(B0, 0, 0); PG8_LDB(B1, 0, 1); PG8_SCHED; PG8_LDA(At, 0, 0); PG8_STAGE(PG8_SA(1, 1), a1 + hstep, voffA);
            PG8_WAIT_V(8); PG8_WAIT_L(0); PG8_BAR; PG8_MMA(0, 0, At, B0); PG8_MMA(0, 1, At, B1); PG8_BAR; PG8_SCHED;
            PG8_LDA(At, 0, 1); PG8_STAGE(PG8_SB(0, 0), b2, voffB); PG8_STAGE(PG8_SB(0, 1), b2 + hstep, voffB); PG8_STAGE(PG8_SA(0, 0), a2, voffA);
            PG8_WAIT_V(8); PG8_WAIT_L(0); PG8_BAR; PG8_MMA(1, 0, At, B0); PG8_MMA(1, 1, At, B1); PG8_BAR; PG8_SCHED;
            PG8_LDB(B0, 1, 0); PG8_LDB(B1, 1, 1); PG8_SCHED; PG8_LDA(At, 1, 0); PG8_STAGE(PG8_SA(0, 1), a2 + hstep, voffA);
            PG8_WAIT_V(8); PG8_WAIT_L(0); PG8_BAR; PG8_MMA(0, 0, At, B0); PG8_MMA(0, 1, At, B1); PG8_BAR; PG8_SCHED;
            PG8_LDA(At, 1, 1); PG8_STAGE(PG8_SB(1, 0), b3, voffB); PG8_STAGE(PG8_SB(1, 1), b3 + hstep, voffB); PG8_STAGE(PG8_SA(1, 0), a3, voffA);
            PG8_WAIT_V(8); PG8_WAIT_L(0); PG8_BAR; PG8_MMA(1, 0, At, B0); PG8_MMA(1, 1, At, B1); PG8_BAR; PG8_SCHED;
            } else {
            PG8_LDB(B0, 0, 0); PG8_SCHED; PG8_LDA(At, 0, 0); PG8_STAGE(PG8_SA(1, 1), a1 + hstep, voffA);
            PG8_WAIT_L(8); PG8_BAR; PG8_WAIT_L(0); PG8_MMA(0, 0, At, B0); PG8_BAR; PG8_SCHED;
            PG8_LDB(B1, 0, 1); PG8_STAGE(PG8_SB(0, 0), b2, voffB);
            PG8_BAR; PG8_WAIT_L(0); PG8_MMA(0, 1, At, B1); PG8_BAR;
            PG8_LDA(At, 0, 1); PG8_STAGE(PG8_SA(0, 0), a2, voffA);
            PG8_BAR; PG8_WAIT_L(0); PG8_MMA(1, 0, At, B0); PG8_BAR; PG8_SCHED;
            PG8_STAGE(PG8_SB(0, 1), b2 + hstep, voffB);
            PG8_WAIT_V(6); PG8_BAR; PG8_MMA(1, 1, At, B1); PG8_BAR;
            PG8_LDB(B0, 1, 0); PG8_SCHED; PG8_LDA(At, 1, 0); PG8_STAGE(PG8_SA(0, 1), a2 + hstep, voffA);
            PG8_WAIT_L(8); PG8_BAR; PG8_WAIT_L(0); PG8_MMA(0, 0, At, B0); PG8_BAR; PG8_SCHED;
            PG8_LDB(B1, 1, 1); PG8_STAGE(PG8_SB(1, 0), b3, voffB);
            PG8_BAR; PG8_WAIT_L(0); PG8_MMA(0, 1, At, B1); PG8_BAR;
            PG8_LDA(At, 1, 1); PG8_STAGE(PG8_SA(1, 0), a3, voffA);
            PG8_BAR; PG8_WAIT_L(0); PG8_MMA(1, 0, At, B0); PG8_BAR; PG8_SCHED;
            PG8_STAGE(PG8_SB(1, 1), b3 + hstep, voffB);
            PG8_WAIT_V(6); PG8_BAR; PG8_MMA(1, 1, At, B1); PG8_BAR;
            }
        }
        if constexpr (ALIGN_EPI) { if (wr == 0) PG8_BAR; }
        if constexpr (!Epi::AFTER_DRAIN) { E(acc, cur, wr, wc, fr, fq); S.done(cur); }
        if (!has_next) break;
#pragma unroll
        for (int a = 0; a < 2; ++a)
#pragma unroll
            for (int b = 0; b < 2; ++b)
#pragma unroll
                for (int m = 0; m < 4; ++m)
#pragma unroll
                    for (int n = 0; n < 2; ++n) acc[a][b][m][n] = (f32x4){0.f, 0.f, 0.f, 0.f};
        cur = nxt; cA = nA; cB = nB; ++ui;
        if constexpr (ALIGN_EPI) { if (wr == 1) PG8_BAR; }
    }
    PG8_WAIT_V(0);
    if constexpr (!ALIGN_EPI) { if (wr == 0) PG8_BAR; }
    PG8_BAR;
    if constexpr (Epi::AFTER_DRAIN) { E.fused(acc, cur, wr, wc, fr, fq, lds, wid, lane); S.done(cur); }
#undef PG8_SA
#undef PG8_SB
#undef PG8_STAGE
#undef PG8_LDA
#undef PG8_LDB
#undef PG8_MMA
#undef PG8_WAIT_V
#undef PG8_WAIT_L
#undef PG8_BAR
#undef PG8_SCHED
}
}

constexpr int G1_NM = MTOK / 256, G1_NN = NPAD / 256, G1_MAIN = G1_NM * G1_NN, G1_UNITS = G1_MAIN + 4;
struct Sched1 {
    pg8::StaticOrder so;
    __device__ void init(int G, int c) { so.init(MTOK, NPAD, G, c); }
    __device__ bool next(int i, pg8::Unit& u) const {
        const long L = (long)i * so.G + so.c;
        if (L >= G1_UNITS) return false;
        if (L >= G1_MAIN) { const int e = (int)L - G1_MAIN; u.pm = G1_NM + (e >> 1); u.pn = G1_NN + (e & 1); return true; }
        return so.next(i, u);
    }
    __device__ __forceinline__ void a_ready(const pg8::Unit&) const {}
    __device__ __forceinline__ void done(const pg8::Unit&) const {}
};

struct Epi1 {
    static constexpr bool PERM = true, AFTER_DRAIN = false;
    const float* rinv; const float* rope; bf16_t *Qb, *Kb, *Vb, *QMb, *Gb, *MKB, *MVB; float* ZB; float* out;
    __device__ __forceinline__ void operator()(const f32x4 (&acc)[2][2][4][2], const pg8::Unit& u, int wr, int wc, int fr, int fq) const {
        const bool memu = u.pm >= G1_NM;
#pragma unroll
        for (int ai = 0; ai < 2; ++ai)
#pragma unroll
            for (int m = 0; m < 4; ++m) {
                const int row = u.pm * 256 + ai * 128 + wr * 64 + m * 16 + fr;
                const float rs = rinv[row];
#pragma unroll
                for (int bj = 0; bj < 2; ++bj) {
                    const int c0 = u.pn * 256 + bj * 128 + wc * 32 + 8 * fq;
                    float v[8];
#pragma unroll
                    for (int e = 0; e < 4; ++e) { v[e] = acc[ai][bj][m][0][e] * rs; v[4 + e] = acc[ai][bj][m][1][e] * rs; }
                    if (memu) {
                        const int mrow = row - MTOK, mc = c0 - NPAD;
                        float* of = out + (mc < 256 ? O_MK_P : O_MV_P) + (size_t)mrow * 256 + (mc & 255);
                        *(f32x4*)of = (f32x4){v[0], v[1], v[2], v[3]}; *(f32x4*)(of + 4) = (f32x4){v[4], v[5], v[6], v[7]};
                        bf16_t* ob = (mc < 256 ? MKB : MVB) + (size_t)mrow * 256 + (mc & 255);
                        *(u32x4*)ob = (u32x4){cvtpk(v[0], v[1]), cvtpk(v[2], v[3]), cvtpk(v[4], v[5]), cvtpk(v[6], v[7])};
                        continue;
                    }
                    const int cb = c0 >> 7;
                    const bool samp = row >= MP;
                    const int srow = row - MP;
                    if (cb < 6) {
                        if ((wc & 1) == 0) {
                            float pr[8];
#pragma unroll
                            for (int e = 0; e < 8; ++e) pr[e] = __shfl_xor(v[e], 16);
                            if (fq < 2) {
                                const int pos = samp ? (SEQ + (srow & 7)) : (row & (SEQ - 1));
                                const f32x4 c0v = *(const f32x4*)(rope + (size_t)pos * 16), c1v = *(const f32x4*)(rope + (size_t)pos * 16 + 4);
                                const f32x4 s0v = *(const f32x4*)(rope + (size_t)pos * 16 + 8), s1v = *(const f32x4*)(rope + (size_t)pos * 16 + 12);
                                const float cs[8] = {c0v[0], c0v[1], c0v[2], c0v[3], c1v[0], c1v[1], c1v[2], c1v[3]};
                                const float sn[8] = {s0v[0], s0v[1], s0v[2], s0v[3], s1v[0], s1v[1], s1v[2], s1v[3]};
                                const float sg = (fq == 0) ? -1.f : 1.f;
#pragma unroll
                                for (int e = 0; e < 8; ++e) v[e] = v[e] * cs[e] + sg * pr[e] * sn[e];
                            }
                        }
                        if (cb < 3) {
#pragma unroll
                            for (int e = 0; e < 8; ++e) v[e] *= 0.125f;
                            *(u32x4*)(Qb + (size_t)row * ATT_W + c0) = (u32x4){cvtpk(v[0], v[1]), cvtpk(v[2], v[3]), cvtpk(v[4], v[5]), cvtpk(v[6], v[7])};
                        } else {
                            const int cc = c0 - C_K;
                            *(u32x4*)(Kb + (size_t)row * ATT_W + cc) = (u32x4){cvtpk(v[0], v[1]), cvtpk(v[2], v[3]), cvtpk(v[4], v[5]), cvtpk(v[6], v[7])};
                            float* of = nullptr;
                            if (samp) of = out + O_WK_S + (size_t)srow * ATT_W + cc;
                            else { const int t = row & (SEQ - 1); if (t >= SEQ - WINP) of = out + O_WK_P + ((size_t)(row >> 13) * WINP + (t - (SEQ - WINP))) * ATT_W + cc; }
                            if (of) { *(f32x4*)of = (f32x4){v[0], v[1], v[2], v[3]}; *(f32x4*)(of + 4) = (f32x4){v[4], v[5], v[6], v[7]}; }
                        }
                    } else if (cb < 9) {
                        const int cc = c0 - C_V;
                        *(u32x4*)(Vb + (size_t)row * ATT_W + cc) = (u32x4){cvtpk(v[0], v[1]), cvtpk(v[2], v[3]), cvtpk(v[4], v[5]), cvtpk(v[6], v[7])};
                        float* of = nullptr;
                        if (samp) of = out + O_WV_S + (size_t)srow * ATT_W + cc;
                        else { const int t = row & (SEQ - 1); if (t >= SEQ - WINP) of = out + O_WV_P + ((size_t)(row >> 13) * WINP + (t - (SEQ - WINP))) * ATT_W + cc; }
                        if (of) { *(f32x4*)of = (f32x4){v[0], v[1], v[2], v[3]}; *(f32x4*)(of + 4) = (f32x4){v[4], v[5], v[6], v[7]}; }
                    } else if (cb < 19) {
                        const int cc = c0 - C_Z;
                        float* zf = ZB + (size_t)row * SHIFT_W + cc;
                        *(f32x4*)zf = (f32x4){v[0], v[1], v[2], v[3]}; *(f32x4*)(zf + 4) = (f32x4){v[4], v[5], v[6], v[7]};
                        float* of = nullptr;
                        if (samp) { if ((srow & 7) == 7) of = out + O_SH_S + (size_t)(srow >> 3) * SHIFT_W + cc; }
                        else if ((row & (SEQ - 1)) == SEQ - 1) of = out + O_SH_P + (size_t)(row >> 13) * SHIFT_W + cc;
                        if (of) { *(f32x4*)of = (f32x4){v[0], v[1], v[2], v[3]}; *(f32x4*)(of + 4) = (f32x4){v[4], v[5], v[6], v[7]}; }
                    } else if (cb < 21) {
                        const int cc = c0 - C_QM;
#pragma unroll
                        for (int e = 0; e < 8; ++e) v[e] *= 0.125f;
                        *(u32x4*)(QMb + (size_t)row * MEM_W + cc) = (u32x4){cvtpk(v[0], v[1]), cvtpk(v[2], v[3]), cvtpk(v[4], v[5]), cvtpk(v[6], v[7])};
                    } else if (cb < 29) {
                        const int cc = c0 - C_G;
#pragma unroll
                        for (int e = 0; e < 8; ++e) v[e] = v[e] / (1.f + __expf(-v[e]));
                        *(u32x4*)(Gb + (size_t)row * DM + cc) = (u32x4){cvtpk(v[0], v[1]), cvtpk(v[2], v[3]), cvtpk(v[4], v[5]), cvtpk(v[6], v[7])};
                    }
                }
            }
    }
};

struct Epi2 {
    static constexpr bool PERM = false, AFTER_DRAIN = false;
    const float* xp; const float* xs; float* Y; float* SS;
    __device__ __forceinline__ void operator()(const f32x4 (&acc)[2][2][4][2], const pg8::Unit& u, int wr, int wc, int fr, int fq) const {
#pragma unroll
        for (int ai = 0; ai < 2; ++ai)
#pragma unroll
            for (int m = 0; m < 4; ++m) {
                const int row = u.pm * 256 + ai * 128 + wr * 64 + m * 16 + fr;
                const float* xr = (row < MP) ? xp + (size_t)row * DM : xs + (size_t)(row - MP) * DM;
                float ss = 0.f;
#pragma unroll
                for (int bj = 0; bj < 2; ++bj)
#pragma unroll
                    for (int n = 0; n < 2; ++n) {
                        const int c = u.pn * 256 + bj * 128 + wc * 32 + n * 16 + 4 * fq;
                        const f32x4 xv = *(const f32x4*)(xr + c);
                        const f32x4 o = xv + acc[ai][bj][m][n];
                        ss += (o[0] * o[0] + o[1] * o[1]) + (o[2] * o[2] + o[3] * o[3]);
                        *(f32x4*)(Y + (size_t)row * DM + c) = o;
                    }
                ss += __shfl_xor(ss, 16); ss += __shfl_xor(ss, 32);
                if (fq == 0) atomicAdd(SS + row, ss);
            }
    }
};

constexpr int KS = 144, VS = 144;
constexpr float L2E = 1.4426950408889634f;
__device__ __forceinline__ int crow(int r, int hi) { return (r & 3) + 8 * (r >> 2) + 4 * hi; }
typedef short v4i16_t __attribute__((ext_vector_type(4)));
__device__ __forceinline__ s16x4 vtr(LAS const unsigned char* p) { return __builtin_bit_cast(s16x4, __builtin_amdgcn_ds_read_tr16_b64_v4i16((LAS v4i16_t*)p)); }

template <int NTG, int NG, bool BAND>
__device__ __forceinline__ void strip_attn(const bf16x8 (&qf)[4], LAS const unsigned char* Kl, LAS const unsigned char* Vl, int krow0, int lane, int kmin,
                                           f32x16 (&o)[2], float& m_out, float& l_out) {
    const int q = lane & 31, hi = lane >> 5;
    float m_run = -INFINITY, l_run = 0.f;
#pragma unroll
    for (int r = 0; r < 16; ++r) { o[0][r] = 0.f; o[1][r] = 0.f; }
#pragma unroll
    for (int g = 0; g < NG; ++g) {
        f32x16 S[NTG];
#pragma unroll
        for (int t = 0; t < NTG; ++t) {
#pragma unroll
            for (int r = 0; r < 16; ++r) S[t][r] = 0.f;
            LAS const unsigned char* kp = Kl + (size_t)(krow0 + (g * NTG + t) * 32 + q) * KS + hi * 16;
#pragma unroll
            for (int d0 = 0; d0 < 4; ++d0) {
                const bf16x8 kf = *(LAS const bf16x8*)(kp + d0 * 32);
                S[t] = __builtin_amdgcn_mfma_f32_32x32x16_bf16(kf, qf[d0], S[t], 0, 0, 0);
            }
        }
        float mx = -INFINITY;
#pragma unroll
        for (int t = 0; t < NTG; ++t)
#pragma unroll
            for (int r = 0; r < 16; ++r) {
                if (BAND) { const int ko = 32 * (g * NTG + t) + crow(r, hi); if (ko < q || ko > q + 128 || ko < kmin) S[t][r] = -INFINITY; }
                mx = fmaxf(mx, S[t][r]);
            }
        mx = fmaxf(mx, __shfl_xor(mx, 32));
        const float m_new = fmaxf(m_run, mx);
        const float alpha = __builtin_amdgcn_exp2f((m_run - m_new) * L2E);
        float ls = 0.f;
#pragma unroll
        for (int t = 0; t < NTG; ++t)
#pragma unroll
            for (int r = 0; r < 16; ++r) { const float p = __builtin_amdgcn_exp2f((S[t][r] - m_new) * L2E); S[t][r] = p; ls += p; }
        ls += __shfl_xor(ls, 32);
        l_run = l_run * alpha + ls; m_run = m_new;
        if (g > 0) {
#pragma unroll
            for (int r = 0; r < 16; ++r) { const float a = __shfl(alpha, crow(r, hi)); o[0][r] *= a; o[1][r] *= a; }
        }
#pragma unroll
        for (int t = 0; t < NTG; ++t)
#pragma unroll
            for (int s = 0; s < 2; ++s) {
                u32x4 pw; pw[0] = cvtpk(S[t][8 * s + 0], S[t][8 * s + 1]); pw[1] = cvtpk(S[t][8 * s + 2], S[t][8 * s + 3]);
                pw[2] = cvtpk(S[t][8 * s + 4], S[t][8 * s + 5]); pw[3] = cvtpk(S[t][8 * s + 6], S[t][8 * s + 7]);
                const bf16x8 pa = __builtin_bit_cast(bf16x8, pw);
                const int vrow = krow0 + (g * NTG + t) * 32 + 16 * s + 4 * hi + ((lane & 15) >> 2);
                LAS const unsigned char* vp = Vl + (size_t)vrow * VS + (16 * ((lane >> 4) & 1) + 4 * (lane & 3)) * 2;
#pragma unroll
                for (int dt = 0; dt < 2; ++dt) {
                    const s16x4 lo = vtr(vp + dt * 64), hh = vtr(vp + dt * 64 + 8 * VS);
                    const bf16x8 vb = (bf16x8){lo[0], lo[1], lo[2], lo[3], hh[0], hh[1], hh[2], hh[3]};
                    o[dt] = __builtin_amdgcn_mfma_f32_32x32x16_bf16(pa, vb, o[dt], 0, 0, 0);
                }
            }
    }
    m_out = m_run; l_out = l_run;
}

struct Ptrs {
    const float* in[25]; float* out; unsigned char* ws;
    float *RINV, *SS, *ROPE, *ZB, *LSE;
    bf16_t *WT, *WOT, *XB, *Qb, *Kb, *Vb, *QMb, *Gb, *MKB, *MVB, *OAP, *OG;
};

constexpr int N_DIL_UNITS = NB * 6 * 3 * 32;
__device__ __forceinline__ void dil_unit(const Ptrs& P, LAS unsigned char* lds, int unit, int tid) {
    const int lane = tid & 63, wave = tid >> 6;
    const int u32 = unit & 31, x = unit >> 5, di = x % 3, bh = x / 3, b = bh / 6, h = bh % 6;
    const int dil = (di == 0) ? 1 : (di == 1 ? 4 : 16), nb2 = 32 / dil, res = u32 / nb2, j = u32 % nb2;
    LAS unsigned char* Kl = lds; LAS unsigned char* Vl = lds + 384 * KS;
    const int l0 = 256 * j - 128;
#pragma unroll
    for (int i = 0; i < 6; ++i) {
        const int e = tid + NTHR * i, row = e >> 3, c = e & 7, l = l0 + row;
        u32x4 kv = (u32x4){0u, 0u, 0u, 0u}, vv = kv;
        if (l >= 0) { const size_t off = ((size_t)b * SEQ + (size_t)l * dil + res) * ATT_W + h * 64 + c * 8; kv = *(const u32x4*)(P.Kb + off); vv = *(const u32x4*)(P.Vb + off); }
        *(LAS u32x4*)(Kl + row * KS + c * 16) = kv; *(LAS u32x4*)(Vl + row * VS + c * 16) = vv;
    }
    __syncthreads();
    const int q = lane & 31, hi = lane >> 5, lq0 = 256 * j + 32 * wave;
    const size_t tokq = (size_t)b * SEQ + (size_t)(lq0 + q) * dil + res;
    bf16x8 qf[4];
#pragma unroll
    for (int d0 = 0; d0 < 4; ++d0) qf[d0] = *(const bf16x8*)(P.Qb + tokq * ATT_W + h * 64 + d0 * 16 + hi * 8);
    f32x16 o[2]; float mm, ll;
    strip_attn<5, 1, true>(qf, Kl, Vl, 32 * wave, lane, (lq0 < 128) ? 128 - lq0 : 0, o, mm, ll);
    const float linv = 1.f / ll;
#pragma unroll
    for (int r = 0; r < 16; ++r) {
        const int qq = crow(r, hi); const float li = __shfl(linv, qq);
        const size_t tok = (size_t)b * SEQ + (size_t)(lq0 + qq) * dil + res;
        bf16_t* op = P.OAP + ((size_t)di * MP + tok) * ATT_W + h * 64 + q;
        op[0] = f2bf(o[0][r] * li); op[32] = f2bf(o[1][r] * li);
    }
    if (hi == 0) P.LSE[((size_t)di * MP + tokq) * 6 + h] = mm + __logf(ll);
    __syncthreads();
}

constexpr int N_MEMA_UNITS = NB * 4 * 32;
__device__ __forceinline__ void mem_unit(const Ptrs& P, LAS unsigned char* lds, int unit, int tid) {
    const int lane = tid & 63, wave = tid >> 6;
    const int jq = unit & 31, bh = unit >> 5, b = bh >> 2, hm = bh & 3;
    LAS unsigned char* Kl = lds; LAS unsigned char* Vl = lds + 256 * KS;
#pragma unroll
    for (int i = 0; i < 4; ++i) {
        const int e = tid + NTHR * i, row = e >> 3, c = e & 7;
        const size_t off = ((size_t)b * NMEM + row) * MEM_W + hm * 64 + c * 8;
        *(LAS u32x4*)(Kl + row * KS + c * 16) = *(const u32x4*)(P.MKB + off); *(LAS u32x4*)(Vl + row * VS + c * 16) = *(const u32x4*)(P.MVB + off);
    }
    __syncthreads();
    const int q = lane & 31, hi = lane >> 5;
    const size_t tok0 = (size_t)b * SEQ + 256 * jq + 32 * wave;
    bf16x8 qf[4];
#pragma unroll
    for (int d0 = 0; d0 < 4; ++d0) qf[d0] = *(const bf16x8*)(P.QMb + (tok0 + q) * MEM_W + hm * 64 + d0 * 16 + hi * 8);
    f32x16 o[2]; float mm, ll;
    strip_attn<4, 2, false>(qf, Kl, Vl, 0, lane, 0, o, mm, ll);
    const float linv = 1.f / ll;
#pragma unroll
    for (int r = 0; r < 16; ++r) {
        const int qq = crow(r, hi); const float li = __shfl(linv, qq);
        const size_t oo = (tok0 + qq) * DM + 768 + hm * 64 + q;
        P.OG[oo] = f2bf(o[0][r] * li * bf2f(P.Gb[oo])); P.OG[oo + 32] = f2bf(o[1][r] * li * bf2f(P.Gb[oo + 32]));
    }
    __syncthreads();
}

constexpr int N_SDIL_ITEMS = DB * DT;
__device__ __forceinline__ void sdil_item(const Ptrs& P, LAS unsigned char* lds, int item, int tid) {
    const int db = item >> 3, i = item & 7, lane = tid & 63, wave = tid >> 6;
    LAS float* sc = (LAS float*)lds;
    LAS float* st = sc + 3 * 132 * 6;
    LAS float* red = st + 32;
    const int g = tid / 96, u = tid % 96, hh = u >> 4;
    const size_t srow = (size_t)MP + db * 8 + i;
    const float* ck = P.in[2] + (size_t)db * WINP * ATT_W; const float* cv = P.in[3] + (size_t)db * WINP * ATT_W;
    const float* nk = P.out + O_WK_S + (size_t)db * 8 * ATT_W; const float* nv = P.out + O_WV_S + (size_t)db * 8 * ATT_W;
    f32x4 q4 = (f32x4){0.f, 0.f, 0.f, 0.f};
    if (g < 5) { const u32x2 w = *(const u32x2*)(P.Qb + srow * ATT_W + u * 4); q4 = (f32x4){bflo(w[0]), bfhi(w[0]), bflo(w[1]), bfhi(w[1])}; }
    for (int di = 0; di < 3; ++di) {
        const int dil = (di == 0) ? 1 : (di == 1 ? 4 : 16);
        for (int jj = g; jj < 129 + 4; jj += 5) {
            float d = 0.f;
            if (g < 5 && jj < 129) { const int idx = WINP + i - dil * jj; const float* kr = (idx >= WINP) ? nk + (size_t)(idx - WINP) * ATT_W : ck + (size_t)idx * ATT_W;
                const f32x4 k4 = *(const f32x4*)(kr + u * 4); d = (k4[0] * q4[0] + k4[1] * q4[1]) + (k4[2] * q4[2] + k4[3] * q4[3]); }
            d += __shfl_xor(d, 1); d += __shfl_xor(d, 2); d += __shfl_xor(d, 4); d += __shfl_xor(d, 8);
            if (g < 5 && jj < 129 && (u & 15) == 0) sc[(di * 132 + jj) * 6 + hh] = d;
        }
    }
    __syncthreads();
    LAS float* stm = st + 32 + 5 * 384;
    for (int pr = wave; pr < 18; pr += 8) {
        const int di = pr / 6, h2 = pr % 6;
        float v0 = sc[(di * 132 + lane) * 6 + h2], v1 = sc[(di * 132 + 64 + lane) * 6 + h2], v2 = (lane == 0) ? sc[(di * 132 + 128) * 6 + h2] : -INFINITY;
        const float mx = wave_max(fmaxf(fmaxf(v0, v1), v2));
        v0 = __expf(v0 - mx); v1 = __expf(v1 - mx); v2 = (lane == 0) ? __expf(v2 - mx) : 0.f;
        const float sm = wave_sum(v0 + v1 + v2);
        sc[(di * 132 + lane) * 6 + h2] = v0; sc[(di * 132 + 64 + lane) * 6 + h2] = v1; if (lane == 0) { sc[(di * 132 + 128) * 6 + h2] = v2; stm[pr] = mx; stm[18 + pr] = sm; }
    }
    __syncthreads();
    if (tid < 6) {
        const float l0 = stm[tid] + __logf(stm[18 + tid]), l1 = stm[6 + tid] + __logf(stm[24 + tid]), l2 = stm[12 + tid] + __logf(stm[30 + tid]);
        const float mx = fmaxf(l0, fmaxf(l1, l2)); const float e0 = __expf(l0 - mx), e1 = __expf(l1 - mx), e2 = __expf(l2 - mx); const float inv = 1.f / (e0 + e1 + e2);
        st[tid] = e0 * inv / stm[18 + tid]; st[6 + tid] = e1 * inv / stm[24 + tid]; st[12 + tid] = e2 * inv / stm[30 + tid];
    }
    __syncthreads();
    if (g < 5) {
        f32x4 a = (f32x4){0.f, 0.f, 0.f, 0.f};
        for (int di = 0; di < 3; ++di) {
            const int dil = (di == 0) ? 1 : (di == 1 ? 4 : 16); const float cf = st[di * 6 + hh];
            for (int jj = g; jj < 129; jj += 5) { const int idx = WINP + i - dil * jj; const float* vr = (idx >= WINP) ? nv + (size_t)(idx - WINP) * ATT_W : cv + (size_t)idx * ATT_W;
                const f32x4 v4 = *(const f32x4*)(vr + u * 4); const float pw = sc[(di * 132 + jj) * 6 + hh] * cf; a += v4 * pw; }
        }
        *(LAS f32x4*)(red + g * 384 + u * 4) = a;
    }
    __syncthreads();
    if (tid < 96) {
        f32x4 a = *(LAS f32x4*)(red + tid * 4);
#pragma unroll
        for (int k = 1; k < 5; ++k) a += *(LAS f32x4*)(red + k * 384 + tid * 4);
        const u32x2 gw = *(const u32x2*)(P.Gb + srow * DM + tid * 4);
        u32x2 w; w[0] = cvtpk(a[0] * bflo(gw[0]), a[1] * bfhi(gw[0])); w[1] = cvtpk(a[2] * bflo(gw[1]), a[3] * bfhi(gw[1]));
        *(u32x2*)(P.OG + srow * DM + tid * 4) = w;
    }
    __syncthreads();
}

constexpr int N_SMEM_ITEMS = DB * 4;
__device__ __forceinline__ void smem_item(const Ptrs& P, LAS unsigned char* lds, int item, int tid) {
    const int db = item >> 2, hm = item & 3, lane = tid & 63, wave = tid >> 6;
    LAS float* qs = (LAS float*)lds;
    LAS float* sc = qs + 512;
    LAS float* li = sc + 2048;
    { const int qi = tid >> 6, d = tid & 63; qs[tid] = bf2f(P.QMb[((size_t)MP + db * 8 + qi) * MEM_W + hm * 64 + d]); }
    __syncthreads();
    {
        const int m = tid & 255, qh = tid >> 8;
        const float* kr = P.in[6] + (((size_t)db * NMEM + m) * 4 + hm) * 64;
        float d0 = 0.f, d1 = 0.f, d2 = 0.f, d3 = 0.f;
#pragma unroll 4
        for (int c = 0; c < 16; ++c) {
            const f32x4 k4 = *(const f32x4*)(kr + c * 4);
            const f32x4 a0 = *(LAS f32x4*)(qs + (qh * 4 + 0) * 64 + c * 4), a1 = *(LAS f32x4*)(qs + (qh * 4 + 1) * 64 + c * 4), a2 = *(LAS f32x4*)(qs + (qh * 4 + 2) * 64 + c * 4), a3 = *(LAS f32x4*)(qs + (qh * 4 + 3) * 64 + c * 4);
            d0 += (k4[0] * a0[0] + k4[1] * a0[1]) + (k4[2] * a0[2] + k4[3] * a0[3]); d1 += (k4[0] * a1[0] + k4[1] * a1[1]) + (k4[2] * a1[2] + k4[3] * a1[3]);
            d2 += (k4[0] * a2[0] + k4[1] * a2[1]) + (k4[2] * a2[2] + k4[3] * a2[3]); d3 += (k4[0] * a3[0] + k4[1] * a3[1]) + (k4[2] * a3[2] + k4[3] * a3[3]);
        }
        sc[(qh * 4 + 0) * 256 + m] = d0; sc[(qh * 4 + 1) * 256 + m] = d1; sc[(qh * 4 + 2) * 256 + m] = d2; sc[(qh * 4 + 3) * 256 + m] = d3;
    }
    __syncthreads();
    {
        float v[4]; float mx = -INFINITY;
#pragma unroll
        for (int k = 0; k < 4; ++k) { v[k] = sc[wave * 256 + k * 64 + lane]; mx = fmaxf(mx, v[k]); }
        mx = wave_max(mx); float sm = 0.f;
#pragma unroll
        for (int k = 0; k < 4; ++k) { v[k] = __expf(v[k] - mx); sm += v[k]; sc[wave * 256 + k * 64 + lane] = v[k]; }
        sm = wave_sum(sm); if (lane == 0) li[wave] = 1.f / sm;
    }
    __syncthreads();
    {
        const int qi = tid >> 6, d = tid & 63;
        const float* vr = P.in[7] + (((size_t)db * NMEM) * 4 + hm) * 64 + d;
        float a = 0.f;
#pragma unroll 8
        for (int m = 0; m < 256; ++m) a += sc[qi * 256 + m] * vr[(size_t)m * 256];
        const size_t oo = ((size_t)MP + db * 8 + qi) * DM + 768 + hm * 64 + d;
        P.OG[oo] = f2bf(a * li[qi] * bf2f(P.Gb[oo]));
    }
    __syncthreads();
}

constexpr int N_SCAN_P = NB * 6, N_SCAN_S = DB * 6;
constexpr int CH = 32;
__device__ __forceinline__ float softplusf(float x) { return fmaxf(x, 0.f) + log1pf(__expf(-fabsf(x))); }
__device__ __forceinline__ void scan_item(const Ptrs& P, LAS unsigned char* lds, bool sample, int bb, int h, int tid) {
    const int lane = tid & 63, wave = tid >> 6;
    const int T = sample ? DT : SEQ;
    const size_t row0 = sample ? (size_t)MP + bb * DT : (size_t)bb * SEQ;
    LAS float* W2h = (LAS float*)lds;
    LAS float* A2h = W2h + 4096;
    LAS float* Rr = A2h + 4096;
    LAS float* Kk = Rr + CH * 64;
    LAS float* Vv = Kk + CH * 64;
    LAS float* Wd = Vv + CH * 64;
    LAS float* KK = Wd + CH * 64;
    LAS float* Bb = KK + CH * 64;
    LAS float* TW = Bb + CH * 64;
    LAS float* AL = TW + CH * 64;
    LAS float* Yb = AL + CH * 64;
    const float* mu = P.in[11]; const float* w0 = P.in[12]; const float* w2 = P.in[13]; const float* a0 = P.in[14]; const float* a2 = P.in[15];
    const float* k_k = P.in[16]; const float* k_a = P.in[17]; const float* r_k = P.in[18]; const float* lnx_g = P.in[19]; const float* lnx_b = P.in[20];
    for (int e = tid; e < 4096; e += NTHR) { const int jr = e >> 6, c = e & 63; W2h[e] = w2[(size_t)jr * RW + h * 64 + c]; A2h[e] = a2[(size_t)jr * RW + h * 64 + c]; }
    const int v = tid >> 3, kq = tid & 7;
    float s[8];
    if (sample) {
        const float* sp = P.in[4] + (((size_t)bb * 6 + h) * 64 + v) * 64 + kq * 8;
#pragma unroll
        for (int e = 0; e < 8; ++e) s[e] = sp[e];
    } else {
#pragma unroll
        for (int e = 0; e < 8; ++e) s[e] = 0.f;
    }
    const float* shift0 = P.in[5] + (size_t)bb * SHIFT_W;
    __syncthreads();
    for (int c0 = 0; c0 < T; c0 += CH) {
        const int n = (T - c0) < CH ? (T - c0) : CH;
        {
            float zv[20], zpv[20];
#pragma unroll
            for (int ti = 0; ti < 4; ++ti)
#pragma unroll
                for (int grp = 0; grp < 5; ++grp) {
                    const int t = wave + 8 * ti, col = (grp < 3) ? grp * RW + h * 64 + lane : 3 * RW + (grp - 3) * 64 + lane;
                    const size_t row = row0 + c0 + t;
                    float z = 0.f, zp = 0.f;
                    if (t < n) { z = P.ZB[row * SHIFT_W + col]; zp = (c0 + t == 0) ? (sample ? shift0[col] : 0.f) : P.ZB[(row - 1) * SHIFT_W + col]; }
                    zv[ti * 5 + grp] = z; zpv[ti * 5 + grp] = zp;
                }
#pragma unroll
            for (int ti = 0; ti < 4; ++ti)
#pragma unroll
                for (int grp = 0; grp < 5; ++grp) {
                    const int t = wave + 8 * ti, col = (grp < 3) ? grp * RW + h * 64 + lane : 3 * RW + (grp - 3) * 64 + lane;
                    const float zs = zv[ti * 5 + grp] + (zpv[ti * 5 + grp] - zv[ti * 5 + grp]) * mu[col];
                    if (t < n) {
                        if (grp == 0) Rr[t * 64 + lane] = zs; else if (grp == 1) Kk[t * 64 + lane] = zs; else if (grp == 2) Vv[t * 64 + lane] = zs;
                        else if (grp == 3) TW[t * 64 + lane] = tanhf(zs); else AL[t * 64 + lane] = zs;
                    }
                }
        }
        __syncthreads();
        for (int idx = tid; idx < n * 64; idx += NTHR) {
            const int t = idx >> 6, c = idx & 63, ch = h * 64 + c;
            float wv = w0[ch], av = a0[ch];
#pragma unroll 8
            for (int jr = 0; jr < 64; ++jr) { wv += TW[t * 64 + jr] * W2h[jr * 64 + c]; av += AL[t * 64 + jr] * A2h[jr * 64 + c]; }
            const float w = -softplusf(-wv) - 0.5f;
            const float decay = __expf(-__expf(w));
            const float a = 1.f / (1.f + __expf(-av));
            const float kraw = Kk[t * 64 + c];
            Wd[t * 64 + c] = decay;
            KK[t * 64 + c] = kraw * k_k[ch];
            Kk[t * 64 + c] = kraw * (1.f + (a - 1.f) * k_a[ch]);
            Bb[t * 64 + c] = a;
        }
        __syncthreads();
        for (int t = wave; t < n; t += 8) {
            const float x = KK[t * 64 + lane];
            const float nrm = fmaxf(sqrtf(wave_sum(x * x)), 1e-12f);
            const float kkn = x / nrm;
            KK[t * 64 + lane] = kkn; Bb[t * 64 + lane] = kkn * Bb[t * 64 + lane];
        }
        __syncthreads();
        for (int t = 0; t < n; ++t) {
            const f32x4 kk0 = *(LAS f32x4*)(KK + t * 64 + kq * 8), kk1 = *(LAS f32x4*)(KK + t * 64 + kq * 8 + 4);
            const f32x4 w0v = *(LAS f32x4*)(Wd + t * 64 + kq * 8), w1v = *(LAS f32x4*)(Wd + t * 64 + kq * 8 + 4);
            const f32x4 b0 = *(LAS f32x4*)(Bb + t * 64 + kq * 8), b1 = *(LAS f32x4*)(Bb + t * 64 + kq * 8 + 4);
            const f32x4 k0 = *(LAS f32x4*)(Kk + t * 64 + kq * 8), k1 = *(LAS f32x4*)(Kk + t * 64 + kq * 8 + 4);
            const f32x4 r0 = *(LAS f32x4*)(Rr + t * 64 + kq * 8), r1 = *(LAS f32x4*)(Rr + t * 64 + kq * 8 + 4);
            const float vv = Vv[t * 64 + v];
            float sa = 0.f;
#pragma unroll
            for (int e = 0; e < 4; ++e) { sa += s[e] * kk0[e]; sa += s[4 + e] * kk1[e]; }
            sa = -sum8(sa);
            float y = 0.f;
#pragma unroll
            for (int e = 0; e < 4; ++e) {
                s[e] = s[e] * w0v[e] + sa * b0[e] + vv * k0[e];
                s[4 + e] = s[4 + e] * w1v[e] + sa * b1[e] + vv * k1[e];
                y += s[e] * r0[e]; y += s[4 + e] * r1[e];
            }
            y = sum8(y);
            if (kq == 0) Yb[t * 64 + v] = y;
        }
        __syncthreads();
        for (int t = wave; t < n; t += 8) {
            const int ch = h * 64 + lane;
            const float y = Yb[t * 64 + lane];
            const float mean = wave_sum(y) * (1.f / 64.f);
            const float d = y - mean;
            const float var = wave_sum(d * d) * (1.f / 64.f);
            const float yn = d * rsqrtf(var + 64e-5f) * lnx_g[ch] + lnx_b[ch];
            const float bonus = wave_sum(Rr[t * 64 + lane] * Kk[t * 64 + lane] * r_k[ch]) * Vv[t * 64 + lane];
            const size_t oo = (row0 + c0 + t) * DM + 384 + ch;
            P.OG[oo] = f2bf((yn + bonus) * bf2f(P.Gb[oo]));
        }
        __syncthreads();
    }
    if (sample) {
        float* so = P.out + O_ST_S + (((size_t)bb * 6 + h) * 64 + v) * 64 + kq * 8;
#pragma unroll
        for (int e = 0; e < 8; ++e) so[e] = s[e];
    }
    __syncthreads();
}

constexpr int NCH = SEQ / 64, N_L_ITEMS = NB * 6 * NCH;
constexpr size_t WS_MF = WS_END;
constexpr size_t WS_NF = WS_MF + (size_t)N_L_ITEMS * 8192;
constexpr size_t WS_QF = WS_NF + (size_t)N_L_ITEMS * 16384;
constexpr size_t WS_YF = WS_QF + (size_t)N_L_ITEMS * 8192;
constexpr size_t WS_SF = WS_YF + (size_t)N_L_ITEMS * 16384;
constexpr size_t WS_RHO = WS_SF + (size_t)N_L_ITEMS * 8192;
constexpr size_t WS_END2 = al256(WS_RHO + (size_t)N_L_ITEMS * 256);
constexpr int TS = 144;
constexpr int FS = 272;
#define MFMA32(a, b, c) __builtin_amdgcn_mfma_f32_32x32x16_bf16((a), (b), (c), 0, 0, 0)
__device__ __forceinline__ bf16x8 rowfrag(LAS const unsigned char* tile, int row, int s, int h) { return *(LAS const bf16x8*)(tile + row * TS + (16 * s + 8 * h) * 2); }
__device__ __forceinline__ bf16x8 colfrag(LAS const unsigned char* tile, int f0, int s, int lane) {
    LAS const unsigned char* p = tile + (16 * s + 8 * (lane >> 5) + ((lane & 15) >> 2)) * TS + (f0 + 16 * ((lane >> 4) & 1) + 4 * (lane & 3)) * 2;
    const s16x4 lo = vtr(p), hh = vtr(p + 4 * TS);
    return (bf16x8){lo[0], lo[1], lo[2], lo[3], hh[0], hh[1], hh[2], hh[3]};
}
__device__ __forceinline__ f32x16 zero16() { f32x16 z; _Pragma("unroll") for (int r = 0; r < 16; ++r) z[r] = 0.f; return z; }

__device__ __forceinline__ void passL_item(const Params& prm, LAS unsigned char* lds, int item, int tid) {
    const int lane = tid & 63, wave = tid >> 6, hi = lane >> 5, l31 = lane & 31;
    const int seq = item >> 7, c = item & 127, b = seq / 6, h = seq % 6;
    const size_t row0 = (size_t)b * SEQ + 64 * c;
    const float* ZB = (const float*)(prm.ws + WS_ZB);
    LAS unsigned char* F_R = lds; LAS unsigned char* F_K = lds + 17408; LAS unsigned char* F_KK = lds + 34816; LAS unsigned char* F_B = lds + 52224; LAS unsigned char* F_LD = lds + 69632;
    LAS unsigned char* T_TW = lds + 87040; LAS unsigned char* T_AL = lds + 96256; LAS unsigned char* T_W2 = lds + 105472; LAS unsigned char* T_A2 = lds + 114688;
    LAS float* SEG = (LAS float*)(lds + 133120);
    LAS unsigned char* T_V = lds + 135168; LAS float* GCs = (LAS float*)(lds + 144384);
    LAS unsigned char* T_At = lds; LAS unsigned char* T_Bt = lds + 9216; LAS unsigned char* T_Kt = lds + 18432; LAS unsigned char* T_Rt = lds + 27648; LAS unsigned char* T_Bh = lds + 36864; LAS unsigned char* T_Kh = lds + 46080;
    LAS unsigned char* T_Aak = lds + 55296; LAS unsigned char* T_Arb = lds + 64512; LAS unsigned char* T_Ark = lds + 73728;
    LAS unsigned char* ATm = lds + 82944;
    LAS unsigned char* RHST = lds + 100352;
    LAS unsigned char* XsT = lds + 9216;
    {
        const float* mu = prm.in[11];
#pragma unroll
        for (int half = 0; half < 2; ++half) {
            float zv[20], zpv[20];
#pragma unroll
            for (int ti = 0; ti < 4; ++ti)
#pragma unroll
                for (int grp = 0; grp < 5; ++grp) {
                    const int t = wave + 8 * (half * 4 + ti), col = (grp < 3) ? grp * RW + h * 64 + lane : 3 * RW + (grp - 3) * 64 + lane;
                    const size_t row = row0 + t;
                    zv[ti * 5 + grp] = ZB[row * SHIFT_W + col];
                    zpv[ti * 5 + grp] = (c == 0 && t == 0) ? 0.f : ZB[(row - 1) * SHIFT_W + col];
                }
#pragma unroll
            for (int ti = 0; ti < 4; ++ti)
#pragma unroll
                for (int grp = 0; grp < 5; ++grp) {
                    const int t = wave + 8 * (half * 4 + ti), col = (grp < 3) ? grp * RW + h * 64 + lane : 3 * RW + (grp - 3) * 64 + lane;
                    const float zs = zv[ti * 5 + grp] + (zpv[ti * 5 + grp] - zv[ti * 5 + grp]) * mu[col];
                    if (grp == 0) *(LAS float*)(F_R + t * FS + lane * 4) = zs;
                    else if (grp == 1) *(LAS float*)(F_K + t * FS + lane * 4) = zs;
                    else if (grp == 2) *(LAS bf16_t*)(T_V + t * TS + lane * 2) = f2bf(zs);
                    else if (grp == 3) *(LAS bf16_t*)(T_TW + t * TS + lane * 2) = f2bf(tanhf(zs));
                    else *(LAS bf16_t*)(T_AL + t * TS + lane * 2) = f2bf(zs);
                }
        }
        const float* w2 = prm.in[13]; const float* a2 = prm.in[15];
#pragma unroll
        for (int i = 0; i < 8; ++i) { const int e = tid + NTHR * i, jr = e >> 6, cc = e & 63;
            *(LAS bf16_t*)(T_W2 + cc * TS + jr * 2) = f2bf(w2[(size_t)jr * RW + h * 64 + cc]); *(LAS bf16_t*)(T_A2 + cc * TS + jr * 2) = f2bf(a2[(size_t)jr * RW + h * 64 + cc]); }
    }
    __syncthreads();
    if (wave < 4) {
        const int t = 16 * wave + (lane & 15), g = lane >> 4;
        f32x4 accW[4], accA[4];
#pragma unroll
        for (int ct = 0; ct < 4; ++ct) { accW[ct] = (f32x4){0.f, 0.f, 0.f, 0.f}; accA[ct] = accW[ct]; }
#pragma unroll
        for (int ks = 0; ks < 2; ++ks) {
            const bf16x8 bw = *(LAS const bf16x8*)(T_TW + t * TS + (32 * ks + 8 * g) * 2), ba = *(LAS const bf16x8*)(T_AL + t * TS + (32 * ks + 8 * g) * 2);
#pragma unroll
            for (int ct = 0; ct < 4; ++ct) {
                const bf16x8 aw = *(LAS const bf16x8*)(T_W2 + (16 * ct + (lane & 15)) * TS + (32 * ks + 8 * g) * 2), aa = *(LAS const bf16x8*)(T_A2 + (16 * ct + (lane & 15)) * TS + (32 * ks + 8 * g) * 2);
                accW[ct] = __builtin_amdgcn_mfma_f32_16x16x32_bf16(aw, bw, accW[ct], 0, 0, 0);
                accA[ct] = __builtin_amdgcn_mfma_f32_16x16x32_bf16(aa, ba, accA[ct], 0, 0, 0);
            }
        }
        const float* w0 = prm.in[12]; const float* a0 = prm.in[14]; const float* k_k = prm.in[16]; const float* k_a = prm.in[17]; const float* r_k = prm.in[18];
        float ssq = 0.f, rho = 0.f; f32x4 kkv[4], av[4];
#pragma unroll
        for (int ct = 0; ct < 4; ++ct) {
            const int c4 = 16 * ct + 4 * g, ch = h * 64 + c4;
            const f32x4 kraw = *(LAS const f32x4*)(F_K + t * FS + c4 * 4), rr = *(LAS const f32x4*)(F_R + t * FS + c4 * 4);
            const f32x4 w0v = *(const f32x4*)(w0 + ch), a0v = *(const f32x4*)(a0 + ch), kkc = *(const f32x4*)(k_k + ch), kac = *(const f32x4*)(k_a + ch), rkc = *(const f32x4*)(r_k + ch);
            f32x4 ld, kp;
#pragma unroll
            for (int e = 0; e < 4; ++e) {
                const float wv = w0v[e] + accW[ct][e];
                const float w = -softplusf(-wv) - 0.5f;
                ld[e] = -__expf(w);
                const float a = 1.f / (1.f + __expf(-(a0v[e] + accA[ct][e])));
                av[ct][e] = a;
                kkv[ct][e] = kraw[e] * kkc[e];
                kp[e] = kraw[e] * (1.f + (a - 1.f) * kac[e]);
                ssq += kkv[ct][e] * kkv[ct][e];
                rho += rr[e] * kp[e] * rkc[e];
            }
            *(LAS f32x4*)(F_LD + t * FS + c4 * 4) = ld; *(LAS f32x4*)(F_K + t * FS + c4 * 4) = kp;
        }
        ssq += __shfl_xor(ssq, 16); ssq += __shfl_xor(ssq, 32); rho += __shfl_xor(rho, 16); rho += __shfl_xor(rho, 32);
        const float inv = 1.f / fmaxf(sqrtf(ssq), 1e-12f);
#pragma unroll
        for (int ct = 0; ct < 4; ++ct) {
            const int c4 = 16 * ct + 4 * g; f32x4 kk, bb;
#pragma unroll
            for (int e = 0; e < 4; ++e) { kk[e] = kkv[ct][e] * inv; bb[e] = kk[e] * av[ct][e]; }
            *(LAS f32x4*)(F_KK + t * FS + c4 * 4) = kk; *(LAS f32x4*)(F_B + t * FS + c4 * 4) = bb;
        }
        if (g == 0) ((float*)(prm.ws + WS_RHO))[(size_t)item * 64 + t] = rho;
    }
    __syncthreads();
    {
        const int cch = tid & 63, seg = tid >> 6;
        float L[8], kk[8], bb[8], kp[8], rr[8];
        float run = 0.f;
#pragma unroll
        for (int i = 0; i < 8; ++i) { const int t = 8 * seg + i; run += *(LAS const float*)(F_LD + t * FS + cch * 4); L[i] = run;
            kk[i] = *(LAS const float*)(F_KK + t * FS + cch * 4); bb[i] = *(LAS const float*)(F_B + t * FS + cch * 4); kp[i] = *(LAS const float*)(F_K + t * FS + cch * 4); rr[i] = *(LAS const float*)(F_R + t * FS + cch * 4); }
        SEG[seg * 64 + cch] = run;
        __syncthreads();
        float off = 0.f, tot = 0.f;
#pragma unroll
        for (int sgi = 0; sgi < 8; ++sgi) { const float v = SEG[sgi * 64 + cch]; tot += v; if (sgi < seg) off += v; }
        __syncthreads();
        f32x4 at0, at1;
#pragma unroll
        for (int i = 0; i < 8; ++i) {
            const int t = 8 * seg + i;
            const float Lc = off + L[i], Lp = (i == 0) ? off : off + L[i - 1];
            const float ep = __expf(Lp), em = __expf(-Lc), el = __expf(Lc), eh = __expf(tot - Lc);
            const float at = -kk[i] * ep;
            if (i < 4) at0[i] = at; else at1[i - 4] = at;
            *(LAS bf16_t*)(T_At + t * TS + cch * 2) = f2bf(at);
            *(LAS bf16_t*)(T_Bt + t * TS + cch * 2) = f2bf(bb[i] * em);
            *(LAS bf16_t*)(T_Kt + t * TS + cch * 2) = f2bf(kp[i] * em);
            *(LAS bf16_t*)(T_Rt + t * TS + cch * 2) = f2bf(rr[i] * el);
            *(LAS bf16_t*)(T_Bh + t * TS + cch * 2) = f2bf(bb[i] * eh);
            *(LAS bf16_t*)(T_Kh + t * TS + cch * 2) = f2bf(kp[i] * eh);
        }
#pragma unroll
        for (int i = 0; i < 8; ++i) *(LAS float*)(RHST + cch * FS + ((i & 3) * 16 + 2 * seg + (i >> 2)) * 4) = (i < 4) ? at0[i & 3] : at1[i & 3];
        if (seg == 0) GCs[cch] = __expf(tot);
    }
    __syncthreads();
#pragma unroll
    for (int rep = 0; rep < 2; ++rep) {
        const int slot = wave + 8 * rep, prod = slot >> 2, tile = slot & 3;
        if (prod == 0) {
            const int tt = tile >> 1, it = tile & 1;
            if (!(tt == 0 && it == 1)) {
                f32x16 d = zero16();
#pragma unroll
                for (int s4 = 0; s4 < 4; ++s4) d = MFMA32(rowfrag(T_At, 32 * tt + l31, s4, hi), rowfrag(T_Bt, 32 * it + l31, s4, hi), d);
#pragma unroll
                for (int rg = 0; rg < 4; ++rg)
#pragma unroll
                    for (int e = 0; e < 4; ++e) *(LAS float*)(ATm + (32 * it + l31) * FS + (e * 16 + 8 * tt + 2 * rg + hi) * 4) = d[4 * rg + e];
            }
        } else {
            const int it = tile >> 1, tt = tile & 1;
            LAS const unsigned char* TA = (prod == 2) ? T_Bt : T_Kt; LAS const unsigned char* TB = (prod == 1) ? T_At : T_Rt;
            LAS unsigned char* TO = (prod == 1) ? T_Aak : (prod == 2) ? T_Arb : T_Ark;
            f32x16 d = zero16();
            if (!(it == 1 && tt == 0)) {
#pragma unroll
                for (int s4 = 0; s4 < 4; ++s4) d = MFMA32(rowfrag(TA, 32 * it + l31, s4, hi), rowfrag(TB, 32 * tt + l31, s4, hi), d);
            }
            const int tg = 32 * tt + l31;
#pragma unroll
            for (int rg = 0; rg < 4; ++rg) {
                float v4[4];
#pragma unroll
                for (int e = 0; e < 4; ++e) { const int ig = 32 * it + 8 * rg + 4 * hi + e; const bool keep = (prod == 1) ? (ig < tg) : (ig <= tg); v4[e] = keep ? d[4 * rg + e] : 0.f; }
                *(LAS u32x2*)(TO + tg * TS + (32 * it + 8 * rg + 4 * hi) * 2) = (u32x2){cvtpk(v4[0], v4[1]), cvtpk(v4[2], v4[3])};
            }
        }
    }
    __syncthreads();
    if (wave < 4) {
        const int tt = wave >> 1, vt = wave & 1;
        f32x16 d = zero16();
#pragma unroll
        for (int s4 = 0; s4 < 4; ++s4) d = MFMA32(rowfrag(T_Aak, 32 * tt + l31, s4, hi), colfrag(T_V, 32 * vt, s4, lane), d);
#pragma unroll
        for (int rg = 0; rg < 4; ++rg)
#pragma unroll
            for (int e = 0; e < 4; ++e) *(LAS float*)(RHST + (64 + 32 * vt + l31) * FS + (e * 16 + 8 * tt + 2 * rg + hi) * 4) = d[4 * rg + e];
    }
    __syncthreads();
    {
        const int col = tid >> 2, j = tid & 3;
        float acc[16];
#pragma unroll
        for (int q = 0; q < 4; ++q) { const f32x4 v = *(LAS const f32x4*)(RHST + col * FS + (j * 16 + 4 * q) * 4); acc[4 * q] = v[0]; acc[4 * q + 1] = v[1]; acc[4 * q + 2] = v[2]; acc[4 * q + 3] = v[3]; }
        LAS const unsigned char* atp = ATm + j * 64;
#pragma unroll
        for (int i = 0; i < 63; ++i) {
            constexpr int dummy = 0; (void)dummy;
            const int jo = i & 3, mo = i >> 2;
            const float x = (jo == 0) ? dpp_f<0x00>(acc[mo]) : (jo == 1) ? dpp_f<0x55>(acc[mo]) : (jo == 2) ? dpp_f<0xAA>(acc[mo]) : dpp_f<0xFF>(acc[mo]);
#pragma unroll
            for (int q = mo / 4; q < 4; ++q) {
                const f32x4 a4 = *(LAS const f32x4*)(atp + i * FS + q * 16);
#pragma unroll
                for (int e = 0; e < 4; ++e) { const int m = 4 * q + e;
                    if (m > mo) acc[m] += a4[e] * x;
                    else if (m == mo) acc[m] += ((j > jo) ? a4[e] : 0.f) * x; }
            }
        }
#pragma unroll
        for (int m = 0; m < 16; ++m) *(LAS bf16_t*)(XsT + col * TS + (4 * m + j) * 2) = f2bf(acc[m]);
    }
    __syncthreads();
    {
        const int tile = wave & 3, ta = tile >> 1, tb = tile & 1;
        if (wave < 4) {
            f32x16 d = zero16();
#pragma unroll
            for (int s4 = 0; s4 < 4; ++s4) d = MFMA32(rowfrag(XsT, 32 * ta + l31, s4, hi), colfrag(T_Bh, 32 * tb, s4, lane), d);
            if (ta == tb) { const float gc = GCs[32 * tb + l31];
#pragma unroll
                for (int r = 0; r < 16; ++r) if (crow(r, hi) == l31) d[r] += gc; }
            u32x4* mf = (u32x4*)(prm.ws + WS_MF + (size_t)item * 8192) + ((ta * 2 + tb) * 2) * 64 + lane;
#pragma unroll
            for (int s2 = 0; s2 < 2; ++s2) mf[s2 * 64] = (u32x4){cvtpk(d[8 * s2], d[8 * s2 + 1]), cvtpk(d[8 * s2 + 2], d[8 * s2 + 3]), cvtpk(d[8 * s2 + 4], d[8 * s2 + 5]), cvtpk(d[8 * s2 + 6], d[8 * s2 + 7])};
            f32x16 n = zero16();
#pragma unroll
            for (int s4 = 0; s4 < 4; ++s4) n = MFMA32(colfrag(T_Bh, 32 * ta, s4, lane), rowfrag(XsT, 64 + 32 * tb + l31, s4, hi), n);
#pragma unroll
            for (int s4 = 0; s4 < 4; ++s4) n = MFMA32(colfrag(T_Kh, 32 * ta, s4, lane), colfrag(T_V, 32 * tb, s4, lane), n);
            f32x4* nf = (f32x4*)(prm.ws + WS_NF + (size_t)item * 16384) + ((tb * 2 + ta) * 64 + lane) * 4;
#pragma unroll
            for (int rg = 0; rg < 4; ++rg) nf[rg] = (f32x4){n[4 * rg], n[4 * rg + 1], n[4 * rg + 2], n[4 * rg + 3]};
        } else {
            f32x16 d;
#pragma unroll
            for (int rg = 0; rg < 4; ++rg) { const u32x2 w = *(LAS const u32x2*)(T_Rt + (32 * tb + l31) * TS + (32 * ta + 8 * rg + 4 * hi) * 2);
                d[4 * rg] = bflo(w[0]); d[4 * rg + 1] = bfhi(w[0]); d[4 * rg + 2] = bflo(w[1]); d[4 * rg + 3] = bfhi(w[1]); }
#pragma unroll
            for (int s4 = 0; s4 < 4; ++s4) d = MFMA32(rowfrag(XsT, 32 * ta + l31, s4, hi), rowfrag(T_Arb, 32 * tb + l31, s4, hi), d);
            u32x4* qf = (u32x4*)(prm.ws + WS_QF + (size_t)item * 8192) + ((ta * 2 + tb) * 2) * 64 + lane;
#pragma unroll
            for (int s2 = 0; s2 < 2; ++s2) qf[s2 * 64] = (u32x4){cvtpk(d[8 * s2], d[8 * s2 + 1]), cvtpk(d[8 * s2 + 2], d[8 * s2 + 3]), cvtpk(d[8 * s2 + 4], d[8 * s2 + 5]), cvtpk(d[8 * s2 + 6], d[8 * s2 + 7])};
            f32x16 y = zero16();
#pragma unroll
            for (int s4 = 0; s4 < 4; ++s4) y = MFMA32(rowfrag(XsT, 64 + 32 * ta + l31, s4, hi), rowfrag(T_Arb, 32 * tb + l31, s4, hi), y);
#pragma unroll
            for (int s4 = 0; s4 < 4; ++s4) y = MFMA32(colfrag(T_V, 32 * ta, s4, lane), rowfrag(T_Ark, 32 * tb + l31, s4, hi), y);
            f32x4* yf = (f32x4*)(prm.ws + WS_YF + (size_t)item * 16384) + ((ta * 2 + tb) * 64 + lane) * 4;
#pragma unroll
            for (int rg = 0; rg < 4; ++rg) yf[rg] = (f32x4){y[4 * rg], y[4 * rg + 1], y[4 * rg + 2], y[4 * rg + 3]};
        }
    }
    __syncthreads();
}

constexpr int N_S_BLOCKS = NB * 6 * 2;
__device__ __forceinline__ void passS_block(const Params& prm, LAS unsigned char* lds, int sblk, int tid) {
    const int lane = tid & 63, wave = tid >> 6;
    const int seq = sblk >> 1, vh = sblk & 1;
    const size_t item0 = (size_t)seq * NCH;
    const int ltid = tid - 64;
    const unsigned char* mbase = prm.ws + WS_MF + item0 * 8192;
    const unsigned char* nbase = prm.ws + WS_NF + item0 * 16384 + (size_t)vh * 8192;
    u32x4 hold[8][3];
#define PS_SRC(chunk, piece) (((piece) < 512) ? (const u32x4*)(mbase + (size_t)(chunk) * 8192) + (piece) : (const u32x4*)(nbase + (size_t)(chunk) * 16384) + ((piece) - 512))
#define PS_ISSUE(chunk, buf) do { if ((chunk) < NCH) { hold[buf][0] = *PS_SRC(chunk, ltid); hold[buf][1] = *PS_SRC(chunk, ltid + 448); if (ltid < 128) hold[buf][2] = *PS_SRC(chunk, ltid + 896); } } while (0)
#define PS_COMMIT(chunk, buf) do { if ((chunk) < NCH) { LAS unsigned char* slot_ = lds + ((chunk) & 7) * 16384; *(LAS u32x4*)(slot_ + ltid * 16) = hold[buf][0]; *(LAS u32x4*)(slot_ + (ltid + 448) * 16) = hold[buf][1]; \
        if (ltid < 128) *(LAS u32x4*)(slot_ + (ltid + 896) * 16) = hold[buf][2]; } } while (0)
    f32x16 acc[2]; acc[0] = zero16(); acc[1] = zero16();
    if (wave >= 1) {
        PS_ISSUE(0, 0); PS_ISSUE(1, 1); PS_COMMIT(0, 0); PS_COMMIT(1, 1);
        PS_ISSUE(2, 2); PS_ISSUE(3, 3); PS_ISSUE(4, 4); PS_ISSUE(5, 5); PS_ISSUE(6, 6); PS_ISSUE(7, 7); PS_ISSUE(8, 0); PS_ISSUE(9, 1);
    }
    __syncthreads();
    for (int c8 = 0; c8 < NCH; c8 += 8) {
#pragma unroll
        for (int par = 0; par < 8; ++par) {
            const int cc = c8 + par;
            if (wave == 0) {
                LAS const unsigned char* slot = lds + par * 16384;
                bf16x8 xb[2][2];
#pragma unroll
                for (int kt = 0; kt < 2; ++kt)
#pragma unroll
                    for (int s2 = 0; s2 < 2; ++s2) { const u32x4 w = (u32x4){cvtpk(acc[kt][8 * s2], acc[kt][8 * s2 + 1]), cvtpk(acc[kt][8 * s2 + 2], acc[kt][8 * s2 + 3]), cvtpk(acc[kt][8 * s2 + 4], acc[kt][8 * s2 + 5]), cvtpk(acc[kt][8 * s2 + 6], acc[kt][8 * s2 + 7])};
                        xb[kt][s2] = __builtin_bit_cast(bf16x8, w);
                        ((u32x4*)(prm.ws + WS_SF + (item0 + cc) * 8192))[((vh * 2 + kt) * 2 + s2) * 64 + lane] = w; }
                f32x16 nacc[2];
#pragma unroll
                for (int i = 0; i < 2; ++i) {
#pragma unroll
                    for (int rg = 0; rg < 4; ++rg) { const f32x4 v = *(LAS const f32x4*)(slot + 8192 + (i * 64 + lane) * 64 + rg * 16); nacc[i][4 * rg] = v[0]; nacc[i][4 * rg + 1] = v[1]; nacc[i][4 * rg + 2] = v[2]; nacc[i][4 * rg + 3] = v[3]; }
#pragma unroll
                    for (int kt = 0; kt < 2; ++kt)
#pragma unroll
                        for (int s2 = 0; s2 < 2; ++s2) { const bf16x8 mf = *(LAS const bf16x8*)(slot + (((kt * 2 + i) * 2 + s2) * 64 + lane) * 16); nacc[i] = MFMA32(mf, xb[kt][s2], nacc[i]); }
                }
                acc[0] = nacc[0]; acc[1] = nacc[1];
            } else {
                PS_COMMIT(cc + 2, (par + 2) & 7); PS_ISSUE(cc + 10, (par + 2) & 7);
            }
            __syncthreads();
        }
    }
#undef PS_SRC
#undef PS_ISSUE
#undef PS_COMMIT
    if (wave == 0) {
        float* so = prm.out + O_ST_P + ((size_t)seq * 64 + 32 * vh + (lane & 31)) * 64;
#pragma unroll
        for (int kt = 0; kt < 2; ++kt)
#pragma unroll
            for (int rg = 0; rg < 4; ++rg) *(f32x4*)(so + 32 * kt + 8 * rg + 4 * (lane >> 5)) = (f32x4){acc[kt][4 * rg], acc[kt][4 * rg + 1], acc[kt][4 * rg + 2], acc[kt][4 * rg + 3]};
    }
    __syncthreads();
}

__device__ __forceinline__ void passO_pair(const Params& prm, int item, int tt, int lane) {
    const int hi = lane >> 5, l31 = lane & 31;
    const int seq = item >> 7, c = item & 127, b = seq / 6, h = seq % 6;
    const u32x4* sf = (const u32x4*)(prm.ws + WS_SF + (size_t)item * 8192);
    const u32x4* qf = (const u32x4*)(prm.ws + WS_QF + (size_t)item * 8192);
    const f32x4* yf = (const f32x4*)(prm.ws + WS_YF + (size_t)item * 16384);
    bf16x8 qb[2][2];
#pragma unroll
    for (int kt = 0; kt < 2; ++kt)
#pragma unroll
        for (int s2 = 0; s2 < 2; ++s2) qb[kt][s2] = __builtin_bit_cast(bf16x8, qf[((kt * 2 + tt) * 2 + s2) * 64 + lane]);
    f32x16 y[2];
#pragma unroll
    for (int vt = 0; vt < 2; ++vt) {
#pragma unroll
        for (int rg = 0; rg < 4; ++rg) { const f32x4 v = yf[((vt * 2 + tt) * 64 + lane) * 4 + rg]; y[vt][4 * rg] = v[0]; y[vt][4 * rg + 1] = v[1]; y[vt][4 * rg + 2] = v[2]; y[vt][4 * rg + 3] = v[3]; }
#pragma unroll
        for (int kt = 0; kt < 2; ++kt)
#pragma unroll
            for (int s2 = 0; s2 < 2; ++s2) y[vt] = MFMA32(__builtin_bit_cast(bf16x8, sf[((vt * 2 + kt) * 2 + s2) * 64 + lane]), qb[kt][s2], y[vt]);
    }
    float sm = 0.f;
#pragma unroll
    for (int vt = 0; vt < 2; ++vt)
#pragma unroll
        for (int r = 0; r < 16; ++r) sm += y[vt][r];
    sm += __shfl_xor(sm, 32);
    const float mean = sm * (1.f / 64.f);
    float sq = 0.f;
#pragma unroll
    for (int vt = 0; vt < 2; ++vt)
#pragma unroll
        for (int r = 0; r < 16; ++r) { const float d = y[vt][r] - mean; sq += d * d; }
    sq += __shfl_xor(sq, 32);
    const float rstd = rsqrtf(sq * (1.f / 64.f) + 64e-5f);
    const int t = 64 * c + 32 * tt + l31;
    const size_t row = (size_t)b * SEQ + t;
    const float rho = ((const float*)(prm.ws + WS_RHO))[(size_t)item * 64 + 32 * tt + l31];
    const float* ZB = (const float*)(prm.ws + WS_ZB);
    const float* mu = prm.in[11]; const float* lg = prm.in[19]; const float* lb = prm.in[20];
    const bf16_t* Gb = (const bf16_t*)(prm.ws + WS_G); bf16_t* OG = (bf16_t*)(prm.ws + WS_OG);
#pragma unroll
    for (int vt = 0; vt < 2; ++vt)
#pragma unroll
        for (int rg = 0; rg < 4; ++rg) {
            const int v0 = 32 * vt + 8 * rg + 4 * hi, ch = h * 64 + v0;
            const f32x4 z = *(const f32x4*)(ZB + row * SHIFT_W + 2 * RW + ch);
            f32x4 zp = (f32x4){0.f, 0.f, 0.f, 0.f};
            if (t > 0) zp = *(const f32x4*)(ZB + (row - 1) * SHIFT_W + 2 * RW + ch);
            const f32x4 muv = *(const f32x4*)(mu + 2 * RW + ch), gv = *(const f32x4*)(lg + ch), bv = *(const f32x4*)(lb + ch);
            const u32x2 gw = *(const u32x2*)(Gb + row * DM + 384 + ch);
            const float gg[4] = {bflo(gw[0]), bfhi(gw[0]), bflo(gw[1]), bfhi(gw[1])};
            float o[4];
#pragma unroll
            for (int e = 0; e < 4; ++e) { const float vv = z[e] + (zp[e] - z[e]) * muv[e]; o[e] = ((y[vt][4 * rg + e] - mean) * rstd * gv[e] + bv[e] + rho * vv) * gg[e]; }
            *(u32x2*)(OG + row * DM + 384 + ch) = (u32x2){cvtpk(o[0], o[1]), cvtpk(o[2], o[3])};
        }
}

__device__ __forceinline__ void p0_transpose_item(const float* W, const float* gain, int K, int N, bf16_t* WT, int row_off, LAS float* scr, int item, int lane) {
    const int nblk = N / 32, kb = item / nblk, nb = item % nblk, k0 = 64 * kb, n0 = 32 * nb;
#pragma unroll 8
    for (int i = 0; i < 32; ++i) { const int kk = 2 * i + (lane >> 5); const float gk = gain ? gain[k0 + kk] : 1.f; scr[kk * 33 + (lane & 31)] = W[(size_t)(k0 + kk) * N + n0 + (lane & 31)] * gk; }
    LDS_WAIT(); asm volatile("" ::: "memory");
    const int c = lane & 7;
#pragma unroll
    for (int j = 0; j < 4; ++j) { const int n = (lane >> 3) + 8 * j; const LAS float* s = scr + (8 * c) * 33 + n;
        u32x4 o; o[0] = cvtpk(s[0 * 33], s[1 * 33]); o[1] = cvtpk(s[2 * 33], s[3 * 33]); o[2] = cvtpk(s[4 * 33], s[5 * 33]); o[3] = cvtpk(s[6 * 33], s[7 * 33]);
        *(u32x4*)(WT + (size_t)(row_off + n0 + n) * K + k0 + 8 * c) = o; }
    LDS_WAIT(); asm volatile("" ::: "memory");
}
__device__ __forceinline__ void sincos_acc(float angf, float& c, float& s) {
    const double a = (double)angf;
    const double kq = __builtin_rint(a * 0.63661977236758134308);
    const double r = (a - kq * 1.57079632679489655800) - kq * 6.12323399573676603587e-17;
    const double r2 = r * r;
    double sp = -1.0 / 1307674368000.0; sp = sp * r2 + 1.0 / 6227020800.0; sp = sp * r2 - 1.0 / 39916800.0; sp = sp * r2 + 1.0 / 362880.0; sp = sp * r2 - 1.0 / 5040.0; sp = sp * r2 + 1.0 / 120.0; sp = sp * r2 - 1.0 / 6.0; sp = sp * r2 + 1.0; sp *= r;
    double cp = 1.0 / 87178291200.0; cp = cp * r2 - 1.0 / 479001600.0; cp = cp * r2 + 1.0 / 3628800.0; cp = cp * r2 - 1.0 / 40320.0; cp = cp * r2 + 1.0 / 720.0; cp = cp * r2 - 1.0 / 24.0; cp = cp * r2 + 0.5; cp = 1.0 - cp * r2;
    const int qd = ((int)kq) & 3;
    const double sv = (qd == 0) ? sp : (qd == 1) ? cp : (qd == 2) ? -sp : -cp;
    const double cv = (qd == 0) ? cp : (qd == 1) ? -sp : (qd == 2) ? -cp : sp;
    c = (float)cv; s = (float)sv;
}
__device__ __forceinline__ void p0_prologue(const Ptrs& P, LAS unsigned char* lds, int bid, int G, int tid) {
    const int lane = tid & 63, wave = tid >> 6;
    LAS float* scr = (LAS float*)(lds + wave * 16384);
    const int gw = bid * 8 + wave, NGW = G * 8;
    constexpr int I_IN = (DM / 64) * (IN_W / 32), I_MEM = (DM / 64) * (512 / 32), I_OUT = (DM / 64) * (DM / 32);
    for (int it = gw; it < I_IN + I_MEM + I_OUT; it += NGW) {
        int r = it;
        if (r < I_IN) { p0_transpose_item(P.in[10], P.in[9], DM, IN_W, P.WT, 0, scr, r, lane); continue; } r -= I_IN;
        if (r < I_MEM) { p0_transpose_item(P.in[22], P.in[21], DM, 512, P.WT, NPAD, scr, r, lane); continue; } r -= I_MEM;
        p0_transpose_item(P.in[23], nullptr, DM, DM, P.WOT, 0, scr, r, lane);
    }
    const int gt = bid * NTHR + tid, NGT = G * NTHR;
    for (int e = gt; e < (NPAD - IN_W) * DM / 8; e += NGT) *(u32x4*)(P.WT + (size_t)IN_W * DM + (size_t)e * 8) = (u32x4){0u, 0u, 0u, 0u};
    for (int m = gw; m < MROWS; m += NGW) {
        const float* xr = (m < MP) ? P.in[0] + (size_t)m * DM : (m < MTOK) ? P.in[1] + (size_t)(m - MP) * DM : P.in[8] + (size_t)(m - MTOK) * DM;
        f32x4 v[4]; float ss = 0.f;
#pragma unroll
        for (int j = 0; j < 4; ++j) { v[j] = *(const f32x4*)(xr + (size_t)(64 * j + lane) * 4); ss += (v[j][0] * v[j][0] + v[j][1] * v[j][1]) + (v[j][2] * v[j][2] + v[j][3] * v[j][3]); }
        ss = wave_sum(ss);
        if (lane == 0) P.RINV[m] = rsqrtf(ss * (1.f / DM) + 1e-6f);
#pragma unroll
        for (int j = 0; j < 4; ++j) { u32x2 w; w[0] = cvtpk(v[j][0], v[j][1]); w[1] = cvtpk(v[j][2], v[j][3]); *(u32x2*)(P.XB + (size_t)m * DM + (size_t)(64 * j + lane) * 4) = w; }
    }
    for (int e = gt; e < NPOS * 8; e += NGT) {
        const int pos = e >> 3, i = e & 7;
        const float invf[8] = {1.0f, 0.19392274f, 0.03760603f, 0.0072926646f, 0.0014142136f, 0.0002742482f, 5.3182957e-05f, 1.0313385e-05f};
        float fi = invf[0];
#pragma unroll
        for (int k = 1; k < 8; ++k) fi = (i == k) ? invf[k] : fi;
        const float ang = (float)pos * fi; float c, s; sincos_acc(ang, c, s);
        P.ROPE[pos * 16 + i] = c; P.ROPE[pos * 16 + 8 + i] = s;
    }
    for (int e = gt; e < MTOK; e += NGT) P.SS[e] = 0.f;
}

__device__ __forceinline__ void p3_combine(const Ptrs& P, int bid, int G, int tid) {
    const int gt = bid * NTHR + tid, NGT = G * NTHR;
    for (int e = gt; e < MP * 48; e += NGT) {
        const int row = e / 48, ch = e % 48, h = ch >> 3;
        const float l0 = P.LSE[((size_t)0 * MP + row) * 6 + h], l1 = P.LSE[((size_t)1 * MP + row) * 6 + h], l2 = P.LSE[((size_t)2 * MP + row) * 6 + h];
        const float mx = fmaxf(l0, fmaxf(l1, l2)); const float e0 = __expf(l0 - mx), e1 = __expf(l1 - mx), e2 = __expf(l2 - mx); const float inv = 1.f / (e0 + e1 + e2);
        const float w0 = e0 * inv, w1 = e1 * inv, w2 = e2 * inv;
        const u32x4 a = *(const u32x4*)(P.OAP + ((size_t)0 * MP + row) * ATT_W + ch * 8), b = *(const u32x4*)(P.OAP + ((size_t)1 * MP + row) * ATT_W + ch * 8), c = *(const u32x4*)(P.OAP + ((size_t)2 * MP + row) * ATT_W + ch * 8);
        const u32x4 gg = *(const u32x4*)(P.Gb + (size_t)row * DM + ch * 8);
        u32x4 o;
#pragma unroll
        for (int k = 0; k < 4; ++k) {
            const float lo = (w0 * bflo(a[k]) + w1 * bflo(b[k]) + w2 * bflo(c[k])) * bflo(gg[k]);
            const float hi = (w0 * bfhi(a[k]) + w1 * bfhi(b[k]) + w2 * bfhi(c[k])) * bfhi(gg[k]);
            o[k] = cvtpk(lo, hi);
        }
        *(u32x4*)(P.OG + (size_t)row * DM + ch * 8) = o;
    }
}

__device__ __forceinline__ void p5_norm(const Ptrs& P, int bid, int G, int tid) {
    const int lane = tid & 63, wave = tid >> 6, gw = bid * 8 + wave, NGW = G * 8;
    const float* gf = P.in[24];
    for (int m = gw; m < MTOK; m += NGW) {
        const float rs = rsqrtf(P.SS[m] * (1.f / DM) + 1e-6f);
        float* yr = P.out + O_Y + (size_t)m * DM;
#pragma unroll
        for (int j = 0; j < 4; ++j) { const size_t c = (size_t)(64 * j + lane) * 4; const f32x4 v = *(const f32x4*)(yr + c); const f32x4 gv = *(const f32x4*)(gf + c); *(f32x4*)(yr + c) = v * rs * gv; }
    }
}

#define XB_TMO      128
#define XB_XCNT(j)  (256  + 64 * (j))
#define XB_XSUB(j)  (1280 + 64 * (j))
#define XB_XGEN(j)  (2304 + 64 * (j))
#define XB_TOP      3328
#define XB_TOPGEN   3392
#define XCD_BAR_WORDS 3456
#define XB_SPIN_CAP (1u << 18)
__device__ __forceinline__ unsigned xb_ld(unsigned* p)              { return __hip_atomic_load(p, __ATOMIC_RELAXED, __HIP_MEMORY_SCOPE_AGENT); }
__device__ __forceinline__ unsigned xb_add(unsigned* p, unsigned v) { return __hip_atomic_fetch_add(p, v, __ATOMIC_RELAXED, __HIP_MEMORY_SCOPE_AGENT); }
__device__ __forceinline__ unsigned xb_xcc_id() { return (unsigned)__builtin_amdgcn_s_getreg((3 << 11) | 20) & 0xFu; }
#define XB_SPIN(cond, bar) do { unsigned _sp = 0; while (cond) { __builtin_amdgcn_s_sleep(1); \
    if ((++_sp & 255u) == 0u) { if (xb_ld(&(bar)[XB_TMO])) break; if (_sp > XB_SPIN_CAP) { atomicAdd(&(bar)[XB_TMO], 1u); break; } } } } while (0)
struct XcdBarrier { unsigned* bar; unsigned x; volatile LAS unsigned* st; };
__device__ __forceinline__ XcdBarrier xcd_barrier_post(unsigned* bar, volatile LAS unsigned* st) {
    XcdBarrier b; b.bar = bar; b.x = xb_xcc_id(); b.st = st;
    if (threadIdx.x == 0) (void)xb_add(&bar[XB_XCNT(b.x)], 1u);
    return b;
}
__device__ __forceinline__ void xcd_barrier_complete(unsigned* bar, unsigned x, unsigned& nloc, unsigned& nx) {
    const unsigned G = gridDim.x * gridDim.y * gridDim.z;
    unsigned sum, cnt, mine, sp = 0u;
    for (;;) {
        sum = 0u; cnt = 0u; mine = 0u;
#pragma unroll
        for (unsigned j = 0; j < 16; ++j) { const unsigned c = xb_ld(&bar[XB_XCNT(j)]); sum += c; cnt += (c > 0u) ? 1u : 0u; mine = (j == x) ? c : mine; }
        if (sum == G) break;
        __builtin_amdgcn_s_sleep(1);
        if ((++sp & 255u) == 0u) { if (xb_ld(&bar[XB_TMO])) break; if (sp > XB_SPIN_CAP) { atomicAdd(&bar[XB_TMO], 1u); break; } }
    }
    nloc = mine > 0u ? mine : 1u; nx = cnt > 0u ? cnt : 1u;
}
__device__ __forceinline__ void xcd_barrier(const XcdBarrier& b) {
    asm volatile("s_waitcnt vmcnt(0)" ::: "memory");
    __syncthreads();
    if (threadIdx.x == 0) {
        unsigned* bar = b.bar;
        __builtin_amdgcn_s_waitcnt(0);
        unsigned nloc = b.st[0], nx = b.st[1];
        if (nloc == 0u) { xcd_barrier_complete(bar, b.x, nloc, nx); b.st[0] = nloc; b.st[1] = nx; }
        const unsigned old = xb_add(&bar[XB_XSUB(b.x)], 1u);
        const unsigned gen = old / nloc;
        if (old + 1u == (gen + 1u) * nloc) {
            __builtin_amdgcn_fence(__ATOMIC_RELEASE, "agent");
            asm volatile("s_waitcnt vmcnt(0)" ::: "memory");
            const unsigned og = xb_add(&bar[XB_TOP], 1u);
            const unsigned tg = og / nx;
            if (og + 1u == (tg + 1u) * nx) xb_add(&bar[XB_TOPGEN], 1u);
            else XB_SPIN(xb_ld(&bar[XB_TOPGEN]) == tg, bar);
            __builtin_amdgcn_fence(__ATOMIC_ACQUIRE, "agent");
            xb_add(&bar[XB_XGEN(b.x)], 1u);
            asm volatile("s_waitcnt vmcnt(0)" ::: "memory");
        } else {
            XB_SPIN(xb_ld(&bar[XB_XGEN(b.x)]) == gen, bar);
            __builtin_amdgcn_fence(__ATOMIC_ACQUIRE, "agent");
            asm volatile("s_waitcnt vmcnt(0)" ::: "memory");
        }
    }
    __syncthreads();
}

__global__ void __launch_bounds__(NTHR, 2) fwd_kernel(Params prm) {
    extern __shared__ __attribute__((aligned(16))) unsigned char lds_raw[];
    LAS unsigned char* lds = (LAS unsigned char*)lds_raw;
    const int tid = threadIdx.x, bid = blockIdx.x, G = gridDim.x;
    Ptrs P;
#pragma unroll
    for (int i = 0; i < 25; ++i) P.in[i] = prm.in[i];
    P.out = prm.out; P.ws = prm.ws;
    P.RINV = (float*)(prm.ws + WS_RINV); P.SS = (float*)(prm.ws + WS_SS); P.ROPE = (float*)(prm.ws + WS_ROPE); P.ZB = (float*)(prm.ws + WS_ZB); P.LSE = (float*)(prm.ws + WS_LSE);
    P.WT = (bf16_t*)(prm.ws + WS_WT); P.WOT = (bf16_t*)(prm.ws + WS_WOT); P.XB = (bf16_t*)(prm.ws + WS_XB); P.Qb = (bf16_t*)(prm.ws + WS_Q); P.Kb = (bf16_t*)(prm.ws + WS_K); P.Vb = (bf16_t*)(prm.ws + WS_V);
    P.QMb = (bf16_t*)(prm.ws + WS_QM); P.Gb = (bf16_t*)(prm.ws + WS_G); P.MKB = (bf16_t*)(prm.ws + WS_MKB); P.MVB = (bf16_t*)(prm.ws + WS_MVB); P.OAP = (bf16_t*)(prm.ws + WS_OAP); P.OG = (bf16_t*)(prm.ws + WS_OG);
    const int lo = prm.ph_lo, hi = prm.ph_hi;
#define IN_PH(k) (lo <= (k) && (k) < hi)
    volatile LAS unsigned* bst = (volatile LAS unsigned*)(lds + LDS_BYTES - 16);
    if (tid < 4) bst[tid] = 0u;
    __syncthreads();
    XcdBarrier xbar; xbar.bar = (unsigned*)(prm.ws + WS_CTL) + 4096; xbar.x = 0; xbar.st = bst;
    if (prm.coop) xbar = xcd_barrier_post((unsigned*)(prm.ws + WS_CTL) + 4096, bst);
#define SEAM(k) do { if (IN_PH(k) && IN_PH((k) + 1)) { if ((k) == 0) cg::this_grid().sync(); else xcd_barrier(xbar); } } while (0)

    if (IN_PH(0)) { p0_prologue(P, lds, bid, G, tid); }
    SEAM(0);
    if (IN_PH(1)) {
        pg8::Gemm g{P.XB, P.WT, MROWS, NWT, DM}; Sched1 S; S.init(G, bid);
        Epi1 E{P.RINV, P.ROPE, P.Qb, P.Kb, P.Vb, P.QMb, P.Gb, P.MKB, P.MVB, P.ZB, P.out};
        pg8::gemm_phase<Epi1, Sched1, true, true>(lds, g, S, E);
    }
    SEAM(1);
#define ITEM_LOOP(LO, HI, B0, GG, CALL) do { int it = (LO) + (((B0) - (LO)) % (GG) + (GG)) % (GG); for (; it < (HI); it += (GG)) { const int li = it - (LO); CALL; } } while (0)
    if (IN_PH(2)) {
        constexpr int N0 = N_L_ITEMS, N1 = N0 + N_SCAN_S;
        ITEM_LOOP(0, N0, bid, G, passL_item(prm, lds, li, tid));
        ITEM_LOOP(N0, N1, bid, G, scan_item(P, lds, true, li / 6, li % 6, tid));
    }
    SEAM(2);
    if (IN_PH(3)) {
        if (bid < N_S_BLOCKS) passS_block(prm, lds, bid, tid);
        else {
            constexpr int N1 = N_DIL_UNITS, N2 = N1 + N_MEMA_UNITS, N3 = N2 + N_SDIL_ITEMS, N4 = N3 + N_SMEM_ITEMS;
            const int b0 = bid - N_S_BLOCKS, gg = G - N_S_BLOCKS;
            ITEM_LOOP(0, N1, b0, gg, dil_unit(P, lds, li, tid));
            ITEM_LOOP(N1, N2, b0, gg, mem_unit(P, lds, li, tid));
            ITEM_LOOP(N2, N3, b0, gg, sdil_item(P, lds, li, tid));
            ITEM_LOOP(N3, N4, b0, gg, smem_item(P, lds, li, tid));
        }
    }
    SEAM(3);
    if (IN_PH(4)) {
        for (int pr = bid * 8 + (tid >> 6); pr < 2 * N_L_ITEMS; pr += G * 8) passO_pair(prm, pr >> 1, pr & 1, tid & 63);
        p3_combine(P, bid, G, tid);
    }
    SEAM(4);
    if (IN_PH(5)) {
        pg8::Gemm g{P.OG, P.WOT, MTOK, DM, DM}; pg8::StaticOrder S; S.init(MTOK, DM, G, bid);
        Epi2 E{P.in[0], P.in[1], P.out + O_Y, P.SS};
        pg8::gemm_phase<Epi2, pg8::StaticOrder, true, true>(lds, g, S, E);
    }
    SEAM(5);
    if (IN_PH(6)) { p5_norm(P, bid, G, tid); }
}

constexpr int N_PHASES = 7;
#ifndef MK_ONE_LAUNCH
#define MK_ONE_LAUNCH 1
#endif
extern "C" void kernel_launch(void* const* d_in, const int* in_sizes, int n_in, void* d_out, int out_size, void* d_ws, size_t ws_size, hipStream_t stream) {
    static int grid = 0;
    if (grid == 0) {
        if (n_in != 25 || out_size != (int)O_END || ws_size < WS_END2) { fprintf(stderr, "kernel_launch: unexpected shapes (n_in %d, out %d, ws %zu < %zu)\n", n_in, out_size, ws_size, (size_t)WS_END2); grid = -1; return; }
        int dev = 0, cus = 0, per_cu = 0;
        (void)hipGetDevice(&dev); (void)hipDeviceGetAttribute(&cus, hipDeviceAttributeMultiprocessorCount, dev);
        if (hipFuncSetAttribute((const void*)fwd_kernel, hipFuncAttributeMaxDynamicSharedMemorySize, LDS_BYTES) != hipSuccess) { fprintf(stderr, "kernel_launch: hipFuncSetAttribute failed\n"); grid = -1; return; }
        if (hipOccupancyMaxActiveBlocksPerMultiprocessor(&per_cu, (const void*)fwd_kernel, NTHR, LDS_BYTES) != hipSuccess || per_cu < 1) { fprintf(stderr, "kernel_launch: occupancy query says %d blocks per CU\n", per_cu); (void)hipGetLastError(); per_cu = 1; }
        grid = cus;
    }
    if (grid < 0) return;
    if (hipMemsetAsync((char*)d_ws + WS_CTL, 0, 65536, stream) != hipSuccess) { fprintf(stderr, "kernel_launch: hipMemsetAsync failed\n"); return; }
    Params p{};
    for (int i = 0; i < 25; ++i) p.in[i] = (const float*)d_in[i];
    p.out = (float*)d_out; p.ws = (unsigned char*)d_ws;
#if MK_ONE_LAUNCH
    p.ph_lo = 0; p.ph_hi = N_PHASES; p.coop = 1;
    void* args[] = {&p};
    hipError_t e = hipLaunchCooperativeKernel((const void*)fwd_kernel, dim3(grid), dim3(NTHR), args, LDS_BYTES, stream);
    if (e != hipSuccess) fprintf(stderr, "cooperative launch failed: %s (grid %d)\n", hipGetErrorString(e), grid);
#else
    for (int ph = 0; ph < N_PHASES; ++ph) {
        p.ph_lo = ph; p.ph_hi = ph + 1; p.coop = 0;
        hipLaunchKernelGGL(fwd_kernel, dim3(grid), dim3(NTHR), LDS_BYTES, stream, p);
    }
#endif
}
```

```cpp
#include <hip/hip_runtime.h>
#include <hip/hip_cooperative_groups.h>
#include <cstdio>
#include <cstdint>
namespace cg = cooperative_groups;

#define LAS __attribute__((address_space(3)))
typedef unsigned short bf16_t;
typedef short bf16x8 __attribute__((ext_vector_type(8)));
typedef short s16x4 __attribute__((ext_vector_type(4)));
typedef float f32x4 __attribute__((ext_vector_type(4)));
typedef float f32x2 __attribute__((ext_vector_type(2)));
typedef float f32x16 __attribute__((ext_vector_type(16)));
typedef unsigned u32x4 __attribute__((ext_vector_type(4)));
typedef unsigned u32x2 __attribute__((ext_vector_type(2)));
typedef __bf16 bf16x2_t __attribute__((ext_vector_type(2)));

constexpr int DM = 1024, SEQ = 8192, NB = 2, DB = 32, DT = 8;
constexpr int MP = NB * SEQ;
constexpr int MS = DB * DT;
constexpr int MTOK = MP + MS;
constexpr int NMEM = 256, MMEM = NB * NMEM;
constexpr int MROWS = MTOK + MMEM;
constexpr int ATT_W = 384, RW = 384, MEM_W = 256, SHIFT_W = 1280, IN_W = 3712;
constexpr int NPAD = 3840;
constexpr int NWT = NPAD + 512;
constexpr int WINP = 2048;
constexpr int C_Q = 0, C_K = 384, C_V = 768, C_Z = 1152, C_QM = 2432, C_G = 2688;
constexpr size_t O_Y = 0, O_WK_P = 17039360, O_WV_P = 18612224, O_ST_P = 20185088, O_SH_P = 20234240, O_MK_P = 20236800, O_MV_P = 20367872,
                 O_WK_S = 20498944, O_WV_S = 20597248, O_ST_S = 20695552, O_SH_S = 21481984, O_END = 21522944;
constexpr size_t al256(size_t x) { return (x + 255) & ~(size_t)255; }
constexpr size_t WS_CTL = 0;
constexpr size_t WS_RINV = 1u << 20;
constexpr size_t WS_SS = al256(WS_RINV + (size_t)MROWS * 4);
constexpr size_t WS_ROPE = al256(WS_SS + (size_t)MTOK * 4);
constexpr int NPOS = 8200;
constexpr size_t WS_WT = al256(WS_ROPE + (size_t)NPOS * 16 * 4);
constexpr size_t WS_WOT = al256(WS_WT + (size_t)NWT * DM * 2);
constexpr size_t WS_XB = al256(WS_WOT + (size_t)DM * DM * 2);
constexpr size_t WS_Q = al256(WS_XB + (size_t)MROWS * DM * 2);
constexpr size_t WS_K = al256(WS_Q + (size_t)MTOK * ATT_W * 2);
constexpr size_t WS_V = al256(WS_K + (size_t)MTOK * ATT_W * 2);
constexpr size_t WS_ZB = al256(WS_V + (size_t)MTOK * ATT_W * 2);
constexpr size_t WS_QM = al256(WS_ZB + (size_t)MTOK * SHIFT_W * 4);
constexpr size_t WS_G = al256(WS_QM + (size_t)MTOK * MEM_W * 2);
constexpr size_t WS_MKB = al256(WS_G + (size_t)MTOK * DM * 2);
constexpr size_t WS_MVB = al256(WS_MKB + (size_t)MMEM * MEM_W * 2);
constexpr size_t WS_OAP = al256(WS_MVB + (size_t)MMEM * MEM_W * 2);
constexpr size_t WS_LSE = al256(WS_OAP + (size_t)3 * MP * ATT_W * 2);
constexpr size_t WS_OG = al256(WS_LSE + (size_t)3 * MP * 6 * 4);
constexpr size_t WS_END = al256(WS_OG + (size_t)MTOK * DM * 2);

constexpr int LDS_BYTES = 147456;
constexpr int NTHR = 512;

struct Params {
    const float* in[25];
    float* out;
    unsigned char* ws;
    int ph_lo, ph_hi, coop, pad;
};

__device__ __forceinline__ unsigned cvtpk(float lo, float hi) { f32x2 v = {lo, hi}; bf16x2_t b = __builtin_convertvector(v, bf16x2_t); return __builtin_bit_cast(unsigned, b); }
__device__ __forceinline__ bf16_t f2bf(float f) { return (bf16_t)(cvtpk(f, 0.f) & 0xffffu); }
__device__ __forceinline__ float bf2f(bf16_t b) { return __builtin_bit_cast(float, (unsigned)b << 16); }
__device__ __forceinline__ float bflo(unsigned w) { return __builtin_bit_cast(float, w << 16); }
__device__ __forceinline__ float bfhi(unsigned w) { return __builtin_bit_cast(float, w & 0xffff0000u); }
__device__ __forceinline__ float wave_sum(float v) {
#pragma unroll
    for (int o = 1; o < 64; o <<= 1) v += __shfl_xor(v, o);
    return v;
}
__device__ __forceinline__ float wave_max(float v) {
#pragma unroll
    for (int o = 1; o < 64; o <<= 1) v = fmaxf(v, __shfl_xor(v, o));
    return v;
}
template <int CTRL> __device__ __forceinline__ float dpp_f(float v) { return __builtin_bit_cast(float, __builtin_amdgcn_update_dpp(0, __builtin_bit_cast(int, v), CTRL, 0xf, 0xf, true)); }
__device__ __forceinline__ float sum8(float v) { v += dpp_f<0xB1>(v); v += dpp_f<0x4E>(v); v += dpp_f<0x141>(v); return v; }
#define LDS_WAIT() asm volatile("s_waitcnt lgkmcnt(0)" ::: "memory")

namespace pg8 {
constexpr int BM = 256, BK = 64, HALF = 128, HTB = HALF * BK * 2, STAGE_BYTES = 8 * HTB, NXCD = 8, WGM = 8;
__host__ __device__ __forceinline__ int lds_byte(int r, int c) { const int st = (r >> 4) * 2 + (c >> 5), rr = r & 15, cc = c & 31, ob = rr * 64 + cc * 2; return st * 1024 + (ob ^ (((ob >> 9) & 1) << 5)); }
__host__ __device__ __forceinline__ void stage_rc(int b, int& R, int& C) { const int st = b / 1024, sb = b % 1024, swz = sb ^ (((sb >> 9) & 1) << 5); R = (st >> 1) * 16 + swz / 64; C = (st & 1) * 32 + (swz % 64) / 2; }
__host__ __device__ __forceinline__ int perm32(int rho) { const int n = rho >> 4, i = rho & 15; return 8 * (i >> 2) + 4 * n + (i & 3); }
struct Unit { int pm, pn; };
struct Gemm { const bf16_t* A; const bf16_t* Bt; int M, N, K; };
struct StaticOrder {
    int nM, nN, nwg, G, c;
    __host__ __device__ void init(int M, int N, int G_, int c_) { nM = M / BM; nN = N / BM; nwg = nM * nN; G = G_; c = c_; }
    __host__ __device__ bool next(int i, Unit& u) const {
        const long L = (long)i * G + c; if (L >= nwg) return false;
        int wgid = (int)L; { const int q = nwg / NXCD, r = nwg % NXCD, xcd = wgid % NXCD, off = wgid / NXCD; wgid = (xcd < r ? xcd * (q + 1) : r * (q + 1) + (xcd - r) * q) + off; }
        const int nig = WGM * nN, gid = wgid / nig, fm = gid * WGM, gsz = (nM - fm) < WGM ? (nM - fm) : WGM;
        u.pm = fm + ((wgid % nig) % gsz); u.pn = (wgid % nig) / gsz; return true;
    }
    __device__ __forceinline__ void a_ready(const Unit&) const {}
    __device__ __forceinline__ void done(const Unit&) const {}
};

template <class Epi, class Sched, bool ALIGN_EPI = false, bool SP2 = false>
__device__ __forceinline__ void gemm_phase(LAS unsigned char* lds, const Gemm g, const Sched& S, const Epi& E) {
    const int tid = threadIdx.x, wid = __builtin_amdgcn_readfirstlane(tid >> 6), lane = tid & 63, wr = wid >> 2, wc = wid & 3, fr = lane & 15, fq = lane >> 4;
    const int K = g.K, nt = K / BK;
    unsigned voffA[2], voffB[2];
#pragma unroll
    for (int i = 0; i < 2; ++i) { int R, C; stage_rc(tid * 16 + i * 8192, R, C); const int Rb = Epi::PERM ? ((R & ~31) + perm32(R & 31)) : R;
        voffA[i] = (unsigned)(R * K + C) * 2u; voffB[i] = (unsigned)(Rb * K + C) * 2u; }
    const size_t kstep = (size_t)(BK * 2);
    const size_t hstep = (size_t)HALF * K * 2;
    const size_t tstep = 2 * hstep;
    const unsigned ldsw = (unsigned)wid * 1024u;
    const int aoff = lds_byte(wr * 64 + fr, fq * 8), boff = lds_byte(wc * 32 + fr, fq * 8);
#define PG8_SA(b, h) (((b) * 2 + (h)) * HTB)
#define PG8_SB(b, h) ((4 + (b) * 2 + (h)) * HTB)
#define PG8_STAGE(bufoff, gbase, voff) do { _Pragma("unroll") for (int _i = 0; _i < 2; ++_i) \
        __builtin_amdgcn_global_load_lds((const unsigned*)((const char*)(gbase) + (voff)[_i]), (LAS unsigned*)(lds + (bufoff) + ldsw + _i * 8192), 16, 0, 0); } while (0)
#define PG8_LDA(dst, b, h) do { _Pragma("unroll") for (int m = 0; m < 4; ++m) _Pragma("unroll") for (int k = 0; k < 2; ++k) dst[m][k] = *(const LAS bf16x8*)(lds + PG8_SA(b, h) + aoff + m * 2048 + k * 1024); } while (0)
#define PG8_LDB(dst, b, h) do { _Pragma("unroll") for (int n = 0; n < 2; ++n) _Pragma("unroll") for (int k = 0; k < 2; ++k) dst[n][k] = *(const LAS bf16x8*)(lds + PG8_SB(b, h) + boff + n * 2048 + k * 1024); } while (0)
#define PG8_MMA(ai, bj, At, Bt) do { __builtin_amdgcn_s_setprio(1); _Pragma("unroll") for (int m = 0; m < 4; ++m) _Pragma("unroll") for (int n = 0; n < 2; ++n) _Pragma("unroll") for (int k = 0; k < 2; ++k) \
        acc[ai][bj][m][n] = __builtin_amdgcn_mfma_f32_16x16x32_bf16(Bt[n][k], At[m][k], acc[ai][bj][m][n], 0, 0, 0); __builtin_amdgcn_s_setprio(0); } while (0)
#define PG8_WAIT_V(n) asm volatile("s_waitcnt vmcnt(" #n ")" ::: "memory")
#define PG8_WAIT_L(n) asm volatile("s_waitcnt lgkmcnt(" #n ")" ::: "memory")
#define PG8_BAR __builtin_amdgcn_s_barrier()
#define PG8_SCHED __builtin_amdgcn_sched_barrier(0)
    Unit cur, nxt; int ui = 0;
    if (!S.next(0, cur)) return;
    f32x4 acc[2][2][4][2];
#pragma unroll
    for (int a = 0; a < 2; ++a)
#pragma unroll
        for (int b = 0; b < 2; ++b)
#pragma unroll
            for (int m = 0; m < 4; ++m)
#pragma unroll
                for (int n = 0; n < 2; ++n) acc[a][b][m][n] = (f32x4){0.f, 0.f, 0.f, 0.f};
    bf16x8 At[4][2], B0[2][2], B1[2][2];
    const char* cA = (const char*)g.A + (size_t)cur.pm * tstep; const char* cB = (const char*)g.Bt + (size_t)cur.pn * tstep;
    S.a_ready(cur);
    if constexpr (SP2) {
        PG8_STAGE(PG8_SB(0, 0), cB, voffB); PG8_STAGE(PG8_SB(0, 1), cB + hstep, voffB); PG8_STAGE(PG8_SA(0, 0), cA, voffA); PG8_STAGE(PG8_SA(0, 1), cA + hstep, voffA);
        if (wr == 1) PG8_BAR;
        PG8_WAIT_V(2); PG8_BAR;
        PG8_STAGE(PG8_SB(1, 0), cB + kstep, voffB); PG8_STAGE(PG8_SA(1, 0), cA + kstep, voffA); PG8_STAGE(PG8_SB(1, 1), cB + hstep + kstep, voffB);
        PG8_WAIT_V(6); PG8_BAR;
    } else {
        PG8_STAGE(PG8_SB(0, 0), cB, voffB); PG8_STAGE(PG8_SA(0, 0), cA, voffA); PG8_STAGE(PG8_SB(0, 1), cB + hstep, voffB); PG8_STAGE(PG8_SA(0, 1), cA + hstep, voffA);
        if (wr == 1) PG8_BAR;
        PG8_WAIT_V(4); PG8_BAR;
        PG8_STAGE(PG8_SB(1, 0), cB + kstep, voffB); PG8_STAGE(PG8_SA(1, 0), cA + kstep, voffA); PG8_STAGE(PG8_SB(1, 1), cB + hstep + kstep, voffB);
        PG8_WAIT_V(6); PG8_BAR;
    }
    for (;;) {
        const bool has_next = S.next(ui + 1, nxt);
        const char* nA = has_next ? (const char*)g.A + (size_t)nxt.pm * tstep : cA; const char* nB = has_next ? (const char*)g.Bt + (size_t)nxt.pn * tstep : cB;
        for (int t = 0; t < nt; t += 2) {
            const bool last = (t == nt - 2);
            const char* a1 = cA + (size_t)(t + 1) * kstep;
            const char* a2 = last ? nA : cA + (size_t)(t + 2) * kstep; const char* b2 = last ? nB : cB + (size_t)(t + 2) * kstep;
            const char* a3 = a2 + kstep; const char* b3 = b2 + kstep;
            if (last && has_next) S.a_ready(nxt);
            if constexpr (SP2) {
            PG8_LDB(B0, 0, 0); PG8_LDB(B1, 0, 1); PG8_SCHED; PG8_LDA(At, 0, 0); PG8_STAGE(PG8_SA(1, 1), a1 + hstep, voffA);
            PG8_WAIT_V(8); PG8_WAIT_L(0); PG8_BAR; PG8_MMA(0, 0, At, B0); PG8_MMA(0, 1, At, B1); PG8_BAR; PG8_SCHED;
            PG8_LDA(At, 0, 1); PG8_STAGE(PG8_SB(0, 0), b2, voffB); PG8_STAGE(PG8_SB(0, 1), b2 + hstep, voffB); PG8_STAGE(PG8_SA(0, 0), a2, voffA);
            PG8_WAIT_V(8); PG8_WAIT_L(0); PG8_BAR; PG8_MMA(1, 0, At, B0); PG8_MMA(1, 1, At, B1); PG8_BAR; PG8_SCHED;
            PG8_LDB(B0, 1, 0); PG8_LDB(B1, 1, 1); PG8_SCHED; PG8_LDA(At, 1, 0); PG8_STAGE(PG8_SA(0, 1), a2 + hstep, voffA);
            PG8_WAIT_V(8); PG8_WAIT_L(0); PG8_BAR; PG8_MMA(0, 0, At, B0); PG8_MMA(0, 1, At, B1); PG8_BAR; PG8_SCHED;
            PG8_LDA(At, 1, 1); PG8_STAGE(PG8_SB(1, 0), b3, voffB); PG8_STAGE(PG8_SB(1, 1), b3 + hstep, voffB); PG8_STAGE(PG8_SA(1, 0), a3, voffA);
            PG8_WAIT_V(8); PG8_WAIT_L(0); PG8_BAR; PG8_MMA(1, 0, At, B0); PG8_MMA(1, 1, At, B1); PG8_BAR; PG8_SCHED;
            } else {
            PG8_LDB(B0, 0, 0); PG8_SCHED; PG8_LDA(At, 0, 0); PG8_STAGE(PG8_SA(1, 1), a1 + hstep, voffA);
            PG8_WAIT_L(8); PG8_BAR; PG8_WAIT_L(0); PG8_MMA(0, 0, At, B0); PG8_BAR; PG8_SCHED;
            PG8_LDB(B1, 0, 1); PG8_STAGE(PG8_SB(0, 0), b2, voffB);
            PG8_BAR; PG8_WAIT_L(0); PG8_MMA(0, 1, At, B1); PG8_BAR;
            PG8_LDA(At, 0, 1); PG8_STAGE(PG8_SA(0, 0), a2, voffA);
            PG8_BAR; PG8_WAIT_L(0); PG8_MMA(1, 0, At, B0); PG8_BAR; PG8_SCHED;
            PG8_STAGE(PG8_SB(0, 1), b2 + hstep, voffB);
            PG8_WAIT_V(6); PG8_BAR; PG8_MMA(1, 1, At, B1); PG8_BAR;
            PG8_LDB(B0, 1, 0); PG8_SCHED; PG8_LDA(At, 1, 0); PG8_STAGE(PG8_SA(0, 1), a2 + hstep, voffA);
            PG8_WAIT_L(8); PG8_BAR; PG8_WAIT_L(0); PG8_MMA(0, 0, At, B0); PG8_BAR; PG8_SCHED;
            PG8_LDB(B1, 1, 1); PG8_STAGE(PG8_SB(1, 0), b3, voffB);
            PG8_BAR; PG8_WAIT_L(0); PG8_MMA(0, 1, At, B1); PG8_BAR;
            PG8_LDA(At, 1, 1); PG8_STAGE(PG8_SA(1, 0), a3, voffA);
            PG8_BAR; PG8_WAIT_L(0); PG8_MMA(1, 0, At, B0); PG8_BAR; PG8_SCHED;
            PG8_STAGE(PG8_SB(1, 1), b3 + hstep, voffB);
            PG8_WAIT_V(6); PG8_BAR; PG8_MMA(1, 1, At, B1); PG8_BAR;
            }
        }
        if constexpr (ALIGN_EPI) { if (wr == 0) PG8_BAR; }
        if constexpr (!Epi::AFTER_DRAIN) { E(acc, cur, wr, wc, fr, fq); S.done(cur); }
        if (!has_next) break;
#pragma unroll
        for (int a = 0; a < 2; ++a)
#pragma unroll
            for (int b = 0; b < 2; ++b)
#pragma unroll
                for (int m = 0; m < 4; ++m)
#pragma unroll
                    for (int n = 0; n < 2; ++n) acc[a][b][m][n] = (f32x4){0.f, 0.f, 0.f, 0.f};
        cur = nxt; cA = nA; cB = nB; ++ui;
        if constexpr (ALIGN_EPI) { if (wr == 1) PG8_BAR; }
    }
    PG8_WAIT_V(0);
    if constexpr (!ALIGN_EPI) { if (wr == 0) PG8_BAR; }
    PG8_BAR;
    if constexpr (Epi::AFTER_DRAIN) { E.fused(acc, cur, wr, wc, fr, fq, lds, wid, lane); S.done(cur); }
#undef PG8_SA
#undef PG8_SB
#undef PG8_STAGE
#undef PG8_LDA
#undef PG8_LDB
#undef PG8_MMA
#undef PG8_WAIT_V
#undef PG8_WAIT_L
#undef PG8_BAR
#undef PG8_SCHED
}
}

constexpr int G1_NM = MTOK / 256, G1_NN = NPAD / 256, G1_MAIN = G1_NM * G1_NN, G1_UNITS = G1_MAIN + 4;
struct Sched1 {
    pg8::StaticOrder so;
    __device__ void init(int G, int c) { so.init(MTOK, NPAD, G, c); }
    __device__ bool next(int i, pg8::Unit& u) const {
        const long L = (long)i * so.G + so.c;
        if (L >= G1_UNITS) return false;
        if (L >= G1_MAIN) { const int e = (int)L - G1_MAIN; u.pm = G1_NM + (e >> 1); u.pn = G1_NN + (e & 1); return true; }
        return so.next(i, u);
    }
    __device__ __forceinline__ void a_ready(const pg8::Unit&) const {}
    __device__ __forceinline__ void done(const pg8::Unit&) const {}
};

struct Epi1 {
    static constexpr bool PERM = true, AFTER_DRAIN = false;
    const float* rinv; const float* rope; bf16_t *Qb, *Kb, *Vb, *QMb, *Gb, *MKB, *MVB; float* ZB; float* out;
    __device__ __forceinline__ void operator()(const f32x4 (&acc)[2][2][4][2], const pg8::Unit& u, int wr, int wc, int fr, int fq) const {
        const bool memu = u.pm >= G1_NM;
#pragma unroll
        for (int ai = 0; ai < 2; ++ai)
#pragma unroll
            for (int m = 0; m < 4; ++m) {
                const int row = u.pm * 256 + ai * 128 + wr * 64 + m * 16 + fr;
                const float rs = rinv[row];
#pragma unroll
                for (int bj = 0; bj < 2; ++bj) {
                    const int c0 = u.pn * 256 + bj * 128 + wc * 32 + 8 * fq;
                    float v[8];
#pragma unroll
                    for (int e = 0; e < 4; ++e) { v[e] = acc[ai][bj][m][0][e] * rs; v[4 + e] = acc[ai][bj][m][1][e] * rs; }
                    if (memu) {
                        const int mrow = row - MTOK, mc = c0 - NPAD;
                        float* of = out + (mc < 256 ? O_MK_P : O_MV_P) + (size_t)mrow * 256 + (mc & 255);
                        *(f32x4*)of = (f32x4){v[0], v[1], v[2], v[3]}; *(f32x4*)(of + 4) = (f32x4){v[4], v[5], v[6], v[7]};
                        bf16_t* ob = (mc < 256 ? MKB : MVB) + (size_t)mrow * 256 + (mc & 255);
                        *(u32x4*)ob = (u32x4){cvtpk(v[0], v[1]), cvtpk(v[2], v[3]), cvtpk(v[4], v[5]), cvtpk(v[6], v[7])};
                        continue;
                    }
                    const int cb = c0 >> 7;
                    const bool samp = row >= MP;
                    const int srow = row - MP;
                    if (cb < 6) {
                        if ((wc & 1) == 0) {
                            float pr[8];
#pragma unroll
                            for (int e = 0; e < 8; ++e) pr[e] = __shfl_xor(v[e], 16);
                            if (fq < 2) {
                                const int pos = samp ? (SEQ + (srow & 7)) : (row & (SEQ - 1));
                                const f32x4 c0v = *(const f32x4*)(rope + (size_t)pos * 16), c1v = *(const f32x4*)(rope + (size_t)pos * 16 + 4);
                                const f32x4 s0v = *(const f32x4*)(rope + (size_t)pos * 16 + 8), s1v = *(const f32x4*)(rope + (size_t)pos * 16 + 12);
                                const float cs[8] = {c0v[0], c0v[1], c0v[2], c0v[3], c1v[0], c1v[1], c1v[2], c1v[3]};
                                const float sn[8] = {s0v[0], s0v[1], s0v[2], s0v[3], s1v[0], s1v[1], s1v[2], s1v[3]};
                                const float sg = (fq == 0) ? -1.f : 1.f;
#pragma unroll
                                for (int e = 0; e < 8; ++e) v[e] = v[e] * cs[e] + sg * pr[e] * sn[e];
                            }
                        }
                        if (cb < 3) {
#pragma unroll
                            for (int e = 0; e < 8; ++e) v[e] *= 0.125f;
                            *(u32x4*)(Qb + (size_t)row * ATT_W + c0) = (u32x4){cvtpk(v[0], v[1]), cvtpk(v[2], v[3]), cvtpk(v[4], v[5]), cvtpk(v[6], v[7])};
                        } else {
                            const int cc = c0 - C_K;
                            *(u32x4*)(Kb + (size_t)row * ATT_W + cc) = (u32x4){cvtpk(v[0], v[1]), cvtpk(v[2], v[3]), cvtpk(v[4], v[5]), cvtpk(v[6], v[7])};
                            float* of = nullptr;
                            if (samp) of = out + O_WK_S + (size_t)srow * ATT_W + cc;
                            else { const int t = row & (SEQ - 1); if (t >= SEQ - WINP) of = out + O_WK_P + ((size_t)(row >> 13) * WINP + (t - (SEQ - WINP))) * ATT_W + cc; }
                            if (of) { *(f32x4*)of = (f32x4){v[0], v[1], v[2], v[3]}; *(f32x4*)(of + 4) = (f32x4){v[4], v[5], v[6], v[7]}; }
                        }
                    } else if (cb < 9) {
                        const int cc = c0 - C_V;
                        *(u32x4*)(Vb + (size_t)row * ATT_W + cc) = (u32x4){cvtpk(v[0], v[1]), cvtpk(v[2], v[3]), cvtpk(v[4], v[5]), cvtpk(v[6], v[7])};
                        float* of = nullptr;
                        if (samp) of = out + O_WV_S + (size_t)srow * ATT_W + cc;
                        else { const int t = row & (SEQ - 1); if (t >= SEQ - WINP) of = out + O_WV_P + ((size_t)(row >> 13) * WINP + (t - (SEQ - WINP))) * ATT_W + cc; }
                        if (of) { *(f32x4*)of = (f32x4){v[0], v[1], v[2], v[3]}; *(f32x4*)(of + 4) = (f32x4){v[4], v[5], v[6], v[7]}; }
                    } else if (cb < 19) {
                        const int cc = c0 - C_Z;
                        float* zf = ZB + (size_t)row * SHIFT_W + cc;
                        *(f32x4*)zf = (f32x4){v[0], v[1], v[2], v[3]}; *(f32x4*)(zf + 4) = (f32x4){v[4], v[5], v[6], v[7]};
                        float* of = nullptr;
                        if (samp) { if ((srow & 7) == 7) of = out + O_SH_S + (size_t)(srow >> 3) * SHIFT_W + cc; }
                        else if ((row & (SEQ - 1)) == SEQ - 1) of = out + O_SH_P + (size_t)(row >> 13) * SHIFT_W + cc;
                        if (of) { *(f32x4*)of = (f32x4){v[0], v[1], v[2], v[3]}; *(f32x4*)(of + 4) = (f32x4){v[4], v[5], v[6], v[7]}; }
                    } else if (cb < 21) {
                        const int cc = c0 - C_QM;
#pragma unroll
                        for (int e = 0; e < 8; ++e) v[e] *= 0.125f;
                        *(u32x4*)(QMb + (size_t)row * MEM_W + cc) = (u32x4){cvtpk(v[0], v[1]), cvtpk(v[2], v[3]), cvtpk(v[4], v[5]), cvtpk(v[6], v[7])};
                    } else if (cb < 29) {
                        const int cc = c0 - C_G;
#pragma unroll
                        for (int e = 0; e < 8; ++e) v[e] = v[e] / (1.f + __expf(-v[e]));
                        *(u32x4*)(Gb + (size_t)row * DM + cc) = (u32x4){cvtpk(v[0], v[1]), cvtpk(v[2], v[3]), cvtpk(v[4], v[5]), cvtpk(v[6], v[7])};
                    }
                }
            }
    }
};

struct Epi2 {
    static constexpr bool PERM = false, AFTER_DRAIN = false;
    const float* xp; const float* xs; float* Y; float* SS;
    __device__ __forceinline__ void operator()(const f32x4 (&acc)[2][2][4][2], const pg8::Unit& u, int wr, int wc, int fr, int fq) const {
#pragma unroll
        for (int ai = 0; ai < 2; ++ai)
#pragma unroll
            for (int m = 0; m < 4; ++m) {
                const int row = u.pm * 256 + ai * 128 + wr * 64 + m * 16 + fr;
                const float* xr = (row < MP) ? xp + (size_t)row * DM : xs + (size_t)(row - MP) * DM;
                float ss = 0.f;
#pragma unroll
                for (int bj = 0; bj < 2; ++bj)
#pragma unroll
                    for (int n = 0; n < 2; ++n) {
                        const int c = u.pn * 256 + bj * 128 + wc * 32 + n * 16 + 4 * fq;
                        const f32x4 xv = *(const f32x4*)(xr + c);
                        const f32x4 o = xv + acc[ai][bj][m][n];
                        ss += (o[0] * o[0] + o[1] * o[1]) + (o[2] * o[2] + o[3] * o[3]);
                        *(f32x4*)(Y + (size_t)row * DM + c) = o;
                    }
                ss += __shfl_xor(ss, 16); ss += __shfl_xor(ss, 32);
                if (fq == 0) atomicAdd(SS + row, ss);
            }
    }
};

constexpr int KS = 144, VS = 144;
constexpr float L2E = 1.4426950408889634f;
__device__ __forceinline__ int crow(int r, int hi) { return (r & 3) + 8 * (r >> 2) + 4 * hi; }
typedef short v4i16_t __attribute__((ext_vector_type(4)));
__device__ __forceinline__ s16x4 vtr(LAS const unsigned char* p) { return __builtin_bit_cast(s16x4, __builtin_amdgcn_ds_read_tr16_b64_v4i16((LAS v4i16_t*)p)); }

template <int NTG, int NG, bool BAND>
__device__ __forceinline__ void strip_attn(const bf16x8 (&qf)[4], LAS const unsigned char* Kl, LAS const unsigned char* Vl, int krow0, int lane, int kmin,
                                           f32x16 (&o)[2], float& m_out, float& l_out) {
    const int q = lane & 31, hi = lane >> 5;
    float m_run = -INFINITY, l_run = 0.f;
#pragma unroll
    for (int r = 0; r < 16; ++r) { o[0][r] = 0.f; o[1][r] = 0.f; }
#pragma unroll
    for (int g = 0; g < NG; ++g) {
        f32x16 S[NTG];
#pragma unroll
        for (int t = 0; t < NTG; ++t) {
#pragma unroll
            for (int r = 0; r < 16; ++r) S[t][r] = 0.f;
            LAS const unsigned char* kp = Kl + (size_t)(krow0 + (g * NTG + t) * 32 + q) * KS + hi * 16;
#pragma unroll
            for (int d0 = 0; d0 < 4; ++d0) {
                const bf16x8 kf = *(LAS const bf16x8*)(kp + d0 * 32);
                S[t] = __builtin_amdgcn_mfma_f32_32x32x16_bf16(kf, qf[d0], S[t], 0, 0, 0);
            }
        }
        float mx = -INFINITY;
#pragma unroll
        for (int t = 0; t < NTG; ++t)
#pragma unroll
            for (int r = 0; r < 16; ++r) {
                if (BAND) { const int ko = 32 * (g * NTG + t) + crow(r, hi); if (ko < q || ko > q + 128 || ko < kmin) S[t][r] = -INFINITY; }
                mx = fmaxf(mx, S[t][r]);
            }
        mx = fmaxf(mx, __shfl_xor(mx, 32));
        const float m_new = fmaxf(m_run, mx);
        const float alpha = __builtin_amdgcn_exp2f((m_run - m_new) * L2E);
        float ls = 0.f;
#pragma unroll
        for (int t = 0; t < NTG; ++t)
#pragma unroll
            for (int r = 0; r < 16; ++r) { const float p = __builtin_amdgcn_exp2f((S[t][r] - m_new) * L2E); S[t][r] = p; ls += p; }
        ls += __shfl_xor(ls, 32);
        l_run = l_run * alpha + ls; m_run = m_new;
        if (g > 0) {
#pragma unroll
            for (int r = 0; r < 16; ++r) { const float a = __shfl(alpha, crow(r, hi)); o[0][r] *= a; o[1][r] *= a; }
        }
#pragma unroll
        for (int t = 0; t < NTG; ++t)
#pragma unroll
            for (int s = 0; s < 2; ++s) {
                u32x4 pw; pw[0] = cvtpk(S[t][8 * s + 0], S[t][8 * s + 1]); pw[1] = cvtpk(S[t][8 * s + 2], S[t][8 * s + 3]);
                pw[2] = cvtpk(S[t][8 * s + 4], S[t][8 * s + 5]); pw[3] = cvtpk(S[t][8 * s + 6], S[t][8 * s + 7]);
                const bf16x8 pa = __builtin_bit_cast(bf16x8, pw);
                const int vrow = krow0 + (g * NTG + t) * 32 + 16 * s + 4 * hi + ((lane & 15) >> 2);
                LAS const unsigned char* vp = Vl + (size_t)vrow * VS + (16 * ((lane >> 4) & 1) + 4 * (lane & 3)) * 2;
#pragma unroll
                for (int dt = 0; dt < 2; ++dt) {
                    const s16x4 lo = vtr(vp + dt * 64), hh = vtr(vp + dt * 64 + 8 * VS);
                    const bf16x8 vb = (bf16x8){lo[0], lo[1], lo[2], lo[3], hh[0], hh[1], hh[2], hh[3]};
                    o[dt] = __builtin_amdgcn_mfma_f32_32x32x16_bf16(pa, vb, o[dt], 0, 0, 0);
                }
            }
    }
    m_out = m_run; l_out = l_run;
}

struct Ptrs {
    const float* in[25]; float* out; unsigned char* ws;
    float *RINV, *SS, *ROPE, *ZB, *LSE;
    bf16_t *WT, *WOT, *XB, *Qb, *Kb, *Vb, *QMb, *Gb, *MKB, *MVB, *OAP, *OG;
};

constexpr int N_DIL_UNITS = NB * 6 * 3 * 32;
__device__ __forceinline__ void dil_unit(const Ptrs& P, LAS unsigned char* lds, int unit, int tid) {
    const int lane = tid & 63, wave = tid >> 6;
    const int u32 = unit & 31, x = unit >> 5, di = x % 3, bh = x / 3, b = bh / 6, h = bh % 6;
    const int dil = (di == 0) ? 1 : (di == 1 ? 4 : 16), nb2 = 32 / dil, res = u32 / nb2, j = u32 % nb2;
    LAS unsigned char* Kl = lds; LAS unsigned char* Vl = lds + 384 * KS;
    const int l0 = 256 * j - 128;
#pragma unroll
    for (int i = 0; i < 6; ++i) {
        const int e = tid + NTHR * i, row = e >> 3, c = e & 7, l = l0 + row;
        u32x4 kv = (u32x4){0u, 0u, 0u, 0u}, vv = kv;
        if (l >= 0) { const size_t off = ((size_t)b * SEQ + (size_t)l * dil + res) * ATT_W + h * 64 + c * 8; kv = *(const u32x4*)(P.Kb + off); vv = *(const u32x4*)(P.Vb + off); }
        *(LAS u32x4*)(Kl + row * KS + c * 16) = kv; *(LAS u32x4*)(Vl + row * VS + c * 16) = vv;
    }
    __syncthreads();
    const int q = lane & 31, hi = lane >> 5, lq0 = 256 * j + 32 * wave;
    const size_t tokq = (size_t)b * SEQ + (size_t)(lq0 + q) * dil + res;
    bf16x8 qf[4];
#pragma unroll
    for (int d0 = 0; d0 < 4; ++d0) qf[d0] = *(const bf16x8*)(P.Qb + tokq * ATT_W + h * 64 + d0 * 16 + hi * 8);
    f32x16 o[2]; float mm, ll;
    strip_attn<5, 1, true>(qf, Kl, Vl, 32 * wave, lane, (lq0 < 128) ? 128 - lq0 : 0, o, mm, ll);
    const float linv = 1.f / ll;
#pragma unroll
    for (int r = 0; r < 16; ++r) {
        const int qq = crow(r, hi); const float li = __shfl(linv, qq);
        const size_t tok = (size_t)b * SEQ + (size_t)(lq0 + qq) * dil + res;
        bf16_t* op = P.OAP + ((size_t)di * MP + tok) * ATT_W + h * 64 + q;
        op[0] = f2bf(o[0][r] * li); op[32] = f2bf(o[1][r] * li);
    }
    if (hi == 0) P.LSE[((size_t)di * MP + tokq) * 6 + h] = mm + __logf(ll);
    __syncthreads();
}

constexpr int N_MEMA_UNITS = NB * 4 * 32;
__device__ __forceinline__ void mem_unit(const Ptrs& P, LAS unsigned char* lds, int unit, int tid) {
    const int lane = tid & 63, wave = tid >> 6;
    const int jq = unit & 31, bh = unit >> 5, b = bh >> 2, hm = bh & 3;
    LAS unsigned char* Kl = lds; LAS unsigned char* Vl = lds + 256 * KS;
#pragma unroll
    for (int i = 0; i < 4; ++i) {
        const int e = tid + NTHR * i, row = e >> 3, c = e & 7;
        const size_t off = ((size_t)b * NMEM + row) * MEM_W + hm * 64 + c * 8;
        *(LAS u32x4*)(Kl + row * KS + c * 16) = *(const u32x4*)(P.MKB + off); *(LAS u32x4*)(Vl + row * VS + c * 16) = *(const u32x4*)(P.MVB + off);
    }
    __syncthreads();
    const int q = lane & 31, hi = lane >> 5;
    const size_t tok0 = (size_t)b * SEQ + 256 * jq + 32 * wave;
    bf16x8 qf[4];
#pragma unroll
    for (int d0 = 0; d0 < 4; ++d0) qf[d0] = *(const bf16x8*)(P.QMb + (tok0 + q) * MEM_W + hm * 64 + d0 * 16 + hi * 8);
    f32x16 o[2]; float mm, ll;
    strip_attn<4, 2, false>(qf, Kl, Vl, 0, lane, 0, o, mm, ll);
    const float linv = 1.f / ll;
#pragma unroll
    for (int r = 0; r < 16; ++r) {
        const int qq = crow(r, hi); const float li = __shfl(linv, qq);
        const size_t oo = (tok0 + qq) * DM + 768 + hm * 64 + q;
        P.OG[oo] = f2bf(o[0][r] * li * bf2f(P.Gb[oo])); P.OG[oo + 32] = f2bf(o[1][r] * li * bf2f(P.Gb[oo + 32]));
    }
    __syncthreads();
}

constexpr int N_SDIL_ITEMS = DB * DT;
__device__ __forceinline__ void sdil_item(const Ptrs& P, LAS unsigned char* lds, int item, int tid) {
    const int db = item >> 3, i = item & 7, lane = tid & 63, wave = tid >> 6;
    LAS float* sc = (LAS float*)lds;
    LAS float* st = sc + 3 * 132 * 6;
    LAS float* red = st + 32;
    const int g = tid / 96, u = tid % 96, hh = u >> 4;
    const size_t srow = (size_t)MP + db * 8 + i;
    const float* ck = P.in[2] + (size_t)db * WINP * ATT_W; const float* cv = P.in[3] + (size_t)db * WINP * ATT_W;
    const float* nk = P.out + O_WK_S + (size_t)db * 8 * ATT_W; const float* nv = P.out + O_WV_S + (size_t)db * 8 * ATT_W;
    f32x4 q4 = (f32x4){0.f, 0.f, 0.f, 0.f};
    if (g < 5) { const u32x2 w = *(const u32x2*)(P.Qb + srow * ATT_W + u * 4); q4 = (f32x4){bflo(w[0]), bfhi(w[0]), bflo(w[1]), bfhi(w[1])}; }
    for (int di = 0; di < 3; ++di) {
        const int dil = (di == 0) ? 1 : (di == 1 ? 4 : 16);
        for (int jj = g; jj < 129 + 4; jj += 5) {
            float d = 0.f;
            if (g < 5 && jj < 129) { const int idx = WINP + i - dil * jj; const float* kr = (idx >= WINP) ? nk + (size_t)(idx - WINP) * ATT_W : ck + (size_t)idx * ATT_W;
                const f32x4 k4 = *(const f32x4*)(kr + u * 4); d = (k4[0] * q4[0] + k4[1] * q4[1]) + (k4[2] * q4[2] + k4[3] * q4[3]); }
            d += __shfl_xor(d, 1); d += __shfl_xor(d, 2); d += __shfl_xor(d, 4); d += __shfl_xor(d, 8);
            if (g < 5 && jj < 129 && (u & 15) == 0) sc[(di * 132 + jj) * 6 + hh] = d;
        }
    }
    __syncthreads();
    LAS float* stm = st + 32 + 5 * 384;
    for (int pr = wave; pr < 18; pr += 8) {
        const int di = pr / 6, h2 = pr % 6;
        float v0 = sc[(di * 132 + lane) * 6 + h2], v1 = sc[(di * 132 + 64 + lane) * 6 + h2], v2 = (lane == 0) ? sc[(di * 132 + 128) * 6 + h2] : -INFINITY;
        const float mx = wave_max(fmaxf(fmaxf(v0, v1), v2));
        v0 = __expf(v0 - mx); v1 = __expf(v1 - mx); v2 = (lane == 0) ? __expf(v2 - mx) : 0.f;
        const float sm = wave_sum(v0 + v1 + v2);
        sc[(di * 132 + lane) * 6 + h2] = v0; sc[(di * 132 + 64 + lane) * 6 + h2] = v1; if (lane == 0) { sc[(di * 132 + 128) * 6 + h2] = v2; stm[pr] = mx; stm[18 + pr] = sm; }
    }
    __syncthreads();
    if (tid < 6) {
        const float l0 = stm[tid] + __logf(stm[18 + tid]), l1 = stm[6 + tid] + __logf(stm[24 + tid]), l2 = stm[12 + tid] + __logf(stm[30 + tid]);
        const float mx = fmaxf(l0, fmaxf(l1, l2)); const float e0 = __expf(l0 - mx), e1 = __expf(l1 - mx), e2 = __expf(l2 - mx); const float inv = 1.f / (e0 + e1 + e2);
        st[tid] = e0 * inv / stm[18 + tid]; st[6 + tid] = e1 * inv / stm[24 + tid]; st[12 + tid] = e2 * inv / stm[30 + tid];
    }
    __syncthreads();
    if (g < 5) {
        f32x4 a = (f32x4){0.f, 0.f, 0.f, 0.f};
        for (int di = 0; di < 3; ++di) {
            const int dil = (di == 0) ? 1 : (di == 1 ? 4 : 16); const float cf = st[di * 6 + hh];
            for (int jj = g; jj < 129; jj += 5) { const int idx = WINP + i - dil * jj; const float* vr = (idx >= WINP) ? nv + (size_t)(idx - WINP) * ATT_W : cv + (size_t)idx * ATT_W;
                const f32x4 v4 = *(const f32x4*)(vr + u * 4); const float pw = sc[(di * 132 + jj) * 6 + hh] * cf; a += v4 * pw; }
        }
        *(LAS f32x4*)(red + g * 384 + u * 4) = a;
    }
    __syncthreads();
    if (tid < 96) {
        f32x4 a = *(LAS f32x4*)(red + tid * 4);
#pragma unroll
        for (int k = 1; k < 5; ++k) a += *(LAS f32x4*)(red + k * 384 + tid * 4);
        const u32x2 gw = *(const u32x2*)(P.Gb + srow * DM + tid * 4);
        u32x2 w; w[0] = cvtpk(a[0] * bflo(gw[0]), a[1] * bfhi(gw[0])); w[1] = cvtpk(a[2] * bflo(gw[1]), a[3] * bfhi(gw[1]));
        *(u32x2*)(P.OG + srow * DM + tid * 4) = w;
    }
    __syncthreads();
}

constexpr int N_SMEM_ITEMS = DB * 4;
__device__ __forceinline__ void smem_item(const Ptrs& P, LAS unsigned char* lds, int item, int tid) {
    const int db = item >> 2, hm = item & 3, lane = tid & 63, wave = tid >> 6;
    LAS float* qs = (LAS float*)lds;
    LAS float* sc = qs + 512;
    LAS float* li = sc + 2048;
    { const int qi = tid >> 6, d = tid & 63; qs[tid] = bf2f(P.QMb[((size_t)MP + db * 8 + qi) * MEM_W + hm * 64 + d]); }
    __syncthreads();
    {
        const int m = tid & 255, qh = tid >> 8;
        const float* kr = P.in[6] + (((size_t)db * NMEM + m) * 4 + hm) * 64;
        float d0 = 0.f, d1 = 0.f, d2 = 0.f, d3 = 0.f;
#pragma unroll 4
        for (int c = 0; c < 16; ++c) {
            const f32x4 k4 = *(const f32x4*)(kr + c * 4);
            const f32x4 a0 = *(LAS f32x4*)(qs + (qh * 4 + 0) * 64 + c * 4), a1 = *(LAS f32x4*)(qs + (qh * 4 + 1) * 64 + c * 4), a2 = *(LAS f32x4*)(qs + (qh * 4 + 2) * 64 + c * 4), a3 = *(LAS f32x4*)(qs + (qh * 4 + 3) * 64 + c * 4);
            d0 += (k4[0] * a0[0] + k4[1] * a0[1]) + (k4[2] * a0[2] + k4[3] * a0[3]); d1 += (k4[0] * a1[0] + k4[1] * a1[1]) + (k4[2] * a1[2] + k4[3] * a1[3]);
            d2 += (k4[0] * a2[0] + k4[1] * a2[1]) + (k4[2] * a2[2] + k4[3] * a2[3]); d3 += (k4[0] * a3[0] + k4[1] * a3[1]) + (k4[2] * a3[2] + k4[3] * a3[3]);
        }
        sc[(qh * 4 + 0) * 256 + m] = d0; sc[(qh * 4 + 1) * 256 + m] = d1; sc[(qh * 4 + 2) * 256 + m] = d2; sc[(qh * 4 + 3) * 256 + m] = d3;
    }
    __syncthreads();
    {
        float v[4]; float mx = -INFINITY;
#pragma unroll
        for (int k = 0; k < 4; ++k) { v[k] = sc[wave * 256 + k * 64 + lane]; mx = fmaxf(mx, v[k]); }
        mx = wave_max(mx); float sm = 0.f;
#pragma unroll
        for (int k = 0; k < 4; ++k) { v[k] = __expf(v[k] - mx); sm += v[k]; sc[wave * 256 + k * 64 + lane] = v[k]; }
        sm = wave_sum(sm); if (lane == 0) li[wave] = 1.f / sm;
    }
    __syncthreads();
    {
        const int qi = tid >> 6, d = tid & 63;
        const float* vr = P.in[7] + (((size_t)db * NMEM) * 4 + hm) * 64 + d;
        float a = 0.f;
#pragma unroll 8
        for (int m = 0; m < 256; ++m) a += sc[qi * 256 + m] * vr[(size_t)m * 256];
        const size_t oo = ((size_t)MP + db * 8 + qi) * DM + 768 + hm * 64 + d;
        P.OG[oo] = f2bf(a * li[qi] * bf2f(P.Gb[oo]));
    }
    __syncthreads();
}

constexpr int N_SCAN_P = NB * 6, N_SCAN_S = DB * 6;
constexpr int CH = 32;
__device__ __forceinline__ float softplusf(float x) { return fmaxf(x, 0.f) + log1pf(__expf(-fabsf(x))); }
__device__ __forceinline__ void scan_item(const Ptrs& P, LAS unsigned char* lds, bool sample, int bb, int h, int tid) {
    const int lane = tid & 63, wave = tid >> 6;
    const int T = sample ? DT : SEQ;
    const size_t row0 = sample ? (size_t)MP + bb * DT : (size_t)bb * SEQ;
    LAS float* W2h = (LAS float*)lds;
    LAS float* A2h = W2h + 4096;
    LAS float* Rr = A2h + 4096;
    LAS float* Kk = Rr + CH * 64;
    LAS float* Vv = Kk + CH * 64;
    LAS float* Wd = Vv + CH * 64;
    LAS float* KK = Wd + CH * 64;
    LAS float* Bb = KK + CH * 64;
    LAS float* TW = Bb + CH * 64;
    LAS float* AL = TW + CH * 64;
    LAS float* Yb = AL + CH * 64;
    const float* mu = P.in[11]; const float* w0 = P.in[12]; const float* w2 = P.in[13]; const float* a0 = P.in[14]; const float* a2 = P.in[15];
    const float* k_k = P.in[16]; const float* k_a = P.in[17]; const float* r_k = P.in[18]; const float* lnx_g = P.in[19]; const float* lnx_b = P.in[20];
    for (int e = tid; e < 4096; e += NTHR) { const int jr = e >> 6, c = e & 63; W2h[e] = w2[(size_t)jr * RW + h * 64 + c]; A2h[e] = a2[(size_t)jr * RW + h * 64 + c]; }
    const int v = tid >> 3, kq = tid & 7;
    float s[8];
    if (sample) {
        const float* sp = P.in[4] + (((size_t)bb * 6 + h) * 64 + v) * 64 + kq * 8;
#pragma unroll
        for (int e = 0; e < 8; ++e) s[e] = sp[e];
    } else {
#pragma unroll
        for (int e = 0; e < 8; ++e) s[e] = 0.f;
    }
    const float* shift0 = P.in[5] + (size_t)bb * SHIFT_W;
    __syncthreads();
    for (int c0 = 0; c0 < T; c0 += CH) {
        const int n = (T - c0) < CH ? (T - c0) : CH;
        {
            float zv[20], zpv[20];
#pragma unroll
            for (int ti = 0; ti < 4; ++ti)
#pragma unroll
                for (int grp = 0; grp < 5; ++grp) {
                    const int t = wave + 8 * ti, col = (grp < 3) ? grp * RW + h * 64 + lane : 3 * RW + (grp - 3) * 64 + lane;
                    const size_t row = row0 + c0 + t;
                    float z = 0.f, zp = 0.f;
                    if (t < n) { z = P.ZB[row * SHIFT_W + col]; zp = (c0 + t == 0) ? (sample ? shift0[col] : 0.f) : P.ZB[(row - 1) * SHIFT_W + col]; }
                    zv[ti * 5 + grp] = z; zpv[ti * 5 + grp] = zp;
                }
#pragma unroll
            for (int ti = 0; ti < 4; ++ti)
#pragma unroll
                for (int grp = 0; grp < 5; ++grp) {
                    const int t = wave + 8 * ti, col = (grp < 3) ? grp * RW + h * 64 + lane : 3 * RW + (grp - 3) * 64 + lane;
                    const float zs = zv[ti * 5 + grp] + (zpv[ti * 5 + grp] - zv[ti * 5 + grp]) * mu[col];
                    if (t < n) {
                        if (grp == 0) Rr[t * 64 + lane] = zs; else if (grp == 1) Kk[t * 64 + lane] = zs; else if (grp == 2) Vv[t * 64 + lane] = zs;
                        else if (grp == 3) TW[t * 64 + lane] = tanhf(zs); else AL[t * 64 + lane] = zs;
                    }
                }
        }
        __syncthreads();
        for (int idx = tid; idx < n * 64; idx += NTHR) {
            const int t = idx >> 6, c = idx & 63, ch = h * 64 + c;
            float wv = w0[ch], av = a0[ch];
#pragma unroll 8
            for (int jr = 0; jr < 64; ++jr) { wv += TW[t * 64 + jr] * W2h[jr * 64 + c]; av += AL[t * 64 + jr] * A2h[jr * 64 + c]; }
            const float w = -softplusf(-wv) - 0.5f;
            const float decay = __expf(-__expf(w));
            const float a = 1.f / (1.f + __expf(-av));
            const float kraw = Kk[t * 64 + c];
            Wd[t * 64 + c] = decay;
            KK[t * 64 + c] = kraw * k_k[ch];
            Kk[t * 64 + c] = kraw * (1.f + (a - 1.f) * k_a[ch]);
            Bb[t * 64 + c] = a;
        }
        __syncthreads();
        for (int t = wave; t < n; t += 8) {
            const float x = KK[t * 64 + lane];
            const float nrm = fmaxf(sqrtf(wave_sum(x * x)), 1e-12f);
            const float kkn = x / nrm;
            KK[t * 64 + lane] = kkn; Bb[t * 64 + lane] = kkn * Bb[t * 64 + lane];
        }
        __syncthreads();
        for (int t = 0; t < n; ++t) {
            const f32x4 kk0 = *(LAS f32x4*)(KK + t * 64 + kq * 8), kk1 = *(LAS f32x4*)(KK + t * 64 + kq * 8 + 4);
            const f32x4 w0v = *(LAS f32x4*)(Wd + t * 64 + kq * 8), w1v = *(LAS f32x4*)(Wd + t * 64 + kq * 8 + 4);
            const f32x4 b0 = *(LAS f32x4*)(Bb + t * 64 + kq * 8), b1 = *(LAS f32x4*)(Bb + t * 64 + kq * 8 + 4);
            const f32x4 k0 = *(LAS f32x4*)(Kk + t * 64 + kq * 8), k1 = *(LAS f32x4*)(Kk + t * 64 + kq * 8 + 4);
            const f32x4 r0 = *(LAS f32x4*)(Rr + t * 64 + kq * 8), r1 = *(LAS f32x4*)(Rr + t * 64 + kq * 8 + 4);
            const float vv = Vv[t * 64 + v];
            float sa = 0.f;
#pragma unroll
            for (int e = 0; e < 4; ++e) { sa += s[e] * kk0[e]; sa += s[4 + e] * kk1[e]; }
            sa = -sum8(sa);
            float y = 0.f;
#pragma unroll
            for (int e = 0; e < 4; ++e) {
                s[e] = s[e] * w0v[e] + sa * b0[e] + vv * k0[e];
                s[4 + e] = s[4 + e] * w1v[e] + sa * b1[e] + vv * k1[e];
                y += s[e] * r0[e]; y += s[4 + e] * r1[e];
            }
            y = sum8(y);
            if (kq == 0) Yb[t * 64 + v] = y;
        }
        __syncthreads();
        for (int t = wave; t < n; t += 8) {
            const int ch = h * 64 + lane;
            const float y = Yb[t * 64 + lane];
            const float mean = wave_sum(y) * (1.f / 64.f);
            const float d = y - mean;
            const float var = wave_sum(d * d) * (1.f / 64.f);
            const float yn = d * rsqrtf(var + 64e-5f) * lnx_g[ch] + lnx_b[ch];
            const float bonus = wave_sum(Rr[t * 64 + lane] * Kk[t * 64 + lane] * r_k[ch]) * Vv[t * 64 + lane];
            const size_t oo = (row0 + c0 + t) * DM + 384 + ch;
            P.OG[oo] = f2bf((yn + bonus) * bf2f(P.Gb[oo]));
        }
        __syncthreads();
    }
    if (sample) {
        float* so = P.out + O_ST_S + (((size_t)bb * 6 + h) * 64 + v) * 64 + kq * 8;
#pragma unroll
        for (int e = 0; e < 8; ++e) so[e] = s[e];
    }
    __syncthreads();
}

constexpr int NCH = SEQ / 64, N_L_ITEMS = NB * 6 * NCH;
constexpr size_t WS_MF = WS_END;
constexpr size_t WS_NF = WS_MF + (size_t)N_L_ITEMS * 8192;
constexpr size_t WS_QF = WS_NF + (size_t)N_L_ITEMS * 16384;
constexpr size_t WS_YF = WS_QF + (size_t)N_L_ITEMS * 8192;
constexpr size_t WS_SF = WS_YF + (size_t)N_L_ITEMS * 16384;
constexpr size_t WS_RHO = WS_SF + (size_t)N_L_ITEMS * 8192;
constexpr size_t WS_END2 = al256(WS_RHO + (size_t)N_L_ITEMS * 256);
constexpr int TS = 144;
constexpr int FS = 272;
#define MFMA32(a, b, c) __builtin_amdgcn_mfma_f32_32x32x16_bf16((a), (b), (c), 0, 0, 0)
__device__ __forceinline__ bf16x8 rowfrag(LAS const unsigned char* tile, int row, int s, int h) { return *(LAS const bf16x8*)(tile + row * TS + (16 * s + 8 * h) * 2); }
__device__ __forceinline__ bf16x8 colfrag(LAS const unsigned char* tile, int f0, int s, int lane) {
    LAS const unsigned char* p = tile + (16 * s + 8 * (lane >> 5) + ((lane & 15) >> 2)) * TS + (f0 + 16 * ((lane >> 4) & 1) + 4 * (lane & 3)) * 2;
    const s16x4 lo = vtr(p), hh = vtr(p + 4 * TS);
    return (bf16x8){lo[0], lo[1], lo[2], lo[3], hh[0], hh[1], hh[2], hh[3]};
}
__device__ __forceinline__ f32x16 zero16() { f32x16 z; _Pragma("unroll") for (int r = 0; r < 16; ++r) z[r] = 0.f; return z; }

__device__ __forceinline__ void passL_item(const Params& prm, LAS unsigned char* lds, int item, int tid) {
    const int lane = tid & 63, wave = tid >> 6, hi = lane >> 5, l31 = lane & 31;
    const int seq = item >> 7, c = item & 127, b = seq / 6, h = seq % 6;
    const size_t row0 = (size_t)b * SEQ + 64 * c;
    const float* ZB = (const float*)(prm.ws + WS_ZB);
    LAS unsigned char* F_R = lds; LAS unsigned char* F_K = lds + 17408; LAS unsigned char* F_KK = lds + 34816; LAS unsigned char* F_B = lds + 52224; LAS unsigned char* F_LD = lds + 69632;
    LAS unsigned char* T_TW = lds + 87040; LAS unsigned char* T_AL = lds + 96256; LAS unsigned char* T_W2 = lds + 105472; LAS unsigned char* T_A2 = lds + 114688;
    LAS float* SEG = (LAS float*)(lds + 133120);
    LAS unsigned char* T_V = lds + 135168; LAS float* GCs = (LAS float*)(lds + 144384);
    LAS unsigned char* T_At = lds; LAS unsigned char* T_Bt = lds + 9216; LAS unsigned char* T_Kt = lds + 18432; LAS unsigned char* T_Rt = lds + 27648; LAS unsigned char* T_Bh = lds + 36864; LAS unsigned char* T_Kh = lds + 46080;
    LAS unsigned char* T_Aak = lds + 55296; LAS unsigned char* T_Arb = lds + 64512; LAS unsigned char* T_Ark = lds + 73728;
    LAS unsigned char* ATm = lds + 82944;
    LAS unsigned char* RHST = lds + 100352;
    LAS unsigned char* XsT = lds + 9216;
    {
        const float* mu = prm.in[11];
#pragma unroll
        for (int half = 0; half < 2; ++half) {
            float zv[20], zpv[20];
#pragma unroll
            for (int ti = 0; ti < 4; ++ti)
#pragma unroll
                for (int grp = 0; grp < 5; ++grp) {
                    const int t = wave + 8 * (half * 4 + ti), col = (grp < 3) ? grp * RW + h * 64 + lane : 3 * RW + (grp - 3) * 64 + lane;
                    const size_t row = row0 + t;
                    zv[ti * 5 + grp] = ZB[row * SHIFT_W + col];
                    zpv[ti * 5 + grp] = (c == 0 && t == 0) ? 0.f : ZB[(row - 1) * SHIFT_W + col];
                }
#pragma unroll
            for (int ti = 0; ti < 4; ++ti)
#pragma unroll
                for (int grp = 0; grp < 5; ++grp) {
                    const int t = wave + 8 * (half * 4 + ti), col = (grp < 3) ? grp * RW + h * 64 + lane : 3 * RW + (grp - 3) * 64 + lane;
                    const float zs = zv[ti * 5 + grp] + (zpv[ti * 5 + grp] - zv[ti * 5 + grp]) * mu[col];
                    if (grp == 0) *(LAS float*)(F_R + t * FS + lane * 4) = zs;
                    else if (grp == 1) *(LAS float*)(F_K + t * FS + lane * 4) = zs;
                    else if (grp == 2) *(LAS bf16_t*)(T_V + t * TS + lane * 2) = f2bf(zs);
                    else if (grp == 3) *(LAS bf16_t*)(T_TW + t * TS + lane * 2) = f2bf(tanhf(zs));
                    else *(LAS bf16_t*)(T_AL + t * TS + lane * 2) = f2bf(zs);
                }
        }
        const float* w2 = prm.in[13]; const float* a2 = prm.in[15];
#pragma unroll
        for (int i = 0; i < 8; ++i) { const int e = tid + NTHR * i, jr = e >> 6, cc = e & 63;
            *(LAS bf16_t*)(T_W2 + cc * TS + jr * 2) = f2bf(w2[(size_t)jr * RW + h * 64 + cc]); *(LAS bf16_t*)(T_A2 + cc * TS + jr * 2) = f2bf(a2[(size_t)jr * RW + h * 64 + cc]); }
    }
    __syncthreads();
    if (wave < 4) {
        const int t = 16 * wave + (lane & 15), g = lane >> 4;
        f32x4 accW[4], accA[4];
#pragma unroll
        for (int ct = 0; ct < 4; ++ct) { accW[ct] = (f32x4){0.f, 0.f, 0.f, 0.f}; accA[ct] = accW[ct]; }
#pragma unroll
        for (int ks = 0; ks < 2; ++ks) {
            const bf16x8 bw = *(LAS const bf16x8*)(T_TW + t * TS + (32 * ks + 8 * g) * 2), ba = *(LAS const bf16x8*)(T_AL + t * TS + (32 * ks + 8 * g) * 2);
#pragma unroll
            for (int ct = 0; ct < 4; ++ct) {
                const bf16x8 aw = *(LAS const bf16x8*)(T_W2 + (16 * ct + (lane & 15)) * TS + (32 * ks + 8 * g) * 2), aa = *(LAS const bf16x8*)(T_A2 + (16 * ct + (lane & 15)) * TS + (32 * ks + 8 * g) * 2);
                accW[ct] = __builtin_amdgcn_mfma_f32_16x16x32_bf16(aw, bw, accW[ct], 0, 0, 0);
                accA[ct] = __builtin_amdgcn_mfma_f32_16x16x32_bf16(aa, ba, accA[ct], 0, 0, 0);
            }
        }
        const float* w0 = prm.in[12]; const float* a0 = prm.in[14]; const float* k_k = prm.in[16]; const float* k_a = prm.in[17]; const float* r_k = prm.in[18];
        float ssq = 0.f, rho = 0.f; f32x4 kkv[4], av[4];
#pragma unroll
        for (int ct = 0; ct < 4; ++ct) {
            const int c4 = 16 * ct + 4 * g, ch = h * 64 + c4;
            const f32x4 kraw = *(LAS const f32x4*)(F_K + t * FS + c4 * 4), rr = *(LAS const f32x4*)(F_R + t * FS + c4 * 4);
            const f32x4 w0v = *(const f32x4*)(w0 + ch), a0v = *(const f32x4*)(a0 + ch), kkc = *(const f32x4*)(k_k + ch), kac = *(const f32x4*)(k_a + ch), rkc = *(const f32x4*)(r_k + ch);
            f32x4 ld, kp;
#pragma unroll
            for (int e = 0; e < 4; ++e) {
                const float wv = w0v[e] + accW[ct][e];
                const float w = -softplusf(-wv) - 0.5f;
                ld[e] = -__expf(w);
                const float a = 1.f / (1.f + __expf(-(a0v[e] + accA[ct][e])));
                av[ct][e] = a;
                kkv[ct][e] = kraw[e] * kkc[e];
                kp[e] = kraw[e] * (1.f + (a - 1.f) * kac[e]);
                ssq += kkv[ct][e] * kkv[ct][e];
                rho += rr[e] * kp[e] * rkc[e];
            }
            *(LAS f32x4*)(F_LD + t * FS + c4 * 4) = ld; *(LAS f32x4*)(F_K + t * FS + c4 * 4) = kp;
        }
        ssq += __shfl_xor(ssq, 16); ssq += __shfl_xor(ssq, 32); rho += __shfl_xor(rho, 16); rho += __shfl_xor(rho, 32);
        const float inv = 1.f / fmaxf(sqrtf(ssq), 1e-12f);
#pragma unroll
        for (int ct = 0; ct < 4; ++ct) {
            const int c4 = 16 * ct + 4 * g; f32x4 kk, bb;
#pragma unroll
            for (int e = 0; e < 4; ++e) { kk[e] = kkv[ct][e] * inv; bb[e] = kk[e] * av[ct][e]; }
            *(LAS f32x4*)(F_KK + t * FS + c4 * 4) = kk; *(LAS f32x4*)(F_B + t * FS + c4 * 4) = bb;
        }
        if (g == 0) ((float*)(prm.ws + WS_RHO))[(size_t)item * 64 + t] = rho;
    }
    __syncthreads();
    {
        const int cch = tid & 63, seg = tid >> 6;
        float L[8], kk[8], bb[8], kp[8], rr[8];
        float run = 0.f;
#pragma unroll
        for (int i = 0; i < 8; ++i) { const int t = 8 * seg + i; run += *(LAS const float*)(F_LD + t * FS + cch * 4); L[i] = run;
            kk[i] = *(LAS const float*)(F_KK + t * FS + cch * 4); bb[i] = *(LAS const float*)(F_B + t * FS + cch * 4); kp[i] = *(LAS const float*)(F_K + t * FS + cch * 4); rr[i] = *(LAS const float*)(F_R + t * FS + cch * 4); }
        SEG[seg * 64 + cch] = run;
        __syncthreads();
        float off = 0.f, tot = 0.f;
#pragma unroll
        for (int sgi = 0; sgi < 8; ++sgi) { const float v = SEG[sgi * 64 + cch]; tot += v; if (sgi < seg) off += v; }
        __syncthreads();
        f32x4 at0, at1;
#pragma unroll
        for (int i = 0; i < 8; ++i) {
            const int t = 8 * seg + i;
            const float Lc = off + L[i], Lp = (i == 0) ? off : off + L[i - 1];
            const float ep = __expf(Lp), em = __expf(-Lc), el = __expf(Lc), eh = __expf(tot - Lc);
            const float at = -kk[i] * ep;
            if (i < 4) at0[i] = at; else at1[i - 4] = at;
            *(LAS bf16_t*)(T_At + t * TS + cch * 2) = f2bf(at);
            *(LAS bf16_t*)(T_Bt + t * TS + cch * 2) = f2bf(bb[i] * em);
            *(LAS bf16_t*)(T_Kt + t * TS + cch * 2) = f2bf(kp[i] * em);
            *(LAS bf16_t*)(T_Rt + t * TS + cch * 2) = f2bf(rr[i] * el);
            *(LAS bf16_t*)(T_Bh + t * TS + cch * 2) = f2bf(bb[i] * eh);
            *(LAS bf16_t*)(T_Kh + t * TS + cch * 2) = f2bf(kp[i] * eh);
        }
#pragma unroll
        for (int i = 0; i < 8; ++i) *(LAS float*)(RHST + cch * FS + ((i & 3) * 16 + 2 * seg + (i >> 2)) * 4) = (i < 4) ? at0[i & 3] : at1[i & 3];
        if (seg == 0) GCs[cch] = __expf(tot);
    }
    __syncthreads();
#pragma unroll
    for (int rep = 0; rep < 2; ++rep) {
        const int slot = wave + 8 * rep, prod = slot >> 2, tile = slot & 3;
        if (prod == 0) {
            const int tt = tile >> 1, it = tile & 1;
            if (!(tt == 0 && it == 1)) {
                f32x16 d = zero16();
#pragma unroll
                for (int s4 = 0; s4 < 4; ++s4) d = MFMA32(rowfrag(T_At, 32 * tt + l31, s4, hi), rowfrag(T_Bt, 32 * it + l31, s4, hi), d);
#pragma unroll
                for (int rg = 0; rg < 4; ++rg)
#pragma unroll
                    for (int e = 0; e < 4; ++e) *(LAS float*)(ATm + (32 * it + l31) * FS + (e * 16 + 8 * tt + 2 * rg + hi) * 4) = d[4 * rg + e];
            }
        } else {
            const int it = tile >> 1, tt = tile & 1;
            LAS const unsigned char* TA = (prod == 2) ? T_Bt : T_Kt; LAS const unsigned char* TB = (prod == 1) ? T_At : T_Rt;
            LAS unsigned char* TO = (prod == 1) ? T_Aak : (prod == 2) ? T_Arb : T_Ark;
            f32x16 d = zero16();
            if (!(it == 1 && tt == 0)) {
#pragma unroll
                for (int s4 = 0; s4 < 4; ++s4) d = MFMA32(rowfrag(TA, 32 * it + l31, s4, hi), rowfrag(TB, 32 * tt + l31, s4, hi), d);
            }
            const int tg = 32 * tt + l31;
#pragma unroll
            for (int rg = 0; rg < 4; ++rg) {
                float v4[4];
#pragma unroll
                for (int e = 0; e < 4; ++e) { const int ig = 32 * it + 8 * rg + 4 * hi + e; const bool keep = (prod == 1) ? (ig < tg) : (ig <= tg); v4[e] = keep ? d[4 * rg + e] : 0.f; }
                *(LAS u32x2*)(TO + tg * TS + (32 * it + 8 * rg + 4 * hi) * 2) = (u32x2){cvtpk(v4[0], v4[1]), cvtpk(v4[2], v4[3])};
            }
        }
    }
    __syncthreads();
    if (wave < 4) {
        const int tt = wave >> 1, vt = wave & 1;
        f32x16 d = zero16();
#pragma unroll
        for (int s4 = 0; s4 < 4; ++s4) d = MFMA32(rowfrag(T_Aak, 32 * tt + l31, s4, hi), colfrag(T_V, 32 * vt, s4, lane), d);
#pragma unroll
        for (int rg = 0; rg < 4; ++rg)
#pragma unroll
            for (int e = 0; e < 4; ++e) *(LAS float*)(RHST + (64 + 32 * vt + l31) * FS + (e * 16 + 8 * tt + 2 * rg + hi) * 4) = d[4 * rg + e];
    }
    __syncthreads();
    {
        const int col = tid >> 2, j = tid & 3;
        float acc[16];
#pragma unroll
        for (int q = 0; q < 4; ++q) { const f32x4 v = *(LAS const f32x4*)(RHST + col * FS + (j * 16 + 4 * q) * 4); acc[4 * q] = v[0]; acc[4 * q + 1] = v[1]; acc[4 * q + 2] = v[2]; acc[4 * q + 3] = v[3]; }
        LAS const unsigned char* atp = ATm + j * 64;
#pragma clang loop unroll(full)
        for (int i = 0; i < 63; ++i) {
            const int jo = i & 3, mo = i >> 2;
            const float x = (jo == 0) ? dpp_f<0x00>(acc[mo]) : (jo == 1) ? dpp_f<0x55>(acc[mo]) : (jo == 2) ? dpp_f<0xAA>(acc[mo]) : dpp_f<0xFF>(acc[mo]);
#pragma unroll
            for (int q = mo / 4; q < 4; ++q) {
                const f32x4 a4 = *(LAS const f32x4*)(atp + i * FS + q * 16);
#pragma unroll
                for (int e = 0; e < 4; ++e) { const int m = 4 * q + e;
                    if (m > mo) acc[m] += a4[e] * x;
                    else if (m == mo) acc[m] += ((j > jo) ? a4[e] : 0.f) * x; }
            }
        }
#pragma unroll
        for (int m = 0; m < 16; ++m) *(LAS bf16_t*)(XsT + col * TS + (4 * m + j) * 2) = f2bf(acc[m]);
    }
    __syncthreads();
    {
        const int tile = wave & 3, ta = tile >> 1, tb = tile & 1;
        if (wave < 4) {
            f32x16 d = zero16();
#pragma unroll
            for (int s4 = 0; s4 < 4; ++s4) d = MFMA32(rowfrag(XsT, 32 * ta + l31, s4, hi), colfrag(T_Bh, 32 * tb, s4, lane), d);
            if (ta == tb) { const float gc = GCs[32 * tb + l31];
#pragma unroll
                for (int r = 0; r < 16; ++r) if (crow(r, hi) == l31) d[r] += gc; }
            u32x4* mf = (u32x4*)(prm.ws + WS_MF + (size_t)item * 8192) + ((ta * 2 + tb) * 2) * 64 + lane;
#pragma unroll
            for (int s2 = 0; s2 < 2; ++s2) mf[s2 * 64] = (u32x4){cvtpk(d[8 * s2], d[8 * s2 + 1]), cvtpk(d[8 * s2 + 2], d[8 * s2 + 3]), cvtpk(d[8 * s2 + 4], d[8 * s2 + 5]), cvtpk(d[8 * s2 + 6], d[8 * s2 + 7])};
            f32x16 n = zero16();
#pragma unroll
            for (int s4 = 0; s4 < 4; ++s4) n = MFMA32(colfrag(T_Bh, 32 * ta, s4, lane), rowfrag(XsT, 64 + 32 * tb + l31, s4, hi), n);
#pragma unroll
            for (int s4 = 0; s4 < 4; ++s4) n = MFMA32(colfrag(T_Kh, 32 * ta, s4, lane), colfrag(T_V, 32 * tb, s4, lane), n);
            f32x4* nf = (f32x4*)(prm.ws + WS_NF + (size_t)item * 16384) + ((tb * 2 + ta) * 64 + lane) * 4;
#pragma unroll
            for (int rg = 0; rg < 4; ++rg) nf[rg] = (f32x4){n[4 * rg], n[4 * rg + 1], n[4 * rg + 2], n[4 * rg + 3]};
        } else {
            f32x16 d;
#pragma unroll
            for (int rg = 0; rg < 4; ++rg) { const u32x2 w = *(LAS const u32x2*)(T_Rt + (32 * tb + l31) * TS + (32 * ta + 8 * rg + 4 * hi) * 2);
                d[4 * rg] = bflo(w[0]); d[4 * rg + 1] = bfhi(w[0]); d[4 * rg + 2] = bflo(w[1]); d[4 * rg + 3] = bfhi(w[1]); }
#pragma unroll
            for (int s4 = 0; s4 < 4; ++s4) d = MFMA32(rowfrag(XsT, 32 * ta + l31, s4, hi), rowfrag(T_Arb, 32 * tb + l31, s4, hi), d);
            u32x4* qf = (u32x4*)(prm.ws + WS_QF + (size_t)item * 8192) + ((ta * 2 + tb) * 2) * 64 + lane;
#pragma unroll
            for (int s2 = 0; s2 < 2; ++s2) qf[s2 * 64] = (u32x4){cvtpk(d[8 * s2], d[8 * s2 + 1]), cvtpk(d[8 * s2 + 2], d[8 * s2 + 3]), cvtpk(d[8 * s2 + 4], d[8 * s2 + 5]), cvtpk(d[8 * s2 + 6], d[8 * s2 + 7])};
            f32x16 y = zero16();
#pragma unroll
            for (int s4 = 0; s4 < 4; ++s4) y = MFMA32(rowfrag(XsT, 64 + 32 * ta + l31, s4, hi), rowfrag(T_Arb, 32 * tb + l31, s4, hi), y);
#pragma unroll
            for (int s4 = 0; s4 < 4; ++s4) y = MFMA32(colfrag(T_V, 32 * ta, s4, lane), rowfrag(T_Ark, 32 * tb + l31, s4, hi), y);
            f32x4* yf = (f32x4*)(prm.ws + WS_YF + (size_t)item * 16384) + ((ta * 2 + tb) * 64 + lane) * 4;
#pragma unroll
            for (int rg = 0; rg < 4; ++rg) yf[rg] = (f32x4){y[4 * rg], y[4 * rg + 1], y[4 * rg + 2], y[4 * rg + 3]};
        }
    }
    __syncthreads();
}

constexpr int N_S_BLOCKS = NB * 6 * 2;
__device__ __forceinline__ void passS_block(const Params& prm, LAS unsigned char* lds, int sblk, int tid) {
    const int lane = tid & 63, wave = tid >> 6;
    const int seq = sblk >> 1, vh = sblk & 1;
    const size_t item0 = (size_t)seq * NCH;
    const int ltid = tid - 64;
    const unsigned char* mbase = prm.ws + WS_MF + item0 * 8192;
    const unsigned char* nbase = prm.ws + WS_NF + item0 * 16384 + (size_t)vh * 8192;
    u32x4 hold[8][3];
#define PS_SRC(chunk, piece) (((piece) < 512) ? (const u32x4*)(mbase + (size_t)(chunk) * 8192) + (piece) : (const u32x4*)(nbase + (size_t)(chunk) * 16384) + ((piece) - 512))
#define PS_ISSUE(chunk, buf) do { if ((chunk) < NCH) { hold[buf][0] = *PS_SRC(chunk, ltid); hold[buf][1] = *PS_SRC(chunk, ltid + 448); if (ltid < 128) hold[buf][2] = *PS_SRC(chunk, ltid + 896); } } while (0)
#define PS_COMMIT(chunk, buf) do { if ((chunk) < NCH) { LAS unsigned char* slot_ = lds + ((chunk) & 7) * 16384; *(LAS u32x4*)(slot_ + ltid * 16) = hold[buf][0]; *(LAS u32x4*)(slot_ + (ltid + 448) * 16) = hold[buf][1]; \
        if (ltid < 128) *(LAS u32x4*)(slot_ + (ltid + 896) * 16) = hold[buf][2]; } } while (0)
    f32x16 acc[2]; acc[0] = zero16(); acc[1] = zero16();
    if (wave >= 1) {
        PS_ISSUE(0, 0); PS_ISSUE(1, 1); PS_COMMIT(0, 0); PS_COMMIT(1, 1);
        PS_ISSUE(2, 2); PS_ISSUE(3, 3); PS_ISSUE(4, 4); PS_ISSUE(5, 5); PS_ISSUE(6, 6); PS_ISSUE(7, 7); PS_ISSUE(8, 0); PS_ISSUE(9, 1);
    }
    __syncthreads();
    for (int c8 = 0; c8 < NCH; c8 += 8) {
#pragma unroll
        for (int par = 0; par < 8; ++par) {
            const int cc = c8 + par;
            if (wave == 0) {
                LAS const unsigned char* slot = lds + par * 16384;
                bf16x8 xb[2][2];
#pragma unroll
                for (int kt = 0; kt < 2; ++kt)
#pragma unroll
                    for (int s2 = 0; s2 < 2; ++s2) { const u32x4 w = (u32x4){cvtpk(acc[kt][8 * s2], acc[kt][8 * s2 + 1]), cvtpk(acc[kt][8 * s2 + 2], acc[kt][8 * s2 + 3]), cvtpk(acc[kt][8 * s2 + 4], acc[kt][8 * s2 + 5]), cvtpk(acc[kt][8 * s2 + 6], acc[kt][8 * s2 + 7])};
                        xb[kt][s2] = __builtin_bit_cast(bf16x8, w);
                        ((u32x4*)(prm.ws + WS_SF + (item0 + cc) * 8192))[((vh * 2 + kt) * 2 + s2) * 64 + lane] = w; }
                f32x16 nacc[2];
#pragma unroll
                for (int i = 0; i < 2; ++i) {
#pragma unroll
                    for (int rg = 0; rg < 4; ++rg) { const f32x4 v = *(LAS const f32x4*)(slot + 8192 + (i * 64 + lane) * 64 + rg * 16); nacc[i][4 * rg] = v[0]; nacc[i][4 * rg + 1] = v[1]; nacc[i][4 * rg + 2] = v[2]; nacc[i][4 * rg + 3] = v[3]; }
#pragma unroll
                    for (int kt = 0; kt < 2; ++kt)
#pragma unroll
                        for (int s2 = 0; s2 < 2; ++s2) { const bf16x8 mf = *(LAS const bf16x8*)(slot + (((kt * 2 + i) * 2 + s2) * 64 + lane) * 16); nacc[i] = MFMA32(mf, xb[kt][s2], nacc[i]); }
                }
                acc[0] = nacc[0]; acc[1] = nacc[1];
            } else {
                PS_COMMIT(cc + 2, (par + 2) & 7); PS_ISSUE(cc + 10, (par + 2) & 7);
            }
            __syncthreads();
        }
    }
#undef PS_SRC
#undef PS_ISSUE
#undef PS_COMMIT
    if (wave == 0) {
        float* so = prm.out + O_ST_P + ((size_t)seq * 64 + 32 * vh + (lane & 31)) * 64;
#pragma unroll
        for (int kt = 0; kt < 2; ++kt)
#pragma unroll
            for (int rg = 0; rg < 4; ++rg) *(f32x4*)(so + 32 * kt + 8 * rg + 4 * (lane >> 5)) = (f32x4){acc[kt][4 * rg], acc[kt][4 * rg + 1], acc[kt][4 * rg + 2], acc[kt][4 * rg + 3]};
    }
    __syncthreads();
}

__device__ __forceinline__ void passO_pair(const Params& prm, int item, int tt, int lane) {
    const int hi = lane >> 5, l31 = lane & 31;
    const int seq = item >> 7, c = item & 127, b = seq / 6, h = seq % 6;
    const u32x4* sf = (const u32x4*)(prm.ws + WS_SF + (size_t)item * 8192);
    const u32x4* qf = (const u32x4*)(prm.ws + WS_QF + (size_t)item * 8192);
    const f32x4* yf = (const f32x4*)(prm.ws + WS_YF + (size_t)item * 16384);
    bf16x8 qb[2][2];
#pragma unroll
    for (int kt = 0; kt < 2; ++kt)
#pragma unroll
        for (int s2 = 0; s2 < 2; ++s2) qb[kt][s2] = __builtin_bit_cast(bf16x8, qf[((kt * 2 + tt) * 2 + s2) * 64 + lane]);
    f32x16 y[2];
#pragma unroll
    for (int vt = 0; vt < 2; ++vt) {
#pragma unroll
        for (int rg = 0; rg < 4; ++rg) { const f32x4 v = yf[((vt * 2 + tt) * 64 + lane) * 4 + rg]; y[vt][4 * rg] = v[0]; y[vt][4 * rg + 1] = v[1]; y[vt][4 * rg + 2] = v[2]; y[vt][4 * rg + 3] = v[3]; }
#pragma unroll
        for (int kt = 0; kt < 2; ++kt)
#pragma unroll
            for (int s2 = 0; s2 < 2; ++s2) y[vt] = MFMA32(__builtin_bit_cast(bf16x8, sf[((vt * 2 + kt) * 2 + s2) * 64 + lane]), qb[kt][s2], y[vt]);
    }
    float sm = 0.f;
#pragma unroll
    for (int vt = 0; vt < 2; ++vt)
#pragma unroll
        for (int r = 0; r < 16; ++r) sm += y[vt][r];
    sm += __shfl_xor(sm, 32);
    const float mean = sm * (1.f / 64.f);
    float sq = 0.f;
#pragma unroll
    for (int vt = 0; vt < 2; ++vt)
#pragma unroll
        for (int r = 0; r < 16; ++r) { const float d = y[vt][r] - mean; sq += d * d; }
    sq += __shfl_xor(sq, 32);
    const float rstd = rsqrtf(sq * (1.f / 64.f) + 64e-5f);
    const int t = 64 * c + 32 * tt + l31;
    const size_t row = (size_t)b * SEQ + t;
    const float rho = ((const float*)(prm.ws + WS_RHO))[(size_t)item * 64 + 32 * tt + l31];
    const float* ZB = (const float*)(prm.ws + WS_ZB);
    const float* mu = prm.in[11]; const float* lg = prm.in[19]; const float* lb = prm.in[20];
    const bf16_t* Gb = (const bf16_t*)(prm.ws + WS_G); bf16_t* OG = (bf16_t*)(prm.ws + WS_OG);
#pragma unroll
    for (int vt = 0; vt < 2; ++vt)
#pragma unroll
        for (int rg = 0; rg < 4; ++rg) {
            const int v0 = 32 * vt + 8 * rg + 4 * hi, ch = h * 64 + v0;
            const f32x4 z = *(const f32x4*)(ZB + row * SHIFT_W + 2 * RW + ch);
            f32x4 zp = (f32x4){0.f, 0.f, 0.f, 0.f};
            if (t > 0) zp = *(const f32x4*)(ZB + (row - 1) * SHIFT_W + 2 * RW + ch);
            const f32x4 muv = *(const f32x4*)(mu + 2 * RW + ch), gv = *(const f32x4*)(lg + ch), bv = *(const f32x4*)(lb + ch);
            const u32x2 gw = *(const u32x2*)(Gb + row * DM + 384 + ch);
            const float gg[4] = {bflo(gw[0]), bfhi(gw[0]), bflo(gw[1]), bfhi(gw[1])};
            float o[4];
#pragma unroll
            for (int e = 0; e < 4; ++e) { const float vv = z[e] + (zp[e] - z[e]) * muv[e]; o[e] = ((y[vt][4 * rg + e] - mean) * rstd * gv[e] + bv[e] + rho * vv) * gg[e]; }
            *(u32x2*)(OG + row * DM + 384 + ch) = (u32x2){cvtpk(o[0], o[1]), cvtpk(o[2], o[3])};
        }
}

__device__ __forceinline__ void p0_transpose_item(const float* W, const float* gain, int K, int N, bf16_t* WT, int row_off, LAS float* scr, int item, int lane) {
    const int nblk = N / 32, kb = item / nblk, nb = item % nblk, k0 = 64 * kb, n0 = 32 * nb;
#pragma unroll 8
    for (int i = 0; i < 32; ++i) { const int kk = 2 * i + (lane >> 5); const float gk = gain ? gain[k0 + kk] : 1.f; scr[kk * 33 + (lane & 31)] = W[(size_t)(k0 + kk) * N + n0 + (lane & 31)] * gk; }
    LDS_WAIT(); asm volatile("" ::: "memory");
    const int c = lane & 7;
#pragma unroll
    for (int j = 0; j < 4; ++j) { const int n = (lane >> 3) + 8 * j; const LAS float* s = scr + (8 * c) * 33 + n;
        u32x4 o; o[0] = cvtpk(s[0 * 33], s[1 * 33]); o[1] = cvtpk(s[2 * 33], s[3 * 33]); o[2] = cvtpk(s[4 * 33], s[5 * 33]); o[3] = cvtpk(s[6 * 33], s[7 * 33]);
        *(u32x4*)(WT + (size_t)(row_off + n0 + n) * K + k0 + 8 * c) = o; }
    LDS_WAIT(); asm volatile("" ::: "memory");
}
__device__ __forceinline__ void sincos_acc(float angf, float& c, float& s) {
    const double a = (double)angf;
    const double kq = __builtin_rint(a * 0.63661977236758134308);
    const double r = (a - kq * 1.57079632679489655800) - kq * 6.12323399573676603587e-17;
    const double r2 = r * r;
    double sp = -1.0 / 1307674368000.0; sp = sp * r2 + 1.0 / 6227020800.0; sp = sp * r2 - 1.0 / 39916800.0; sp = sp * r2 + 1.0 / 362880.0; sp = sp * r2 - 1.0 / 5040.0; sp = sp * r2 + 1.0 / 120.0; sp = sp * r2 - 1.0 / 6.0; sp = sp * r2 + 1.0; sp *= r;
    double cp = 1.0 / 87178291200.0; cp = cp * r2 - 1.0 / 479001600.0; cp = cp * r2 + 1.0 / 3628800.0; cp = cp * r2 - 1.0 / 40320.0; cp = cp * r2 + 1.0 / 720.0; cp = cp * r2 - 1.0 / 24.0; cp = cp * r2 + 0.5; cp = 1.0 - cp * r2;
    const int qd = ((int)kq) & 3;
    const double sv = (qd == 0) ? sp : (qd == 1) ? cp : (qd == 2) ? -sp : -cp;
    const double cv = (qd == 0) ? cp : (qd == 1) ? -sp : (qd == 2) ? -cp : sp;
    c = (float)cv; s = (float)sv;
}
__device__ __forceinline__ void p0_prologue(const Ptrs& P, LAS unsigned char* lds, int bid, int G, int tid) {
    const int lane = tid & 63, wave = tid >> 6;
    LAS float* scr = (LAS float*)(lds + wave * 16384);
    const int gw = bid * 8 + wave, NGW = G * 8;
    constexpr int I_IN = (DM / 64) * (IN_W / 32), I_MEM = (DM / 64) * (512 / 32), I_OUT = (DM / 64) * (DM / 32);
    for (int it = gw; it < I_IN + I_MEM + I_OUT; it += NGW) {
        int r = it;
        if (r < I_IN) { p0_transpose_item(P.in[10], P.in[9], DM, IN_W, P.WT, 0, scr, r, lane); continue; } r -= I_IN;
        if (r < I_MEM) { p0_transpose_item(P.in[22], P.in[21], DM, 512, P.WT, NPAD, scr, r, lane); continue; } r -= I_MEM;
        p0_transpose_item(P.in[23], nullptr, DM, DM, P.WOT, 0, scr, r, lane);
    }
    const int gt = bid * NTHR + tid, NGT = G * NTHR;
    for (int e = gt; e < (NPAD - IN_W) * DM / 8; e += NGT) *(u32x4*)(P.WT + (size_t)IN_W * DM + (size_t)e * 8) = (u32x4){0u, 0u, 0u, 0u};
    for (int m = gw; m < MROWS; m += NGW) {
        const float* xr = (m < MP) ? P.in[0] + (size_t)m * DM : (m < MTOK) ? P.in[1] + (size_t)(m - MP) * DM : P.in[8] + (size_t)(m - MTOK) * DM;
        f32x4 v[4]; float ss = 0.f;
#pragma unroll
        for (int j = 0; j < 4; ++j) { v[j] = *(const f32x4*)(xr + (size_t)(64 * j + lane) * 4); ss += (v[j][0] * v[j][0] + v[j][1] * v[j][1]) + (v[j][2] * v[j][2] + v[j][3] * v[j][3]); }
        ss = wave_sum(ss);
        if (lane == 0) P.RINV[m] = rsqrtf(ss * (1.f / DM) + 1e-6f);
#pragma unroll
        for (int j = 0; j < 4; ++j) { u32x2 w; w[0] = cvtpk(v[j][0], v[j][1]); w[1] = cvtpk(v[j][2], v[j][3]); *(u32x2*)(P.XB + (size_t)m * DM + (size_t)(64 * j + lane) * 4) = w; }
    }
    for (int e = gt; e < NPOS * 8; e += NGT) {
        const int pos = e >> 3, i = e & 7;
        const float invf[8] = {1.0f, 0.19392274f, 0.03760603f, 0.0072926646f, 0.0014142136f, 0.0002742482f, 5.3182957e-05f, 1.0313385e-05f};
        float fi = invf[0];
#pragma unroll
        for (int k = 1; k < 8; ++k) fi = (i == k) ? invf[k] : fi;
        const float ang = (float)pos * fi; float c, s; sincos_acc(ang, c, s);
        P.ROPE[pos * 16 + i] = c; P.ROPE[pos * 16 + 8 + i] = s;
    }
    for (int e = gt; e < MTOK; e += NGT) P.SS[e] = 0.f;
}

__device__ __forceinline__ void p3_combine(const Ptrs& P, int bid, int G, int tid) {
    const int gt = bid * NTHR + tid, NGT = G * NTHR;
    for (int e = gt; e < MP * 48; e += NGT) {
        const int row = e / 48, ch = e % 48, h = ch >> 3;
        const float l0 = P.LSE[((size_t)0 * MP + row) * 6 + h], l1 = P.LSE[((size_t)1 * MP + row) * 6 + h], l2 = P.LSE[((size_t)2 * MP + row) * 6 + h];
        const float mx = fmaxf(l0, fmaxf(l1, l2)); const float e0 = __expf(l0 - mx), e1 = __expf(l1 - mx), e2 = __expf(l2 - mx); const float inv = 1.f / (e0 + e1 + e2);
        const float w0 = e0 * inv, w1 = e1 * inv, w2 = e2 * inv;
        const u32x4 a = *(const u32x4*)(P.OAP + ((size_t)0 * MP + row) * ATT_W + ch * 8), b = *(const u32x4*)(P.OAP + ((size_t)1 * MP + row) * ATT_W + ch * 8), c = *(const u32x4*)(P.OAP + ((size_t)2 * MP + row) * ATT_W + ch * 8);
        const u32x4 gg = *(const u32x4*)(P.Gb + (size_t)row * DM + ch * 8);
        u32x4 o;
#pragma unroll
        for (int k = 0; k < 4; ++k) {
            const float lo = (w0 * bflo(a[k]) + w1 * bflo(b[k]) + w2 * bflo(c[k])) * bflo(gg[k]);
            const float hi = (w0 * bfhi(a[k]) + w1 * bfhi(b[k]) + w2 * bfhi(c[k])) * bfhi(gg[k]);
            o[k] = cvtpk(lo, hi);
        }
        *(u32x4*)(P.OG + (size_t)row * DM + ch * 8) = o;
    }
}

__device__ __forceinline__ void p5_norm(const Ptrs& P, int bid, int G, int tid) {
    const int lane = tid & 63, wave = tid >> 6, gw = bid * 8 + wave, NGW = G * 8;
    const float* gf = P.in[24];
    for (int m = gw; m < MTOK; m += NGW) {
        const float rs = rsqrtf(P.SS[m] * (1.f / DM) + 1e-6f);
        float* yr = P.out + O_Y + (size_t)m * DM;
#pragma unroll
        for (int j = 0; j < 4; ++j) { const size_t c = (size_t)(64 * j + lane) * 4; const f32x4 v = *(const f32x4*)(yr + c); const f32x4 gv = *(const f32x4*)(gf + c); *(f32x4*)(yr + c) = v * rs * gv; }
    }
}

#define XB_TMO      128
#define XB_XCNT(j)  (256  + 64 * (j))
#define XB_XSUB(j)  (1280 + 64 * (j))
#define XB_XGEN(j)  (2304 + 64 * (j))
#define XB_TOP      3328
#define XB_TOPGEN   3392
#define XCD_BAR_WORDS 3456
#define XB_SPIN_CAP (1u << 18)
__device__ __forceinline__ unsigned xb_ld(unsigned* p)              { return __hip_atomic_load(p, __ATOMIC_RELAXED, __HIP_MEMORY_SCOPE_AGENT); }
__device__ __forceinline__ unsigned xb_add(unsigned* p, unsigned v) { return __hip_atomic_fetch_add(p, v, __ATOMIC_RELAXED, __HIP_MEMORY_SCOPE_AGENT); }
__device__ __forceinline__ unsigned xb_xcc_id() { return (unsigned)__builtin_amdgcn_s_getreg((3 << 11) | 20) & 0xFu; }
#define XB_SPIN(cond, bar) do { unsigned _sp = 0; while (cond) { __builtin_amdgcn_s_sleep(1); \
    if ((++_sp & 255u) == 0u) { if (xb_ld(&(bar)[XB_TMO])) break; if (_sp > XB_SPIN_CAP) { atomicAdd(&(bar)[XB_TMO], 1u); break; } } } } while (0)
struct XcdBarrier { unsigned* bar; unsigned x; volatile LAS unsigned* st; };
__device__ __forceinline__ XcdBarrier xcd_barrier_post(unsigned* bar, volatile LAS unsigned* st) {
    XcdBarrier b; b.bar = bar; b.x = xb_xcc_id(); b.st = st;
    if (threadIdx.x == 0) (void)xb_add(&bar[XB_XCNT(b.x)], 1u);
    return b;
}
__device__ __forceinline__ void xcd_barrier_complete(unsigned* bar, unsigned x, unsigned& nloc, unsigned& nx) {
    const unsigned G = gridDim.x * gridDim.y * gridDim.z;
    unsigned sum, cnt, mine, sp = 0u;
    for (;;) {
        sum = 0u; cnt = 0u; mine = 0u;
#pragma unroll
        for (unsigned j = 0; j < 16; ++j) { const unsigned c = xb_ld(&bar[XB_XCNT(j)]); sum += c; cnt += (c > 0u) ? 1u : 0u; mine = (j == x) ? c : mine; }
        if (sum == G) break;
        __builtin_amdgcn_s_sleep(1);
        if ((++sp & 255u) == 0u) { if (xb_ld(&bar[XB_TMO])) break; if (sp > XB_SPIN_CAP) { atomicAdd(&bar[XB_TMO], 1u); break; } }
    }
    nloc = mine > 0u ? mine : 1u; nx = cnt > 0u ? cnt : 1u;
}
__device__ __forceinline__ void xcd_barrier(const XcdBarrier& b) {
    asm volatile("s_waitcnt vmcnt(0)" ::: "memory");
    __syncthreads();
    if (threadIdx.x == 0) {
        unsigned* bar = b.bar;
        __builtin_amdgcn_s_waitcnt(0);
        unsigned nloc = b.st[0], nx = b.st[1];
        if (nloc == 0u) { xcd_barrier_complete(bar, b.x, nloc, nx); b.st[0] = nloc; b.st[1] = nx; }
        const unsigned old = xb_add(&bar[XB_XSUB(b.x)], 1u);
        const unsigned gen = old / nloc;
        if (old + 1u == (gen + 1u) * nloc) {
            __builtin_amdgcn_fence(__ATOMIC_RELEASE, "agent");
            asm volatile("s_waitcnt vmcnt(0)" ::: "memory");
            const unsigned og = xb_add(&bar[XB_TOP], 1u);
            const unsigned tg = og / nx;
            if (og + 1u == (tg + 1u) * nx) xb_add(&bar[XB_TOPGEN], 1u);
            else XB_SPIN(xb_ld(&bar[XB_TOPGEN]) == tg, bar);
            __builtin_amdgcn_fence(__ATOMIC_ACQUIRE, "agent");
            xb_add(&bar[XB_XGEN(b.x)], 1u);
            asm volatile("s_waitcnt vmcnt(0)" ::: "memory");
        } else {
            XB_SPIN(xb_ld(&bar[XB_XGEN(b.x)]) == gen, bar);
            __builtin_amdgcn_fence(__ATOMIC_ACQUIRE, "agent");
            asm volatile("s_waitcnt vmcnt(0)" ::: "memory");
        }
    }
    __syncthreads();
}

__global__ void __launch_bounds__(NTHR, 2) fwd_kernel(Params prm) {
    extern __shared__ __attribute__((aligned(16))) unsigned char lds_raw[];
    LAS unsigned char* lds = (LAS unsigned char*)lds_raw;
    const int tid = threadIdx.x, bid = blockIdx.x, G = gridDim.x;
    Ptrs P;
#pragma unroll
    for (int i = 0; i < 25; ++i) P.in[i] = prm.in[i];
    P.out = prm.out; P.ws = prm.ws;
    P.RINV = (float*)(prm.ws + WS_RINV); P.SS = (float*)(prm.ws + WS_SS); P.ROPE = (float*)(prm.ws + WS_ROPE); P.ZB = (float*)(prm.ws + WS_ZB); P.LSE = (float*)(prm.ws + WS_LSE);
    P.WT = (bf16_t*)(prm.ws + WS_WT); P.WOT = (bf16_t*)(prm.ws + WS_WOT); P.XB = (bf16_t*)(prm.ws + WS_XB); P.Qb = (bf16_t*)(prm.ws + WS_Q); P.Kb = (bf16_t*)(prm.ws + WS_K); P.Vb = (bf16_t*)(prm.ws + WS_V);
    P.QMb = (bf16_t*)(prm.ws + WS_QM); P.Gb = (bf16_t*)(prm.ws + WS_G); P.MKB = (bf16_t*)(prm.ws + WS_MKB); P.MVB = (bf16_t*)(prm.ws + WS_MVB); P.OAP = (bf16_t*)(prm.ws + WS_OAP); P.OG = (bf16_t*)(prm.ws + WS_OG);
    const int lo = prm.ph_lo, hi = prm.ph_hi;
#define IN_PH(k) (lo <= (k) && (k) < hi)
    volatile LAS unsigned* bst = (volatile LAS unsigned*)(lds + LDS_BYTES - 16);
    if (tid < 4) bst[tid] = 0u;
    __syncthreads();
    XcdBarrier xbar; xbar.bar = (unsigned*)(prm.ws + WS_CTL) + 4096; xbar.x = 0; xbar.st = bst;
    if (prm.coop) xbar = xcd_barrier_post((unsigned*)(prm.ws + WS_CTL) + 4096, bst);
#define SEAM(k) do { if (IN_PH(k) && IN_PH((k) + 1)) { if ((k) == 0) cg::this_grid().sync(); else xcd_barrier(xbar); } } while (0)

    if (IN_PH(0)) { p0_prologue(P, lds, bid, G, tid); }
    SEAM(0);
    if (IN_PH(1)) {
        pg8::Gemm g{P.XB, P.WT, MROWS, NWT, DM}; Sched1 S; S.init(G, bid);
        Epi1 E{P.RINV, P.ROPE, P.Qb, P.Kb, P.Vb, P.QMb, P.Gb, P.MKB, P.MVB, P.ZB, P.out};
        pg8::gemm_phase<Epi1, Sched1, true, true>(lds, g, S, E);
    }
    SEAM(1);
#define ITEM_LOOP(LO, HI, B0, GG, CALL) do { int it = (LO) + (((B0) - (LO)) % (GG) + (GG)) % (GG); for (; it < (HI); it += (GG)) { const int li = it - (LO); CALL; } } while (0)
    if (IN_PH(2)) {
        constexpr int N0 = N_L_ITEMS, N1 = N0 + N_SCAN_S;
#ifndef DUP_L
#define DUP_L 1
#endif
#ifndef DUP_SS
#define DUP_SS 1
#endif
#ifndef DUP_S
#define DUP_S 1
#endif
#ifndef DUP_ATT
#define DUP_ATT 1
#endif
#ifndef DUP_MEM
#define DUP_MEM 1
#endif
#ifndef DUP_SDIL
#define DUP_SDIL 1
#endif
#ifndef DUP_SMEM
#define DUP_SMEM 1
#endif
        ITEM_LOOP(0, DUP_L * N0, bid, G, passL_item(prm, lds, li % N_L_ITEMS, tid));
        ITEM_LOOP(0, DUP_SS * N_SCAN_S, bid, G, scan_item(P, lds, true, (li % N_SCAN_S) / 6, li % 6, tid));
    }
    SEAM(2);
    if (IN_PH(3)) {
        if (bid < N_S_BLOCKS) { for (int rep = 0; rep < DUP_S; ++rep) passS_block(prm, lds, bid, tid); }
        else {
            constexpr int N1 = N_DIL_UNITS, N2 = N1 + N_MEMA_UNITS, N3 = N2 + N_SDIL_ITEMS, N4 = N3 + N_SMEM_ITEMS;
            const int b0 = bid - N_S_BLOCKS, gg = G - N_S_BLOCKS;
            ITEM_LOOP(0, DUP_ATT * N1, b0, gg, dil_unit(P, lds, li % N_DIL_UNITS, tid));
            ITEM_LOOP(0, DUP_MEM * N_MEMA_UNITS, b0, gg, mem_unit(P, lds, li % N_MEMA_UNITS, tid));
            ITEM_LOOP(0, DUP_SDIL * N_SDIL_ITEMS, b0, gg, sdil_item(P, lds, li % N_SDIL_ITEMS, tid));
            ITEM_LOOP(0, DUP_SMEM * N_SMEM_ITEMS, b0, gg, smem_item(P, lds, li % N_SMEM_ITEMS, tid));
        }
    }
    SEAM(3);
    if (IN_PH(4)) {
        for (int pr = bid * 8 + (tid >> 6); pr < 2 * N_L_ITEMS; pr += G * 8) passO_pair(prm, pr >> 1, pr & 1, tid & 63);
        p3_combine(P, bid, G, tid);
    }
    SEAM(4);
    if (IN_PH(5)) {
        pg8::Gemm g{P.OG, P.WOT, MTOK, DM, DM}; pg8::StaticOrder S; S.init(MTOK, DM, G, bid);
        Epi2 E{P.in[0], P.in[1], P.out + O_Y, P.SS};
        pg8::gemm_phase<Epi2, pg8::StaticOrder, true, true>(lds, g, S, E);
    }
    SEAM(5);
    if (IN_PH(6)) { p5_norm(P, bid, G, tid); }
}

constexpr int N_PHASES = 7;
#ifndef MK_ONE_LAUNCH
#define MK_ONE_LAUNCH 1
#endif
extern "C" void kernel_launch(void* const* d_in, const int* in_sizes, int n_in, void* d_out, int out_size, void* d_ws, size_t ws_size, hipStream_t stream) {
    static int grid = 0;
    if (grid == 0) {
        if (n_in != 25 || out_size != (int)O_END || ws_size < WS_END2) { fprintf(stderr, "kernel_launch: unexpected shapes (n_in %d, out %d, ws %zu < %zu)\n", n_in, out_size, ws_size, (size_t)WS_END2); grid = -1; return; }
        int dev = 0, cus = 0, per_cu = 0;
        (void)hipGetDevice(&dev); (void)hipDeviceGetAttribute(&cus, hipDeviceAttributeMultiprocessorCount, dev);
        if (hipFuncSetAttribute((const void*)fwd_kernel, hipFuncAttributeMaxDynamicSharedMemorySize, LDS_BYTES) != hipSuccess) { fprintf(stderr, "kernel_launch: hipFuncSetAttribute failed\n"); grid = -1; return; }
        if (hipOccupancyMaxActiveBlocksPerMultiprocessor(&per_cu, (const void*)fwd_kernel, NTHR, LDS_BYTES) != hipSuccess || per_cu < 1) { fprintf(stderr, "kernel_launch: occupancy query says %d blocks per CU\n", per_cu); (void)hipGetLastError(); per_cu = 1; }
        grid = cus;
    }
    if (grid < 0) return;
    if (hipMemsetAsync((char*)d_ws + WS_CTL, 0, 65536, stream) != hipSuccess) { fprintf(stderr, "kernel_launch: hipMemsetAsync failed\n"); return; }
    Params p{};
    for (int i = 0; i < 25; ++i) p.in[i] = (const float*)d_in[i];
    p.out = (float*)d_out; p.ws = (unsigned char*)d_ws;
#if MK_ONE_LAUNCH
    p.ph_lo = 0; p.ph_hi = N_PHASES; p.coop = 1;
    void* args[] = {&p};
    hipError_t e = hipLaunchCooperativeKernel((const void*)fwd_kernel, dim3(grid), dim3(NTHR), args, LDS_BYTES, stream);
    if (e != hipSuccess) fprintf(stderr, "cooperative launch failed: %s (grid %d)\n", hipGetErrorString(e), grid);
#else
    for (int ph = 0; ph < N_PHASES; ++ph) {
        p.ph_lo = ph; p.ph_hi = ph + 1; p.coop = 0;
        hipLaunchKernelGGL(fwd_kernel, dim3(grid), dim3(NTHR), LDS_BYTES, stream, p);
    }
#endif
}
```

```cpp
#include <hip/hip_runtime.h>
#include <hip/hip_cooperative_groups.h>
#include <cstdio>
#include <cstdint>
namespace cg = cooperative_groups;

#define LAS __attribute__((address_space(3)))
typedef unsigned short bf16_t;
typedef short bf16x8 __attribute__((ext_vector_type(8)));
typedef short s16x4 __attribute__((ext_vector_type(4)));
typedef float f32x4 __attribute__((ext_vector_type(4)));
typedef float f32x2 __attribute__((ext_vector_type(2)));
typedef float f32x16 __attribute__((ext_vector_type(16)));
typedef unsigned u32x4 __attribute__((ext_vector_type(4)));
typedef unsigned u32x2 __attribute__((ext_vector_type(2)));
typedef __bf16 bf16x2_t __attribute__((ext_vector_type(2)));

constexpr int DM = 1024, SEQ = 8192, NB = 2, DB = 32, DT = 8;
constexpr int MP = NB * SEQ;
constexpr int MS = DB * DT;
constexpr int MTOK = MP + MS;
constexpr int NMEM = 256, MMEM = NB * NMEM;
constexpr int MROWS = MTOK + MMEM;
constexpr int ATT_W = 384, RW = 384, MEM_W = 256, SHIFT_W = 1280, IN_W = 3712;
constexpr int NPAD = 3840;
constexpr int NWT = NPAD + 512;
constexpr int WINP = 2048;
constexpr int C_Q = 0, C_K = 384, C_V = 768, C_Z = 1152, C_QM = 2432, C_G = 2688;
constexpr size_t O_Y = 0, O_WK_P = 17039360, O_WV_P = 18612224, O_ST_P = 20185088, O_SH_P = 20234240, O_MK_P = 20236800, O_MV_P = 20367872,
                 O_WK_S = 20498944, O_WV_S = 20597248, O_ST_S = 20695552, O_SH_S = 21481984, O_END = 21522944;
constexpr size_t al256(size_t x) { return (x + 255) & ~(size_t)255; }
constexpr size_t WS_CTL = 0;
constexpr size_t WS_RINV = 1u << 20;
constexpr size_t WS_SS = al256(WS_RINV + (size_t)MROWS * 4);
constexpr size_t WS_ROPE = al256(WS_SS + (size_t)MTOK * 4);
constexpr int NPOS = 8200;
constexpr size_t WS_WT = al256(WS_ROPE + (size_t)NPOS * 16 * 4);
constexpr size_t WS_WOT = al256(WS_WT + (size_t)NWT * DM * 2);
constexpr size_t WS_XB = al256(WS_WOT + (size_t)DM * DM * 2);
constexpr size_t WS_Q = al256(WS_XB + (size_t)MROWS * DM * 2);
constexpr size_t WS_K = al256(WS_Q + (size_t)MTOK * ATT_W * 2);
constexpr size_t WS_V = al256(WS_K + (size_t)MTOK * ATT_W * 2);
constexpr size_t WS_ZB = al256(WS_V + (size_t)MTOK * ATT_W * 2);
constexpr size_t WS_QM = al256(WS_ZB + (size_t)MTOK * SHIFT_W * 4);
constexpr size_t WS_G = al256(WS_QM + (size_t)MTOK * MEM_W * 2);
constexpr size_t WS_MKB = al256(WS_G + (size_t)MTOK * DM * 2);
constexpr size_t WS_MVB = al256(WS_MKB + (size_t)MMEM * MEM_W * 2);
constexpr size_t WS_OAP = al256(WS_MVB + (size_t)MMEM * MEM_W * 2);
constexpr size_t WS_LSE = al256(WS_OAP + (size_t)3 * MTOK * ATT_W * 2);
constexpr size_t WS_OG = al256(WS_LSE + (size_t)3 * MTOK * 6 * 4);
constexpr size_t WS_END = al256(WS_OG + (size_t)MTOK * DM * 2);

constexpr int LDS_BYTES = 147456;
constexpr int NTHR = 512;

struct Params {
    const float* in[25];
    float* out;
    unsigned char* ws;
    int ph_lo, ph_hi, coop, pad;
};

__device__ __forceinline__ unsigned cvtpk(float lo, float hi) { f32x2 v = {lo, hi}; bf16x2_t b = __builtin_convertvector(v, bf16x2_t); return __builtin_bit_cast(unsigned, b); }
__device__ __forceinline__ bf16_t f2bf(float f) { return (bf16_t)(cvtpk(f, 0.f) & 0xffffu); }
__device__ __forceinline__ float bf2f(bf16_t b) { return __builtin_bit_cast(float, (unsigned)b << 16); }
__device__ __forceinline__ float bflo(unsigned w) { return __builtin_bit_cast(float, w << 16); }
__device__ __forceinline__ float bfhi(unsigned w) { return __builtin_bit_cast(float, w & 0xffff0000u); }
__device__ __forceinline__ float wave_sum(float v) {
#pragma unroll
    for (int o = 1; o < 64; o <<= 1) v += __shfl_xor(v, o);
    return v;
}
__device__ __forceinline__ float wave_max(float v) {
#pragma unroll
    for (int o = 1; o < 64; o <<= 1) v = fmaxf(v, __shfl_xor(v, o));
    return v;
}
template <int CTRL> __device__ __forceinline__ float dpp_f(float v) { return __builtin_bit_cast(float, __builtin_amdgcn_update_dpp(0, __builtin_bit_cast(int, v), CTRL, 0xf, 0xf, true)); }
__device__ __forceinline__ float sum8(float v) { v += dpp_f<0xB1>(v); v += dpp_f<0x4E>(v); v += dpp_f<0x141>(v); return v; }
#define LDS_WAIT() asm volatile("s_waitcnt lgkmcnt(0)" ::: "memory")

namespace pg8 {
constexpr int BM = 256, BK = 64, HALF = 128, HTB = HALF * BK * 2, STAGE_BYTES = 8 * HTB, NXCD = 8, WGM = 8;
__host__ __device__ __forceinline__ int lds_byte(int r, int c) { const int st = (r >> 4) * 2 + (c >> 5), rr = r & 15, cc = c & 31, ob = rr * 64 + cc * 2; return st * 1024 + (ob ^ (((ob >> 9) & 1) << 5)); }
__host__ __device__ __forceinline__ void stage_rc(int b, int& R, int& C) { const int st = b / 1024, sb = b % 1024, swz = sb ^ (((sb >> 9) & 1) << 5); R = (st >> 1) * 16 + swz / 64; C = (st & 1) * 32 + (swz % 64) / 2; }
__host__ __device__ __forceinline__ int perm32(int rho) { const int n = rho >> 4, i = rho & 15; return 8 * (i >> 2) + 4 * n + (i & 3); }
struct Unit { int pm, pn; };
struct Gemm { const bf16_t* A; const bf16_t* Bt; int M, N, K; };
struct StaticOrder {
    int nM, nN, nwg, G, c;
    __host__ __device__ void init(int M, int N, int G_, int c_) { nM = M / BM; nN = N / BM; nwg = nM * nN; G = G_; c = c_; }
    __host__ __device__ bool next(int i, Unit& u) const {
        const long L = (long)i * G + c; if (L >= nwg) return false;
        int wgid = (int)L; { const int q = nwg / NXCD, r = nwg % NXCD, xcd = wgid % NXCD, off = wgid / NXCD; wgid = (xcd < r ? xcd * (q + 1) : r * (q + 1) + (xcd - r) * q) + off; }
        const int nig = WGM * nN, gid = wgid / nig, fm = gid * WGM, gsz = (nM - fm) < WGM ? (nM - fm) : WGM;
        u.pm = fm + ((wgid % nig) % gsz); u.pn = (wgid % nig) / gsz; return true;
    }
    __device__ __forceinline__ void a_ready(const Unit&) const {}
    __device__ __forceinline__ void done(const Unit&) const {}
};

template <class Epi, class Sched, bool ALIGN_EPI = false, bool SP2 = false>
__device__ __forceinline__ void gemm_phase(LAS unsigned char* lds, const Gemm g, const Sched& S, const Epi& E) {
    const int tid = threadIdx.x, wid = __builtin_amdgcn_readfirstlane(tid >> 6), lane = tid & 63, wr = wid >> 2, wc = wid & 3, fr = lane & 15, fq = lane >> 4;
    const int K = g.K, nt = K / BK;
    unsigned voffA[2], voffB[2];
#pragma unroll
    for (int i = 0; i < 2; ++i) { int R, C; stage_rc(tid * 16 + i * 8192, R, C); const int Rb = Epi::PERM ? ((R & ~31) + perm32(R & 31)) : R;
        voffA[i] = (unsigned)(R * K + C) * 2u; voffB[i] = (unsigned)(Rb * K + C) * 2u; }
    const size_t kstep = (size_t)(BK * 2);
    const size_t hstep = (size_t)HALF * K * 2;
    const size_t tstep = 2 * hstep;
    const unsigned ldsw = (unsigned)wid * 1024u;
    const int aoff = lds_byte(wr * 64 + fr, fq * 8), boff = lds_byte(wc * 32 + fr, fq * 8);
#define PG8_SA(b, h) (((b) * 2 + (h)) * HTB)
#define PG8_SB(b, h) ((4 + (b) * 2 + (h)) * HTB)
#define PG8_STAGE(bufoff, gbase, voff) do { _Pragma("unroll") for (int _i = 0; _i < 2; ++_i) \
        __builtin_amdgcn_global_load_lds((const unsigned*)((const char*)(gbase) + (voff)[_i]), (LAS unsigned*)(lds + (bufoff) + ldsw + _i * 8192), 16, 0, 0); } while (0)
#define PG8_LDA(dst, b, h) do { _Pragma("unroll") for (int m = 0; m < 4; ++m) _Pragma("unroll") for (int k = 0; k < 2; ++k) dst[m][k] = *(const LAS bf16x8*)(lds + PG8_SA(b, h) + aoff + m * 2048 + k * 1024); } while (0)
#define PG8_LDB(dst, b, h) do { _Pragma("unroll") for (int n = 0; n < 2; ++n) _Pragma("unroll") for (int k = 0; k < 2; ++k) dst[n][k] = *(const LAS bf16x8*)(lds + PG8_SB(b, h) + boff + n * 2048 + k * 1024); } while (0)
#define PG8_MMA(ai, bj, At, Bt) do { __builtin_amdgcn_s_setprio(1); _Pragma("unroll") for (int m = 0; m < 4; ++m) _Pragma("unroll") for (int n = 0; n < 2; ++n) _Pragma("unroll") for (int k = 0; k < 2; ++k) \
        acc[ai][bj][m][n] = __builtin_amdgcn_mfma_f32_16x16x32_bf16(Bt[n][k], At[m][k], acc[ai][bj][m][n], 0, 0, 0); __builtin_amdgcn_s_setprio(0); } while (0)
#define PG8_WAIT_V(n) asm volatile("s_waitcnt vmcnt(" #n ")" ::: "memory")
#define PG8_WAIT_L(n) asm volatile("s_waitcnt lgkmcnt(" #n ")" ::: "memory")
#define PG8_BAR __builtin_amdgcn_s_barrier()
#define PG8_SCHED __builtin_amdgcn_sched_barrier(0)
    Unit cur, nxt; int ui = 0;
    if (!S.next(0, cur)) return;
    f32x4 acc[2][2][4][2];
#pragma unroll
    for (int a = 0; a < 2; ++a)
#pragma unroll
        for (int b = 0; b < 2; ++b)
#pragma unroll
            for (int m = 0; m < 4; ++m)
#pragma unroll
                for (int n = 0; n < 2; ++n) acc[a][b][m][n] = (f32x4){0.f, 0.f, 0.f, 0.f};
    bf16x8 At[4][2], B0[2][2], B1[2][2];
    const char* cA = (const char*)g.A + (size_t)cur.pm * tstep; const char* cB = (const char*)g.Bt + (size_t)cur.pn * tstep;
    S.a_ready(cur);
    if constexpr (SP2) {
        PG8_STAGE(PG8_SB(0, 0), cB, voffB); PG8_STAGE(PG8_SB(0, 1), cB + hstep, voffB); PG8_STAGE(PG8_SA(0, 0), cA, voffA); PG8_STAGE(PG8_SA(0, 1), cA + hstep, voffA);
        if (wr == 1) PG8_BAR;
        PG8_WAIT_V(2); PG8_BAR;
        PG8_STAGE(PG8_SB(1, 0), cB + kstep, voffB); PG8_STAGE(PG8_SA(1, 0), cA + kstep, voffA); PG8_STAGE(PG8_SB(1, 1), cB + hstep + kstep, voffB);
        PG8_WAIT_V(6); PG8_BAR;
    } else {
        PG8_STAGE(PG8_SB(0, 0), cB, voffB); PG8_STAGE(PG8_SA(0, 0), cA, voffA); PG8_STAGE(PG8_SB(0, 1), cB + hstep, voffB); PG8_STAGE(PG8_SA(0, 1), cA + hstep, voffA);
        if (wr == 1) PG8_BAR;
        PG8_WAIT_V(4); PG8_BAR;
        PG8_STAGE(PG8_SB(1, 0), cB + kstep, voffB); PG8_STAGE(PG8_SA(1, 0), cA + kstep, voffA); PG8_STAGE(PG8_SB(1, 1), cB + hstep + kstep, voffB);
        PG8_WAIT_V(6); PG8_BAR;
    }
    for (;;) {
        const bool has_next = S.next(ui + 1, nxt);
        const char* nA = has_next ? (const char*)g.A + (size_t)nxt.pm * tstep : cA; const char* nB = has_next ? (const char*)g.Bt + (size_t)nxt.pn * tstep : cB;
        for (int t = 0; t < nt; t += 2) {
            const bool last = (t == nt - 2);
            const char* a1 = cA + (size_t)(t + 1) * kstep;
            const char* a2 = last ? nA : cA + (size_t)(t + 2) * kstep; const char* b2 = last ? nB : cB + (size_t)(t + 2) * kstep;
            const char* a3 = a2 + kstep; const char* b3 = b2 + kstep;
            if (last && has_next) S.a_ready(nxt);
            if constexpr (SP2) {
            PG8_LDB(B0, 0, 0); PG8_LDB(B1, 0, 1); PG8_SCHED; PG8_LDA(At, 0, 0); PG8_STAGE(PG8_SA(1, 1), a1 + hstep, voffA);
            PG8_WAIT_V(8); PG8_WAIT_L(0); PG8_BAR; PG8_MMA(0, 0, At, B0); PG8_MMA(0, 1, At, B1); PG8_BAR; PG8_SCHED;
            PG8_LDA(At, 0, 1); PG8_STAGE(PG8_SB(0, 0), b2, voffB); PG8_STAGE(PG8_SB(0, 1), b2 + hstep, voffB); PG8_STAGE(PG8_SA(0, 0), a2, voffA);
            PG8_WAIT_V(8); PG8_WAIT_L(0); PG8_BAR; PG8_MMA(1, 0, At, B0); PG8_MMA(1, 1, At, B1); PG8_BAR; PG8_SCHED;
            PG8_LDB(B0, 1, 0); PG8_LDB(B1, 1, 1); PG8_SCHED; PG8_LDA(At, 1, 0); PG8_STAGE(PG8_SA(0, 1), a2 + hstep, voffA);
            PG8_WAIT_V(8); PG8_WAIT_L(0); PG8_BAR; PG8_MMA(0, 0, At, B0); PG8_MMA(0, 1, At, B1); PG8_BAR; PG8_SCHED;
            PG8_LDA(At, 1, 1); PG8_STAGE(PG8_SB(1, 0), b3, voffB); PG8_STAGE(PG8_SB(1, 1), b3 + hstep, voffB); PG8_STAGE(PG8_SA(1, 0), a3, voffA);
            PG8_WAIT_V(8); PG8_WAIT_L(0); PG8_BAR; PG8_MMA(1, 0, At, B0); PG8_MMA(1, 1, At, B1); PG8_BAR; PG8_SCHED;
            } else {
            PG8_LDB(B0, 0, 0); PG8_SCHED; PG8_LDA(At, 0, 0); PG8_STAGE(PG8_SA(1, 1), a1 + hstep, voffA);
            PG8_WAIT_L(8); PG8_BAR; PG8_WAIT_L(0); PG8_MMA(0, 0, At, B0); PG8_BAR; PG8_SCHED;
            PG8_LDB(B1, 0, 1); PG8_STAGE(PG8_SB(0, 0), b2, voffB);
            PG8_BAR; PG8_WAIT_L(0); PG8_MMA(0, 1, At, B1); PG8_BAR;
            PG8_LDA(At, 0, 1); PG8_STAGE(PG8_SA(0, 0), a2, voffA);
            PG8_BAR; PG8_WAIT_L(0); PG8_MMA(1, 0, At, B0); PG8_BAR; PG8_SCHED;
            PG8_STAGE(PG8_SB(0, 1), b2 + hstep, voffB);
            PG8_WAIT_V(6); PG8_BAR; PG8_MMA(1, 1, At, B1); PG8_BAR;
            PG8_LDB(B0, 1, 0); PG8_SCHED; PG8_LDA(At, 1, 0); PG8_STAGE(PG8_SA(0, 1), a2 + hstep, voffA);
            PG8_WAIT_L(8); PG8_BAR; PG8_WAIT_L(0); PG8_MMA(0, 0, At, B0); PG8_BAR; PG8_SCHED;
            PG8_LDB(B1, 1, 1); PG8_STAGE(PG8_SB(1, 0), b3, voffB);
            PG8_BAR; PG8_WAIT_L(0); PG8_MMA(0, 1, At, B1); PG8_BAR;
            PG8_LDA(At, 1, 1); PG8_STAGE(PG8_SA(1, 0), a3, voffA);
            PG8_BAR; PG8_WAIT_L(0); PG8_MMA(1, 0, At, B0); PG8_BAR; PG8_SCHED;
            PG8_STAGE(PG8_SB(1, 1), b3 + hstep, voffB);
            PG8_WAIT_V(6); PG8_BAR; PG8_MMA(1, 1, At, B1); PG8_BAR;
            }
        }
        if constexpr (ALIGN_EPI) { if (wr == 0) PG8_BAR; }
        if constexpr (!Epi::AFTER_DRAIN) { E(acc, cur, wr, wc, fr, fq); S.done(cur); }
        if (!has_next) break;
#pragma unroll
        for (int a = 0; a < 2; ++a)
#pragma unroll
            for (int b = 0; b < 2; ++b)
#pragma unroll
                for (int m = 0; m < 4; ++m)
#pragma unroll
                    for (int n = 0; n < 2; ++n) acc[a][b][m][n] = (f32x4){0.f, 0.f, 0.f, 0.f};
        cur = nxt; cA = nA; cB = nB; ++ui;
        if constexpr (ALIGN_EPI) { if (wr == 1) PG8_BAR; }
    }
    PG8_WAIT_V(0);
    if constexpr (!ALIGN_EPI) { if (wr == 0) PG8_BAR; }
    PG8_BAR;
    if constexpr (Epi::AFTER_DRAIN) { E.fused(acc, cur, wr, wc, fr, fq, lds, wid, lane); S.done(cur); }
#undef PG8_SA
#undef PG8_SB
#undef PG8_STAGE
#undef PG8_LDA
#undef PG8_LDB
#undef PG8_MMA
#undef PG8_WAIT_V
#undef PG8_WAIT_L
#undef PG8_BAR
#undef PG8_SCHED
}
}

constexpr int G1_NM = MTOK / 256, G1_NN = NPAD / 256, G1_MAIN = G1_NM * G1_NN, G1_UNITS = G1_MAIN + 4;
struct Sched1 {
    pg8::StaticOrder so;
    __device__ void init(int G, int c) { so.init(MTOK, NPAD, G, c); }
    __device__ bool next(int i, pg8::Unit& u) const {
        const long L = (long)i * so.G + so.c;
        if (L >= G1_UNITS) return false;
        if (L >= G1_MAIN) { const int e = (int)L - G1_MAIN; u.pm = G1_NM + (e >> 1); u.pn = G1_NN + (e & 1); return true; }
        return so.next(i, u);
    }
    __device__ __forceinline__ void a_ready(const pg8::Unit&) const {}
    __device__ __forceinline__ void done(const pg8::Unit&) const {}
};

struct Epi1 {
    static constexpr bool PERM = true, AFTER_DRAIN = false;
    const float* rinv; const float* rope; bf16_t *Qb, *Kb, *Vb, *QMb, *Gb, *MKB, *MVB; float* ZB; float* out;
    __device__ __forceinline__ void operator()(const f32x4 (&acc)[2][2][4][2], const pg8::Unit& u, int wr, int wc, int fr, int fq) const {
        const bool memu = u.pm >= G1_NM;
#pragma unroll
        for (int ai = 0; ai < 2; ++ai)
#pragma unroll
            for (int m = 0; m < 4; ++m) {
                const int row = u.pm * 256 + ai * 128 + wr * 64 + m * 16 + fr;
                const float rs = rinv[row];
#pragma unroll
                for (int bj = 0; bj < 2; ++bj) {
                    const int c0 = u.pn * 256 + bj * 128 + wc * 32 + 8 * fq;
                    float v[8];
#pragma unroll
                    for (int e = 0; e < 4; ++e) { v[e] = acc[ai][bj][m][0][e] * rs; v[4 + e] = acc[ai][bj][m][1][e] * rs; }
                    if (memu) {
                        const int mrow = row - MTOK, mc = c0 - NPAD;
                        float* of = out + (mc < 256 ? O_MK_P : O_MV_P) + (size_t)mrow * 256 + (mc & 255);
                        *(f32x4*)of = (f32x4){v[0], v[1], v[2], v[3]}; *(f32x4*)(of + 4) = (f32x4){v[4], v[5], v[6], v[7]};
                        bf16_t* ob = (mc < 256 ? MKB : MVB) + (size_t)mrow * 256 + (mc & 255);
                        *(u32x4*)ob = (u32x4){cvtpk(v[0], v[1]), cvtpk(v[2], v[3]), cvtpk(v[4], v[5]), cvtpk(v[6], v[7])};
                        continue;
                    }
                    const int cb = c0 >> 7;
                    const bool samp = row >= MP;
                    const int srow = row - MP;
                    if (cb < 6) {
                        if ((wc & 1) == 0) {
                            float pr[8];
#pragma unroll
                            for (int e = 0; e < 8; ++e) pr[e] = __shfl_xor(v[e], 16);
                            if (fq < 2) {
                                const int pos = samp ? (SEQ + (srow & 7)) : (row & (SEQ - 1));
                                const f32x4 c0v = *(const f32x4*)(rope + (size_t)pos * 16), c1v = *(const f32x4*)(rope + (size_t)pos * 16 + 4);
                                const f32x4 s0v = *(const f32x4*)(rope + (size_t)pos * 16 + 8), s1v = *(const f32x4*)(rope + (size_t)pos * 16 + 12);
                                const float cs[8] = {c0v[0], c0v[1], c0v[2], c0v[3], c1v[0], c1v[1], c1v[2], c1v[3]};
                                const float sn[8] = {s0v[0], s0v[1], s0v[2], s0v[3], s1v[0], s1v[1], s1v[2], s1v[3]};
                                const float sg = (fq == 0) ? -1.f : 1.f;
#pragma unroll
                                for (int e = 0; e < 8; ++e) v[e] = v[e] * cs[e] + sg * pr[e] * sn[e];
                            }
                        }
                        if (cb < 3) {
#pragma unroll
                            for (int e = 0; e < 8; ++e) v[e] *= 0.125f;
                            *(u32x4*)(Qb + (size_t)row * ATT_W + c0) = (u32x4){cvtpk(v[0], v[1]), cvtpk(v[2], v[3]), cvtpk(v[4], v[5]), cvtpk(v[6], v[7])};
                        } else {
                            const int cc = c0 - C_K;
                            *(u32x4*)(Kb + (size_t)row * ATT_W + cc) = (u32x4){cvtpk(v[0], v[1]), cvtpk(v[2], v[3]), cvtpk(v[4], v[5]), cvtpk(v[6], v[7])};
                            float* of = nullptr;
                            if (samp) of = out + O_WK_S + (size_t)srow * ATT_W + cc;
                            else { const int t = row & (SEQ - 1); if (t >= SEQ - WINP) of = out + O_WK_P + ((size_t)(row >> 13) * WINP + (t - (SEQ - WINP))) * ATT_W + cc; }
                            if (of) { *(f32x4*)of = (f32x4){v[0], v[1], v[2], v[3]}; *(f32x4*)(of + 4) = (f32x4){v[4], v[5], v[6], v[7]}; }
                        }
                    } else if (cb < 9) {
                        const int cc = c0 - C_V;
                        *(u32x4*)(Vb + (size_t)row * ATT_W + cc) = (u32x4){cvtpk(v[0], v[1]), cvtpk(v[2], v[3]), cvtpk(v[4], v[5]), cvtpk(v[6], v[7])};
                        float* of = nullptr;
                        if (samp) of = out + O_WV_S + (size_t)srow * ATT_W + cc;
                        else { const int t = row & (SEQ - 1); if (t >= SEQ - WINP) of = out + O_WV_P + ((size_t)(row >> 13) * WINP + (t - (SEQ - WINP))) * ATT_W + cc; }
                        if (of) { *(f32x4*)of = (f32x4){v[0], v[1], v[2], v[3]}; *(f32x4*)(of + 4) = (f32x4){v[4], v[5], v[6], v[7]}; }
                    } else if (cb < 19) {
                        const int cc = c0 - C_Z;
                        float* zf = ZB + (size_t)row * SHIFT_W + cc;
                        *(f32x4*)zf = (f32x4){v[0], v[1], v[2], v[3]}; *(f32x4*)(zf + 4) = (f32x4){v[4], v[5], v[6], v[7]};
                        float* of = nullptr;
                        if (samp) { if ((srow & 7) == 7) of = out + O_SH_S + (size_t)(srow >> 3) * SHIFT_W + cc; }
                        else if ((row & (SEQ - 1)) == SEQ - 1) of = out + O_SH_P + (size_t)(row >> 13) * SHIFT_W + cc;
                        if (of) { *(f32x4*)of = (f32x4){v[0], v[1], v[2], v[3]}; *(f32x4*)(of + 4) = (f32x4){v[4], v[5], v[6], v[7]}; }
                    } else if (cb < 21) {
                        const int cc = c0 - C_QM;
#pragma unroll
                        for (int e = 0; e < 8; ++e) v[e] *= 0.125f;
                        *(u32x4*)(QMb + (size_t)row * MEM_W + cc) = (u32x4){cvtpk(v[0], v[1]), cvtpk(v[2], v[3]), cvtpk(v[4], v[5]), cvtpk(v[6], v[7])};
                    } else if (cb < 29) {
                        const int cc = c0 - C_G;
#pragma unroll
                        for (int e = 0; e < 8; ++e) v[e] = v[e] / (1.f + __expf(-v[e]));
                        *(u32x4*)(Gb + (size_t)row * DM + cc) = (u32x4){cvtpk(v[0], v[1]), cvtpk(v[2], v[3]), cvtpk(v[4], v[5]), cvtpk(v[6], v[7])};
                    }
                }
            }
    }
};

struct Epi2 {
    static constexpr bool PERM = false, AFTER_DRAIN = false;
    const float* xp; const float* xs; float* Y; float* SS;
    __device__ __forceinline__ void operator()(const f32x4 (&acc)[2][2][4][2], const pg8::Unit& u, int wr, int wc, int fr, int fq) const {
#pragma unroll
        for (int ai = 0; ai < 2; ++ai)
#pragma unroll
            for (int m = 0; m < 4; ++m) {
                const int row = u.pm * 256 + ai * 128 + wr * 64 + m * 16 + fr;
                const float* xr = (row < MP) ? xp + (size_t)row * DM : xs + (size_t)(row - MP) * DM;
                float ss = 0.f;
#pragma unroll
                for (int bj = 0; bj < 2; ++bj)
#pragma unroll
                    for (int n = 0; n < 2; ++n) {
                        const int c = u.pn * 256 + bj * 128 + wc * 32 + n * 16 + 4 * fq;
                        const f32x4 xv = *(const f32x4*)(xr + c);
                        const f32x4 o = xv + acc[ai][bj][m][n];
                        ss += (o[0] * o[0] + o[1] * o[1]) + (o[2] * o[2] + o[3] * o[3]);
                        *(f32x4*)(Y + (size_t)row * DM + c) = o;
                    }
                ss += __shfl_xor(ss, 16); ss += __shfl_xor(ss, 32);
                if (fq == 0) atomicAdd(SS + row, ss);
            }
    }
};

constexpr int KS = 144, VS = 144;
constexpr float L2E = 1.4426950408889634f;
__device__ __forceinline__ int crow(int r, int hi) { return (r & 3) + 8 * (r >> 2) + 4 * hi; }
typedef short v4i16_t __attribute__((ext_vector_type(4)));
__device__ __forceinline__ s16x4 vtr(LAS const unsigned char* p) { return __builtin_bit_cast(s16x4, __builtin_amdgcn_ds_read_tr16_b64_v4i16((LAS v4i16_t*)p)); }

template <int NTG, int NG, bool BAND>
__device__ __forceinline__ void strip_attn(const bf16x8 (&qf)[4], LAS const unsigned char* Kl, LAS const unsigned char* Vl, int krow0, int lane, int kmin,
                                           f32x16 (&o)[2], float& m_out, float& l_out) {
    const int q = lane & 31, hi = lane >> 5;
    float m_run = -INFINITY, l_run = 0.f;
#pragma unroll
    for (int r = 0; r < 16; ++r) { o[0][r] = 0.f; o[1][r] = 0.f; }
#pragma unroll
    for (int g = 0; g < NG; ++g) {
        f32x16 S[NTG];
#pragma unroll
        for (int t = 0; t < NTG; ++t) {
#pragma unroll
            for (int r = 0; r < 16; ++r) S[t][r] = 0.f;
            LAS const unsigned char* kp = Kl + (size_t)(krow0 + (g * NTG + t) * 32 + q) * KS + hi * 16;
#pragma unroll
            for (int d0 = 0; d0 < 4; ++d0) {
                const bf16x8 kf = *(LAS const bf16x8*)(kp + d0 * 32);
                S[t] = __builtin_amdgcn_mfma_f32_32x32x16_bf16(kf, qf[d0], S[t], 0, 0, 0);
            }
        }
        float mx = -INFINITY;
#pragma unroll
        for (int t = 0; t < NTG; ++t)
#pragma unroll
            for (int r = 0; r < 16; ++r) {
                if (BAND) { const int ko = 32 * (g * NTG + t) + crow(r, hi); if (ko < q || ko > q + 128 || ko < kmin) S[t][r] = -INFINITY; }
                mx = fmaxf(mx, S[t][r]);
            }
        mx = fmaxf(mx, __shfl_xor(mx, 32));
        const float m_new = fmaxf(m_run, mx);
        const float alpha = __builtin_amdgcn_exp2f((m_run - m_new) * L2E);
        float ls = 0.f;
#pragma unroll
        for (int t = 0; t < NTG; ++t)
#pragma unroll
            for (int r = 0; r < 16; ++r) { const float p = __builtin_amdgcn_exp2f((S[t][r] - m_new) * L2E); S[t][r] = p; ls += p; }
        ls += __shfl_xor(ls, 32);
        l_run = l_run * alpha + ls; m_run = m_new;
        if (g > 0) {
#pragma unroll
            for (int r = 0; r < 16; ++r) { const float a = __shfl(alpha, crow(r, hi)); o[0][r] *= a; o[1][r] *= a; }
        }
#pragma unroll
        for (int t = 0; t < NTG; ++t)
#pragma unroll
            for (int s = 0; s < 2; ++s) {
                u32x4 pw; pw[0] = cvtpk(S[t][8 * s + 0], S[t][8 * s + 1]); pw[1] = cvtpk(S[t][8 * s + 2], S[t][8 * s + 3]);
                pw[2] = cvtpk(S[t][8 * s + 4], S[t][8 * s + 5]); pw[3] = cvtpk(S[t][8 * s + 6], S[t][8 * s + 7]);
                const bf16x8 pa = __builtin_bit_cast(bf16x8, pw);
                const int vrow = krow0 + (g * NTG + t) * 32 + 16 * s + 4 * hi + ((lane & 15) >> 2);
                LAS const unsigned char* vp = Vl + (size_t)vrow * VS + (16 * ((lane >> 4) & 1) + 4 * (lane & 3)) * 2;
#pragma unroll
                for (int dt = 0; dt < 2; ++dt) {
                    const s16x4 lo = vtr(vp + dt * 64), hh = vtr(vp + dt * 64 + 8 * VS);
                    const bf16x8 vb = (bf16x8){lo[0], lo[1], lo[2], lo[3], hh[0], hh[1], hh[2], hh[3]};
                    o[dt] = __builtin_amdgcn_mfma_f32_32x32x16_bf16(pa, vb, o[dt], 0, 0, 0);
                }
            }
    }
    m_out = m_run; l_out = l_run;
}

struct Ptrs {
    const float* in[25]; float* out; unsigned char* ws;
    float *RINV, *SS, *ROPE, *ZB, *LSE;
    bf16_t *WT, *WOT, *XB, *Qb, *Kb, *Vb, *QMb, *Gb, *MKB, *MVB, *OAP, *OG;
};

constexpr int N_DIL_UNITS = NB * 6 * 3 * 32;
constexpr int OSTG = 110592;
__device__ __forceinline__ void o_stage(LAS unsigned char* stg, const f32x16 (&o)[2], float linv, int lane, u32x4 (&outv)[4]) {
    const int hi = lane >> 5, q = lane & 31;
#pragma unroll
    for (int r = 0; r < 16; ++r) {
        const int qq = crow(r, hi); const float li = __shfl(linv, qq);
        *(LAS bf16_t*)(stg + qq * 144 + q * 2) = f2bf(o[0][r] * li); *(LAS bf16_t*)(stg + qq * 144 + (32 + q) * 2) = f2bf(o[1][r] * li);
    }
    LDS_WAIT();
#pragma unroll
    for (int k = 0; k < 4; ++k) { const int idx = lane + 64 * k; outv[k] = *(LAS const u32x4*)(stg + (idx >> 3) * 144 + (idx & 7) * 16); }
}
__device__ __forceinline__ void dil_unit(const Ptrs& P, LAS unsigned char* lds, int unit, int tid) {
    const int lane = tid & 63, wave = tid >> 6;
    const int u32 = unit & 31, x = unit >> 5, di = x % 3, bh = x / 3, b = bh / 6, h = bh % 6;
    const int dil = (di == 0) ? 1 : (di == 1 ? 4 : 16), nb2 = 32 / dil, res = u32 / nb2, j = u32 % nb2;
    LAS unsigned char* Kl = lds; LAS unsigned char* Vl = lds + 384 * KS;
    const int l0 = 256 * j - 128;
    const int q = lane & 31, hi = lane >> 5, lq0 = 256 * j + 32 * wave;
    const size_t tokq = (size_t)b * SEQ + (size_t)(lq0 + q) * dil + res;
    u32x4 kv[6], vv[6];
#pragma unroll
    for (int i = 0; i < 6; ++i) {
        const int e = tid + NTHR * i, row = e >> 3, c = e & 7, l = l0 + row, lc = l < 0 ? 0 : l;
        const size_t off = ((size_t)b * SEQ + (size_t)lc * dil + res) * ATT_W + h * 64 + c * 8;
        kv[i] = *(const u32x4*)(P.Kb + off); vv[i] = *(const u32x4*)(P.Vb + off);
    }
    bf16x8 qf[4];
#pragma unroll
    for (int d0 = 0; d0 < 4; ++d0) qf[d0] = *(const bf16x8*)(P.Qb + tokq * ATT_W + h * 64 + d0 * 16 + hi * 8);
#pragma unroll
    for (int i = 0; i < 6; ++i) {
        const int e = tid + NTHR * i, row = e >> 3, c = e & 7, l = l0 + row;
        if (l < 0) { kv[i] = (u32x4){0u, 0u, 0u, 0u}; vv[i] = kv[i]; }
        *(LAS u32x4*)(Kl + row * KS + c * 16) = kv[i]; *(LAS u32x4*)(Vl + row * VS + c * 16) = vv[i];
    }
    __syncthreads();
    f32x16 o[2]; float mm, ll;
    strip_attn<5, 1, true>(qf, Kl, Vl, 32 * wave, lane, (lq0 < 128) ? 128 - lq0 : 0, o, mm, ll);
    u32x4 ov[4];
    o_stage(lds + OSTG + wave * 4608, o, 1.f / ll, lane, ov);
#pragma unroll
    for (int k = 0; k < 4; ++k) { const int idx = lane + 64 * k, row = idx >> 3, c = idx & 7;
        const size_t tok = (size_t)b * SEQ + (size_t)(lq0 + row) * dil + res;
        *(u32x4*)(P.OAP + ((size_t)di * MTOK + tok) * ATT_W + h * 64 + c * 8) = ov[k]; }
    if (hi == 0) P.LSE[((size_t)di * MTOK + tokq) * 6 + h] = mm + __logf(ll);
    __syncthreads();
}

constexpr int N_MEMA_UNITS = NB * 4 * 32;
__device__ __forceinline__ void mem_unit(const Ptrs& P, LAS unsigned char* lds, int unit, int tid) {
    const int lane = tid & 63, wave = tid >> 6;
    const int jq = unit & 31, bh = unit >> 5, b = bh >> 2, hm = bh & 3;
    LAS unsigned char* Kl = lds; LAS unsigned char* Vl = lds + 256 * KS;
    const int q = lane & 31, hi = lane >> 5;
    const size_t tok0 = (size_t)b * SEQ + 256 * jq + 32 * wave;
    u32x4 kv[4], vv[4];
#pragma unroll
    for (int i = 0; i < 4; ++i) {
        const int e = tid + NTHR * i, row = e >> 3, c = e & 7;
        const size_t off = ((size_t)b * NMEM + row) * MEM_W + hm * 64 + c * 8;
        kv[i] = *(const u32x4*)(P.MKB + off); vv[i] = *(const u32x4*)(P.MVB + off);
    }
    bf16x8 qf[4];
#pragma unroll
    for (int d0 = 0; d0 < 4; ++d0) qf[d0] = *(const bf16x8*)(P.QMb + (tok0 + q) * MEM_W + hm * 64 + d0 * 16 + hi * 8);
    u32x4 gv[4];
#pragma unroll
    for (int k = 0; k < 4; ++k) { const int idx = lane + 64 * k; gv[k] = *(const u32x4*)(P.Gb + (tok0 + (idx >> 3)) * DM + 768 + hm * 64 + (idx & 7) * 8); }
#pragma unroll
    for (int i = 0; i < 4; ++i) { const int e = tid + NTHR * i, row = e >> 3, c = e & 7; *(LAS u32x4*)(Kl + row * KS + c * 16) = kv[i]; *(LAS u32x4*)(Vl + row * VS + c * 16) = vv[i]; }
    __syncthreads();
    f32x16 o[2]; float mm, ll;
    strip_attn<4, 2, false>(qf, Kl, Vl, 0, lane, 0, o, mm, ll);
    u32x4 ov[4];
    o_stage(lds + OSTG + wave * 4608, o, 1.f / ll, lane, ov);
#pragma unroll
    for (int k = 0; k < 4; ++k) { const int idx = lane + 64 * k;
        u32x4 w;
#pragma unroll
        for (int e = 0; e < 4; ++e) w[e] = cvtpk(bflo(ov[k][e]) * bflo(gv[k][e]), bfhi(ov[k][e]) * bfhi(gv[k][e]));
        *(u32x4*)(P.OG + (tok0 + (idx >> 3)) * DM + 768 + hm * 64 + (idx & 7) * 8) = w; }
    __syncthreads();
}

constexpr int N_SDIL_ITEMS = DB * DT * 3;
__device__ __forceinline__ void sdil_item(const Ptrs& P, LAS unsigned char* lds, int item, int tid) {
    const int di = item % 3, qi = item / 3, db = qi >> 3, i = qi & 7, lane = tid & 63, wave = tid >> 6;
    const int dil = (di == 0) ? 1 : (di == 1 ? 4 : 16);
    LAS float* sc = (LAS float*)lds;
    LAS float* stm = sc + 132 * 6;
    LAS float* red = stm + 16;
    const int g = tid / 96, u = tid % 96, hh = u >> 4;
    const size_t srow = (size_t)MP + db * 8 + i;
    const float* ck = P.in[2] + (size_t)db * WINP * ATT_W; const float* cv = P.in[3] + (size_t)db * WINP * ATT_W;
    const float* nk = P.out + O_WK_S + (size_t)db * 8 * ATT_W; const float* nv = P.out + O_WV_S + (size_t)db * 8 * ATT_W;
    f32x4 q4 = (f32x4){0.f, 0.f, 0.f, 0.f};
    if (g < 5) { const u32x2 w = *(const u32x2*)(P.Qb + srow * ATT_W + u * 4); q4 = (f32x4){bflo(w[0]), bfhi(w[0]), bflo(w[1]), bfhi(w[1])}; }
    const int gc = g < 5 ? g : 4;
#pragma unroll
    for (int half = 0; half < 2; ++half) {
        f32x4 kr[13];
#pragma unroll
        for (int k = 0; k < 13; ++k) { int jj = gc + 5 * (13 * half + k); if (jj > 128) jj = 128; const int idx = WINP + i - dil * jj;
            const float* p = (idx >= WINP) ? nk + (size_t)(idx - WINP) * ATT_W : ck + (size_t)idx * ATT_W; kr[k] = *(const f32x4*)(p + u * 4); }
#pragma unroll
        for (int k = 0; k < 13; ++k) { const int jj = g + 5 * (13 * half + k);
            float d = (kr[k][0] * q4[0] + kr[k][1] * q4[1]) + (kr[k][2] * q4[2] + kr[k][3] * q4[3]);
            d += __shfl_xor(d, 1); d += __shfl_xor(d, 2); d += __shfl_xor(d, 4); d += __shfl_xor(d, 8);
            if (g < 5 && jj < 129 && (u & 15) == 0) sc[jj * 6 + hh] = d; }
    }
    __syncthreads();
    if (wave < 6) {
        float v0 = sc[lane * 6 + wave], v1 = sc[(64 + lane) * 6 + wave], v2 = (lane == 0) ? sc[128 * 6 + wave] : -INFINITY;
        const float mx = wave_max(fmaxf(fmaxf(v0, v1), v2));
        v0 = __expf(v0 - mx); v1 = __expf(v1 - mx); v2 = (lane == 0) ? __expf(v2 - mx) : 0.f;
        const float sm = wave_sum(v0 + v1 + v2);
        sc[lane * 6 + wave] = v0; sc[(64 + lane) * 6 + wave] = v1; if (lane == 0) { sc[128 * 6 + wave] = v2; stm[wave] = mx; stm[8 + wave] = sm; }
    }
    __syncthreads();
    {
        f32x4 a = (f32x4){0.f, 0.f, 0.f, 0.f};
#pragma unroll
        for (int half = 0; half < 2; ++half) {
            f32x4 vr[13];
#pragma unroll
            for (int k = 0; k < 13; ++k) { int jj = gc + 5 * (13 * half + k); if (jj > 128) jj = 128; const int idx = WINP + i - dil * jj;
                const float* p = (idx >= WINP) ? nv + (size_t)(idx - WINP) * ATT_W : cv + (size_t)idx * ATT_W; vr[k] = *(const f32x4*)(p + u * 4); }
#pragma unroll
            for (int k = 0; k < 13; ++k) { const int jj = g + 5 * (13 * half + k); const float pw = (g < 5 && jj < 129) ? sc[jj * 6 + hh] : 0.f; a += vr[k] * pw; }
        }
        if (g < 5) *(LAS f32x4*)(red + g * 384 + u * 4) = a;
    }
    __syncthreads();
    if (tid < 96) {
        f32x4 a = *(LAS f32x4*)(red + tid * 4);
#pragma unroll
        for (int k = 1; k < 5; ++k) a += *(LAS f32x4*)(red + k * 384 + tid * 4);
        const float li = 1.f / stm[8 + (tid >> 4)];
        *(u32x2*)(P.OAP + ((size_t)di * MTOK + srow) * ATT_W + tid * 4) = (u32x2){cvtpk(a[0] * li, a[1] * li), cvtpk(a[2] * li, a[3] * li)};
        if ((tid & 15) == 0) P.LSE[((size_t)di * MTOK + srow) * 6 + (tid >> 4)] = stm[tid >> 4] + __logf(stm[8 + (tid >> 4)]);
    }
    __syncthreads();
}

constexpr int N_SMEM_ITEMS = DB * 4;
__device__ __forceinline__ void smem_item(const Ptrs& P, LAS unsigned char* lds, int item, int tid) {
    const int db = item >> 2, hm = item & 3, lane = tid & 63, wave = tid >> 6;
    LAS float* qs = (LAS float*)lds;
    LAS float* sc = qs + 512;
    LAS float* li = sc + 2048;
    { const int qi = tid >> 6, d = tid & 63; qs[tid] = bf2f(P.QMb[((size_t)MP + db * 8 + qi) * MEM_W + hm * 64 + d]); }
    __syncthreads();
    {
        const int m = tid & 255, qh = tid >> 8;
        const float* kr = P.in[6] + (((size_t)db * NMEM + m) * 4 + hm) * 64;
        float d0 = 0.f, d1 = 0.f, d2 = 0.f, d3 = 0.f;
#pragma unroll 4
        for (int c = 0; c < 16; ++c) {
            const f32x4 k4 = *(const f32x4*)(kr + c * 4);
            const f32x4 a0 = *(LAS f32x4*)(qs + (qh * 4 + 0) * 64 + c * 4), a1 = *(LAS f32x4*)(qs + (qh * 4 + 1) * 64 + c * 4), a2 = *(LAS f32x4*)(qs + (qh * 4 + 2) * 64 + c * 4), a3 = *(LAS f32x4*)(qs + (qh * 4 + 3) * 64 + c * 4);
            d0 += (k4[0] * a0[0] + k4[1] * a0[1]) + (k4[2] * a0[2] + k4[3] * a0[3]); d1 += (k4[0] * a1[0] + k4[1] * a1[1]) + (k4[2] * a1[2] + k4[3] * a1[3]);
            d2 += (k4[0] * a2[0] + k4[1] * a2[1]) + (k4[2] * a2[2] + k4[3] * a2[3]); d3 += (k4[0] * a3[0] + k4[1] * a3[1]) + (k4[2] * a3[2] + k4[3] * a3[3]);
        }
        sc[(qh * 4 + 0) * 256 + m] = d0; sc[(qh * 4 + 1) * 256 + m] = d1; sc[(qh * 4 + 2) * 256 + m] = d2; sc[(qh * 4 + 3) * 256 + m] = d3;
    }
    __syncthreads();
    {
        float v[4]; float mx = -INFINITY;
#pragma unroll
        for (int k = 0; k < 4; ++k) { v[k] = sc[wave * 256 + k * 64 + lane]; mx = fmaxf(mx, v[k]); }
        mx = wave_max(mx); float sm = 0.f;
#pragma unroll
        for (int k = 0; k < 4; ++k) { v[k] = __expf(v[k] - mx); sm += v[k]; sc[wave * 256 + k * 64 + lane] = v[k]; }
        sm = wave_sum(sm); if (lane == 0) li[wave] = 1.f / sm;
    }
    __syncthreads();
    {
        const int qi = tid >> 6, d = tid & 63;
        const float* vr = P.in[7] + (((size_t)db * NMEM) * 4 + hm) * 64 + d;
        float a = 0.f;
#pragma unroll 8
        for (int m = 0; m < 256; ++m) a += sc[qi * 256 + m] * vr[(size_t)m * 256];
        const size_t oo = ((size_t)MP + db * 8 + qi) * DM + 768 + hm * 64 + d;
        P.OG[oo] = f2bf(a * li[qi] * bf2f(P.Gb[oo]));
    }
    __syncthreads();
}

constexpr int N_SCAN_P = NB * 6, N_SCAN_S = DB * 6;
constexpr int CH = 32;
__device__ __forceinline__ float softplusf(float x) { return fmaxf(x, 0.f) + log1pf(__expf(-fabsf(x))); }
__device__ __forceinline__ void scan_item(const Ptrs& P, LAS unsigned char* lds, bool sample, int bb, int h, int tid) {
    const int lane = tid & 63, wave = tid >> 6;
    const int T = sample ? DT : SEQ;
    const size_t row0 = sample ? (size_t)MP + bb * DT : (size_t)bb * SEQ;
    LAS float* W2h = (LAS float*)lds;
    LAS float* A2h = W2h + 4096;
    LAS float* Rr = A2h + 4096;
    LAS float* Kk = Rr + CH * 64;
    LAS float* Vv = Kk + CH * 64;
    LAS float* Wd = Vv + CH * 64;
    LAS float* KK = Wd + CH * 64;
    LAS float* Bb = KK + CH * 64;
    LAS float* TW = Bb + CH * 64;
    LAS float* AL = TW + CH * 64;
    LAS float* Yb = AL + CH * 64;
    const float* mu = P.in[11]; const float* w0 = P.in[12]; const float* w2 = P.in[13]; const float* a0 = P.in[14]; const float* a2 = P.in[15];
    const float* k_k = P.in[16]; const float* k_a = P.in[17]; const float* r_k = P.in[18]; const float* lnx_g = P.in[19]; const float* lnx_b = P.in[20];
    for (int e = tid; e < 4096; e += NTHR) { const int jr = e >> 6, c = e & 63; W2h[e] = w2[(size_t)jr * RW + h * 64 + c]; A2h[e] = a2[(size_t)jr * RW + h * 64 + c]; }
    const int v = tid >> 3, kq = tid & 7;
    float s[8];
    if (sample) {
        const float* sp = P.in[4] + (((size_t)bb * 6 + h) * 64 + v) * 64 + kq * 8;
#pragma unroll
        for (int e = 0; e < 8; ++e) s[e] = sp[e];
    } else {
#pragma unroll
        for (int e = 0; e < 8; ++e) s[e] = 0.f;
    }
    const float* shift0 = P.in[5] + (size_t)bb * SHIFT_W;
    __syncthreads();
    for (int c0 = 0; c0 < T; c0 += CH) {
        const int n = (T - c0) < CH ? (T - c0) : CH;
        {
            float zv[20], zpv[20];
#pragma unroll
            for (int ti = 0; ti < 4; ++ti)
#pragma unroll
                for (int grp = 0; grp < 5; ++grp) {
                    const int t = wave + 8 * ti, col = (grp < 3) ? grp * RW + h * 64 + lane : 3 * RW + (grp - 3) * 64 + lane;
                    const size_t row = row0 + c0 + t;
                    float z = 0.f, zp = 0.f;
                    if (t < n) { z = P.ZB[row * SHIFT_W + col]; zp = (c0 + t == 0) ? (sample ? shift0[col] : 0.f) : P.ZB[(row - 1) * SHIFT_W + col]; }
                    zv[ti * 5 + grp] = z; zpv[ti * 5 + grp] = zp;
                }
#pragma unroll
            for (int ti = 0; ti < 4; ++ti)
#pragma unroll
                for (int grp = 0; grp < 5; ++grp) {
                    const int t = wave + 8 * ti, col = (grp < 3) ? grp * RW + h * 64 + lane : 3 * RW + (grp - 3) * 64 + lane;
                    const float zs = zv[ti * 5 + grp] + (zpv[ti * 5 + grp] - zv[ti * 5 + grp]) * mu[col];
                    if (t < n) {
                        if (grp == 0) Rr[t * 64 + lane] = zs; else if (grp == 1) Kk[t * 64 + lane] = zs; else if (grp == 2) Vv[t * 64 + lane] = zs;
                        else if (grp == 3) TW[t * 64 + lane] = tanhf(zs); else AL[t * 64 + lane] = zs;
                    }
                }
        }
        __syncthreads();
        for (int idx = tid; idx < n * 64; idx += NTHR) {
            const int t = idx >> 6, c = idx & 63, ch = h * 64 + c;
            float wv = w0[ch], av = a0[ch];
#pragma unroll 8
            for (int jr = 0; jr < 64; ++jr) { wv += TW[t * 64 + jr] * W2h[jr * 64 + c]; av += AL[t * 64 + jr] * A2h[jr * 64 + c]; }
            const float w = -softplusf(-wv) - 0.5f;
            const float decay = __expf(-__expf(w));
            const float a = 1.f / (1.f + __expf(-av));
            const float kraw = Kk[t * 64 + c];
            Wd[t * 64 + c] = decay;
            KK[t * 64 + c] = kraw * k_k[ch];
            Kk[t * 64 + c] = kraw * (1.f + (a - 1.f) * k_a[ch]);
            Bb[t * 64 + c] = a;
        }
        __syncthreads();
        for (int t = wave; t < n; t += 8) {
            const float x = KK[t * 64 + lane];
            const float nrm = fmaxf(sqrtf(wave_sum(x * x)), 1e-12f);
            const float kkn = x / nrm;
            KK[t * 64 + lane] = kkn; Bb[t * 64 + lane] = kkn * Bb[t * 64 + lane];
        }
        __syncthreads();
        for (int t = 0; t < n; ++t) {
            const f32x4 kk0 = *(LAS f32x4*)(KK + t * 64 + kq * 8), kk1 = *(LAS f32x4*)(KK + t * 64 + kq * 8 + 4);
            const f32x4 w0v = *(LAS f32x4*)(Wd + t * 64 + kq * 8), w1v = *(LAS f32x4*)(Wd + t * 64 + kq * 8 + 4);
            const f32x4 b0 = *(LAS f32x4*)(Bb + t * 64 + kq * 8), b1 = *(LAS f32x4*)(Bb + t * 64 + kq * 8 + 4);
            const f32x4 k0 = *(LAS f32x4*)(Kk + t * 64 + kq * 8), k1 = *(LAS f32x4*)(Kk + t * 64 + kq * 8 + 4);
            const f32x4 r0 = *(LAS f32x4*)(Rr + t * 64 + kq * 8), r1 = *(LAS f32x4*)(Rr + t * 64 + kq * 8 + 4);
            const float vv = Vv[t * 64 + v];
            float sa = 0.f;
#pragma unroll
            for (int e = 0; e < 4; ++e) { sa += s[e] * kk0[e]; sa += s[4 + e] * kk1[e]; }
            sa = -sum8(sa);
            float y = 0.f;
#pragma unroll
            for (int e = 0; e < 4; ++e) {
                s[e] = s[e] * w0v[e] + sa * b0[e] + vv * k0[e];
                s[4 + e] = s[4 + e] * w1v[e] + sa * b1[e] + vv * k1[e];
                y += s[e] * r0[e]; y += s[4 + e] * r1[e];
            }
            y = sum8(y);
            if (kq == 0) Yb[t * 64 + v] = y;
        }
        __syncthreads();
        for (int t = wave; t < n; t += 8) {
            const int ch = h * 64 + lane;
            const float y = Yb[t * 64 + lane];
            const float mean = wave_sum(y) * (1.f / 64.f);
            const float d = y - mean;
            const float var = wave_sum(d * d) * (1.f / 64.f);
            const float yn = d * rsqrtf(var + 64e-5f) * lnx_g[ch] + lnx_b[ch];
            const float bonus = wave_sum(Rr[t * 64 + lane] * Kk[t * 64 + lane] * r_k[ch]) * Vv[t * 64 + lane];
            const size_t oo = (row0 + c0 + t) * DM + 384 + ch;
            P.OG[oo] = f2bf((yn + bonus) * bf2f(P.Gb[oo]));
        }
        __syncthreads();
    }
    if (sample) {
        float* so = P.out + O_ST_S + (((size_t)bb * 6 + h) * 64 + v) * 64 + kq * 8;
#pragma unroll
        for (int e = 0; e < 8; ++e) so[e] = s[e];
    }
    __syncthreads();
}

constexpr int NCH = SEQ / 64, N_L_ITEMS = NB * 6 * NCH;
constexpr size_t WS_MF = WS_END;
constexpr size_t WS_NF = WS_MF + (size_t)N_L_ITEMS * 8192;
constexpr size_t WS_QF = WS_NF + (size_t)N_L_ITEMS * 16384;
constexpr size_t WS_YF = WS_QF + (size_t)N_L_ITEMS * 8192;
constexpr size_t WS_SF = WS_YF + (size_t)N_L_ITEMS * 16384;
constexpr size_t WS_RHO = WS_SF + (size_t)N_L_ITEMS * 8192;
constexpr size_t WS_END2 = al256(WS_RHO + (size_t)N_L_ITEMS * 256);
constexpr int TS = 144;
constexpr int FS = 272;
#define MFMA32(a, b, c) __builtin_amdgcn_mfma_f32_32x32x16_bf16((a), (b), (c), 0, 0, 0)
__device__ __forceinline__ bf16x8 rowfrag(LAS const unsigned char* tile, int row, int s, int h) { return *(LAS const bf16x8*)(tile + row * TS + (16 * s + 8 * h) * 2); }
__device__ __forceinline__ bf16x8 colfrag(LAS const unsigned char* tile, int f0, int s, int lane) {
    LAS const unsigned char* p = tile + (16 * s + 8 * (lane >> 5) + ((lane & 15) >> 2)) * TS + (f0 + 16 * ((lane >> 4) & 1) + 4 * (lane & 3)) * 2;
    const s16x4 lo = vtr(p), hh = vtr(p + 4 * TS);
    return (bf16x8){lo[0], lo[1], lo[2], lo[3], hh[0], hh[1], hh[2], hh[3]};
}
__device__ __forceinline__ f32x16 zero16() { f32x16 z; _Pragma("unroll") for (int r = 0; r < 16; ++r) z[r] = 0.f; return z; }

__device__ __forceinline__ void passL_item(const Params& prm, LAS unsigned char* lds, int item, int tid) {
    const int lane = tid & 63, wave = tid >> 6, hi = lane >> 5, l31 = lane & 31;
    const int seq = item >> 7, c = item & 127, b = seq / 6, h = seq % 6;
    const size_t row0 = (size_t)b * SEQ + 64 * c;
    const float* ZB = (const float*)(prm.ws + WS_ZB);
    LAS unsigned char* F_R = lds; LAS unsigned char* F_K = lds + 17408; LAS unsigned char* F_KK = lds + 34816; LAS unsigned char* F_B = lds + 52224; LAS unsigned char* F_LD = lds + 69632;
    LAS unsigned char* T_TW = lds + 87040; LAS unsigned char* T_AL = lds + 96256; LAS unsigned char* T_W2 = lds + 105472; LAS unsigned char* T_A2 = lds + 114688;
    LAS float* SEG = (LAS float*)(lds + 133120);
    LAS unsigned char* T_V = lds + 135168; LAS float* GCs = (LAS float*)(lds + 144384);
    LAS unsigned char* T_At = lds; LAS unsigned char* T_Bt = lds + 9216; LAS unsigned char* T_Kt = lds + 18432; LAS unsigned char* T_Rt = lds + 27648; LAS unsigned char* T_Bh = lds + 36864; LAS unsigned char* T_Kh = lds + 46080;
    LAS unsigned char* T_Aak = lds + 55296; LAS unsigned char* T_Arb = lds + 64512; LAS unsigned char* T_Ark = lds + 73728;
    LAS unsigned char* ATm = lds + 82944;
    LAS unsigned char* RHST = lds + 100352;
    LAS unsigned char* XsT = lds + 9216;
    {
        const float* mu = prm.in[11];
#pragma unroll
        for (int half = 0; half < 2; ++half) {
            float zv[20], zpv[20];
#pragma unroll
            for (int ti = 0; ti < 4; ++ti)
#pragma unroll
                for (int grp = 0; grp < 5; ++grp) {
                    const int t = wave + 8 * (half * 4 + ti), col = (grp < 3) ? grp * RW + h * 64 + lane : 3 * RW + (grp - 3) * 64 + lane;
                    const size_t row = row0 + t;
                    zv[ti * 5 + grp] = ZB[row * SHIFT_W + col];
                    zpv[ti * 5 + grp] = (c == 0 && t == 0) ? 0.f : ZB[(row - 1) * SHIFT_W + col];
                }
#pragma unroll
            for (int ti = 0; ti < 4; ++ti)
#pragma unroll
                for (int grp = 0; grp < 5; ++grp) {
                    const int t = wave + 8 * (half * 4 + ti), col = (grp < 3) ? grp * RW + h * 64 + lane : 3 * RW + (grp - 3) * 64 + lane;
                    const float zs = zv[ti * 5 + grp] + (zpv[ti * 5 + grp] - zv[ti * 5 + grp]) * mu[col];
                    if (grp == 0) *(LAS float*)(F_R + t * FS + lane * 4) = zs;
                    else if (grp == 1) *(LAS float*)(F_K + t * FS + lane * 4) = zs;
                    else if (grp == 2) *(LAS bf16_t*)(T_V + t * TS + lane * 2) = f2bf(zs);
                    else if (grp == 3) *(LAS bf16_t*)(T_TW + t * TS + lane * 2) = f2bf(tanhf(zs));
                    else *(LAS bf16_t*)(T_AL + t * TS + lane * 2) = f2bf(zs);
                }
        }
        const float* w2 = prm.in[13]; const float* a2 = prm.in[15];
#pragma unroll
        for (int i = 0; i < 8; ++i) { const int e = tid + NTHR * i, jr = e >> 6, cc = e & 63;
            *(LAS bf16_t*)(T_W2 + cc * TS + jr * 2) = f2bf(w2[(size_t)jr * RW + h * 64 + cc]); *(LAS bf16_t*)(T_A2 + cc * TS + jr * 2) = f2bf(a2[(size_t)jr * RW + h * 64 + cc]); }
    }
    __syncthreads();
    if (wave < 4) {
        const int t = 16 * wave + (lane & 15), g = lane >> 4;
        f32x4 accW[4], accA[4];
#pragma unroll
        for (int ct = 0; ct < 4; ++ct) { accW[ct] = (f32x4){0.f, 0.f, 0.f, 0.f}; accA[ct] = accW[ct]; }
#pragma unroll
        for (int ks = 0; ks < 2; ++ks) {
            const bf16x8 bw = *(LAS const bf16x8*)(T_TW + t * TS + (32 * ks + 8 * g) * 2), ba = *(LAS const bf16x8*)(T_AL + t * TS + (32 * ks + 8 * g) * 2);
#pragma unroll
            for (int ct = 0; ct < 4; ++ct) {
                const bf16x8 aw = *(LAS const bf16x8*)(T_W2 + (16 * ct + (lane & 15)) * TS + (32 * ks + 8 * g) * 2), aa = *(LAS const bf16x8*)(T_A2 + (16 * ct + (lane & 15)) * TS + (32 * ks + 8 * g) * 2);
                accW[ct] = __builtin_amdgcn_mfma_f32_16x16x32_bf16(aw, bw, accW[ct], 0, 0, 0);
                accA[ct] = __builtin_amdgcn_mfma_f32_16x16x32_bf16(aa, ba, accA[ct], 0, 0, 0);
            }
        }
        const float* w0 = prm.in[12]; const float* a0 = prm.in[14]; const float* k_k = prm.in[16]; const float* k_a = prm.in[17]; const float* r_k = prm.in[18];
        float ssq = 0.f, rho = 0.f; f32x4 kkv[4], av[4];
#pragma unroll
        for (int ct = 0; ct < 4; ++ct) {
            const int c4 = 16 * ct + 4 * g, ch = h * 64 + c4;
            const f32x4 kraw = *(LAS const f32x4*)(F_K + t * FS + c4 * 4), rr = *(LAS const f32x4*)(F_R + t * FS + c4 * 4);
            const f32x4 w0v = *(const f32x4*)(w0 + ch), a0v = *(const f32x4*)(a0 + ch), kkc = *(const f32x4*)(k_k + ch), kac = *(const f32x4*)(k_a + ch), rkc = *(const f32x4*)(r_k + ch);
            f32x4 ld, kp;
#pragma unroll
            for (int e = 0; e < 4; ++e) {
                const float wv = w0v[e] + accW[ct][e];
                const float w = -softplusf(-wv) - 0.5f;
                ld[e] = -__expf(w);
                const float a = 1.f / (1.f + __expf(-(a0v[e] + accA[ct][e])));
                av[ct][e] = a;
                kkv[ct][e] = kraw[e] * kkc[e];
                kp[e] = kraw[e] * (1.f + (a - 1.f) * kac[e]);
                ssq += kkv[ct][e] * kkv[ct][e];
                rho += rr[e] * kp[e] * rkc[e];
            }
            *(LAS f32x4*)(F_LD + t * FS + c4 * 4) = ld; *(LAS f32x4*)(F_K + t * FS + c4 * 4) = kp;
        }
        ssq += __shfl_xor(ssq, 16); ssq += __shfl_xor(ssq, 32); rho += __shfl_xor(rho, 16); rho += __shfl_xor(rho, 32);
        const float inv = 1.f / fmaxf(sqrtf(ssq), 1e-12f);
#pragma unroll
        for (int ct = 0; ct < 4; ++ct) {
            const int c4 = 16 * ct + 4 * g; f32x4 kk, bb;
#pragma unroll
            for (int e = 0; e < 4; ++e) { kk[e] = kkv[ct][e] * inv; bb[e] = kk[e] * av[ct][e]; }
            *(LAS f32x4*)(F_KK + t * FS + c4 * 4) = kk; *(LAS f32x4*)(F_B + t * FS + c4 * 4) = bb;
        }
        if (g == 0) ((float*)(prm.ws + WS_RHO))[(size_t)item * 64 + t] = rho;
    }
    __syncthreads();
    {
        const int cch = tid & 63, seg = tid >> 6;
        float L[8], kk[8], bb[8], kp[8], rr[8];
        float run = 0.f;
#pragma unroll
        for (int i = 0; i < 8; ++i) { const int t = 8 * seg + i; run += *(LAS const float*)(F_LD + t * FS + cch * 4); L[i] = run;
            kk[i] = *(LAS const float*)(F_KK + t * FS + cch * 4); bb[i] = *(LAS const float*)(F_B + t * FS + cch * 4); kp[i] = *(LAS const float*)(F_K + t * FS + cch * 4); rr[i] = *(LAS const float*)(F_R + t * FS + cch * 4); }
        SEG[seg * 64 + cch] = run;
        __syncthreads();
        float off = 0.f, tot = 0.f;
#pragma unroll
        for (int sgi = 0; sgi < 8; ++sgi) { const float v = SEG[sgi * 64 + cch]; tot += v; if (sgi < seg) off += v; }
        __syncthreads();
        f32x4 at0, at1;
#pragma unroll
        for (int i = 0; i < 8; ++i) {
            const int t = 8 * seg + i;
            const float Lc = off + L[i], Lp = (i == 0) ? off : off + L[i - 1];
            const float ep = __expf(Lp), em = __expf(-Lc), el = __expf(Lc), eh = __expf(tot - Lc);
            const float at = -kk[i] * ep;
            if (i < 4) at0[i] = at; else at1[i - 4] = at;
            *(LAS bf16_t*)(T_At + t * TS + cch * 2) = f2bf(at);
            *(LAS bf16_t*)(T_Bt + t * TS + cch * 2) = f2bf(bb[i] * em);
            *(LAS bf16_t*)(T_Kt + t * TS + cch * 2) = f2bf(kp[i] * em);
            *(LAS bf16_t*)(T_Rt + t * TS + cch * 2) = f2bf(rr[i] * el);
            *(LAS bf16_t*)(T_Bh + t * TS + cch * 2) = f2bf(bb[i] * eh);
            *(LAS bf16_t*)(T_Kh + t * TS + cch * 2) = f2bf(kp[i] * eh);
        }
#pragma unroll
        for (int i = 0; i < 8; ++i) *(LAS float*)(RHST + cch * FS + ((i & 3) * 16 + 2 * seg + (i >> 2)) * 4) = (i < 4) ? at0[i & 3] : at1[i & 3];
        if (seg == 0) GCs[cch] = __expf(tot);
    }
    __syncthreads();
#pragma unroll
    for (int rep = 0; rep < 2; ++rep) {
        const int slot = wave + 8 * rep, prod = slot >> 2, tile = slot & 3;
        if (prod == 0) {
            const int tt = tile >> 1, it = tile & 1;
            if (!(tt == 0 && it == 1)) {
                f32x16 d = zero16();
#pragma unroll
                for (int s4 = 0; s4 < 4; ++s4) d = MFMA32(rowfrag(T_At, 32 * tt + l31, s4, hi), rowfrag(T_Bt, 32 * it + l31, s4, hi), d);
#pragma unroll
                for (int rg = 0; rg < 4; ++rg)
#pragma unroll
                    for (int e = 0; e < 4; ++e) *(LAS float*)(ATm + (32 * it + l31) * FS + (e * 16 + 8 * tt + 2 * rg + hi) * 4) = d[4 * rg + e];
            }
        } else {
            const int it = tile >> 1, tt = tile & 1;
            LAS const unsigned char* TA = (prod == 2) ? T_Bt : T_Kt; LAS const unsigned char* TB = (prod == 1) ? T_At : T_Rt;
            LAS unsigned char* TO = (prod == 1) ? T_Aak : (prod == 2) ? T_Arb : T_Ark;
            f32x16 d = zero16();
            if (!(it == 1 && tt == 0)) {
#pragma unroll
                for (int s4 = 0; s4 < 4; ++s4) d = MFMA32(rowfrag(TA, 32 * it + l31, s4, hi), rowfrag(TB, 32 * tt + l31, s4, hi), d);
            }
            const int tg = 32 * tt + l31;
#pragma unroll
            for (int rg = 0; rg < 4; ++rg) {
                float v4[4];
#pragma unroll
                for (int e = 0; e < 4; ++e) { const int ig = 32 * it + 8 * rg + 4 * hi + e; const bool keep = (prod == 1) ? (ig < tg) : (ig <= tg); v4[e] = keep ? d[4 * rg + e] : 0.f; }
                *(LAS u32x2*)(TO + tg * TS + (32 * it + 8 * rg + 4 * hi) * 2) = (u32x2){cvtpk(v4[0], v4[1]), cvtpk(v4[2], v4[3])};
            }
        }
    }
    __syncthreads();
    if (wave < 4) {
        const int tt = wave >> 1, vt = wave & 1;
        f32x16 d = zero16();
#pragma unroll
        for (int s4 = 0; s4 < 4; ++s4) d = MFMA32(rowfrag(T_Aak, 32 * tt + l31, s4, hi), colfrag(T_V, 32 * vt, s4, lane), d);
#pragma unroll
        for (int rg = 0; rg < 4; ++rg)
#pragma unroll
            for (int e = 0; e < 4; ++e) *(LAS float*)(RHST + (64 + 32 * vt + l31) * FS + (e * 16 + 8 * tt + 2 * rg + hi) * 4) = d[4 * rg + e];
    }
    __syncthreads();
    {
        const int col = tid >> 2, j = tid & 3;
        float acc[16];
#pragma unroll
        for (int q = 0; q < 4; ++q) { const f32x4 v = *(LAS const f32x4*)(RHST + col * FS + (j * 16 + 4 * q) * 4); acc[4 * q] = v[0]; acc[4 * q + 1] = v[1]; acc[4 * q + 2] = v[2]; acc[4 * q + 3] = v[3]; }
        LAS const unsigned char* atp = ATm + j * 64;
#pragma clang loop unroll(full)
        for (int i = 0; i < 63; ++i) {
            const int jo = i & 3, mo = i >> 2;
            const float x = (jo == 0) ? dpp_f<0x00>(acc[mo]) : (jo == 1) ? dpp_f<0x55>(acc[mo]) : (jo == 2) ? dpp_f<0xAA>(acc[mo]) : dpp_f<0xFF>(acc[mo]);
#pragma unroll
            for (int q = mo / 4; q < 4; ++q) {
                const f32x4 a4 = *(LAS const f32x4*)(atp + i * FS + q * 16);
#pragma unroll
                for (int e = 0; e < 4; ++e) { const int m = 4 * q + e;
                    if (m > mo) acc[m] += a4[e] * x;
                    else if (m == mo) acc[m] += ((j > jo) ? a4[e] : 0.f) * x; }
            }
        }
#pragma unroll
        for (int m = 0; m < 16; ++m) *(LAS bf16_t*)(XsT + col * TS + (4 * m + j) * 2) = f2bf(acc[m]);
    }
    __syncthreads();
    {
        const int tile = wave & 3, ta = tile >> 1, tb = tile & 1;
        if (wave < 4) {
            f32x16 d = zero16();
#pragma unroll
            for (int s4 = 0; s4 < 4; ++s4) d = MFMA32(rowfrag(XsT, 32 * ta + l31, s4, hi), colfrag(T_Bh, 32 * tb, s4, lane), d);
            if (ta == tb) { const float gc = GCs[32 * tb + l31];
#pragma unroll
                for (int r = 0; r < 16; ++r) if (crow(r, hi) == l31) d[r] += gc; }
            u32x4* mf = (u32x4*)(prm.ws + WS_MF + (size_t)item * 8192) + ((ta * 2 + tb) * 2) * 64 + lane;
#pragma unroll
            for (int s2 = 0; s2 < 2; ++s2) mf[s2 * 64] = (u32x4){cvtpk(d[8 * s2], d[8 * s2 + 1]), cvtpk(d[8 * s2 + 2], d[8 * s2 + 3]), cvtpk(d[8 * s2 + 4], d[8 * s2 + 5]), cvtpk(d[8 * s2 + 6], d[8 * s2 + 7])};
            f32x16 n = zero16();
#pragma unroll
            for (int s4 = 0; s4 < 4; ++s4) n = MFMA32(colfrag(T_Bh, 32 * ta, s4, lane), rowfrag(XsT, 64 + 32 * tb + l31, s4, hi), n);
#pragma unroll
            for (int s4 = 0; s4 < 4; ++s4) n = MFMA32(colfrag(T_Kh, 32 * ta, s4, lane), colfrag(T_V, 32 * tb, s4, lane), n);
            f32x4* nf = (f32x4*)(prm.ws + WS_NF + (size_t)item * 16384) + ((tb * 2 + ta) * 64 + lane) * 4;
#pragma unroll
            for (int rg = 0; rg < 4; ++rg) nf[rg] = (f32x4){n[4 * rg], n[4 * rg + 1], n[4 * rg + 2], n[4 * rg + 3]};
        } else {
            f32x16 d;
#pragma unroll
            for (int rg = 0; rg < 4; ++rg) { const u32x2 w = *(LAS const u32x2*)(T_Rt + (32 * tb + l31) * TS + (32 * ta + 8 * rg + 4 * hi) * 2);
                d[4 * rg] = bflo(w[0]); d[4 * rg + 1] = bfhi(w[0]); d[4 * rg + 2] = bflo(w[1]); d[4 * rg + 3] = bfhi(w[1]); }
#pragma unroll
            for (int s4 = 0; s4 < 4; ++s4) d = MFMA32(rowfrag(XsT, 32 * ta + l31, s4, hi), rowfrag(T_Arb, 32 * tb + l31, s4, hi), d);
            u32x4* qf = (u32x4*)(prm.ws + WS_QF + (size_t)item * 8192) + ((ta * 2 + tb) * 2) * 64 + lane;
#pragma unroll
            for (int s2 = 0; s2 < 2; ++s2) qf[s2 * 64] = (u32x4){cvtpk(d[8 * s2], d[8 * s2 + 1]), cvtpk(d[8 * s2 + 2], d[8 * s2 + 3]), cvtpk(d[8 * s2 + 4], d[8 * s2 + 5]), cvtpk(d[8 * s2 + 6], d[8 * s2 + 7])};
            f32x16 y = zero16();
#pragma unroll
            for (int s4 = 0; s4 < 4; ++s4) y = MFMA32(rowfrag(XsT, 64 + 32 * ta + l31, s4, hi), rowfrag(T_Arb, 32 * tb + l31, s4, hi), y);
#pragma unroll
            for (int s4 = 0; s4 < 4; ++s4) y = MFMA32(colfrag(T_V, 32 * ta, s4, lane), rowfrag(T_Ark, 32 * tb + l31, s4, hi), y);
            f32x4* yf = (f32x4*)(prm.ws + WS_YF + (size_t)item * 16384) + ((ta * 2 + tb) * 64 + lane) * 4;
#pragma unroll
            for (int rg = 0; rg < 4; ++rg) yf[rg] = (f32x4){y[4 * rg], y[4 * rg + 1], y[4 * rg + 2], y[4 * rg + 3]};
        }
    }
    __syncthreads();
}

constexpr int N_S_BLOCKS = NB * 6 * 2;
__device__ __forceinline__ void passS_block(const Params& prm, LAS unsigned char* lds, int sblk, int tid) {
    const int lane = tid & 63, wave = tid >> 6;
    const int seq = sblk >> 1, vh = sblk & 1;
    const size_t item0 = (size_t)seq * NCH;
    const int ltid = tid - 64;
    const unsigned char* mbase = prm.ws + WS_MF + item0 * 8192;
    const unsigned char* nbase = prm.ws + WS_NF + item0 * 16384 + (size_t)vh * 8192;
    u32x4 hold[8][3];
#define PS_SRC(chunk, piece) (((piece) < 512) ? (const u32x4*)(mbase + (size_t)(chunk) * 8192) + (piece) : (const u32x4*)(nbase + (size_t)(chunk) * 16384) + ((piece) - 512))
#define PS_ISSUE(chunk, buf) do { if ((chunk) < NCH) { hold[buf][0] = *PS_SRC(chunk, ltid); hold[buf][1] = *PS_SRC(chunk, ltid + 448); if (ltid < 128) hold[buf][2] = *PS_SRC(chunk, ltid + 896); } } while (0)
#define PS_COMMIT(chunk, buf) do { if ((chunk) < NCH) { LAS unsigned char* slot_ = lds + ((chunk) & 7) * 16384; *(LAS u32x4*)(slot_ + ltid * 16) = hold[buf][0]; *(LAS u32x4*)(slot_ + (ltid + 448) * 16) = hold[buf][1]; \
        if (ltid < 128) *(LAS u32x4*)(slot_ + (ltid + 896) * 16) = hold[buf][2]; } } while (0)
    f32x16 acc[2]; acc[0] = zero16(); acc[1] = zero16();
    if (wave >= 1) {
        PS_ISSUE(0, 0); PS_ISSUE(1, 1); PS_COMMIT(0, 0); PS_COMMIT(1, 1);
        PS_ISSUE(2, 2); PS_ISSUE(3, 3); PS_ISSUE(4, 4); PS_ISSUE(5, 5); PS_ISSUE(6, 6); PS_ISSUE(7, 7); PS_ISSUE(8, 0); PS_ISSUE(9, 1);
    }
    __syncthreads();
    for (int c8 = 0; c8 < NCH; c8 += 8) {
#pragma unroll
        for (int par = 0; par < 8; ++par) {
            const int cc = c8 + par;
            if (wave == 0) {
                LAS const unsigned char* slot = lds + par * 16384;
                bf16x8 xb[2][2];
#pragma unroll
                for (int kt = 0; kt < 2; ++kt)
#pragma unroll
                    for (int s2 = 0; s2 < 2; ++s2) { const u32x4 w = (u32x4){cvtpk(acc[kt][8 * s2], acc[kt][8 * s2 + 1]), cvtpk(acc[kt][8 * s2 + 2], acc[kt][8 * s2 + 3]), cvtpk(acc[kt][8 * s2 + 4], acc[kt][8 * s2 + 5]), cvtpk(acc[kt][8 * s2 + 6], acc[kt][8 * s2 + 7])};
                        xb[kt][s2] = __builtin_bit_cast(bf16x8, w);
                        ((u32x4*)(prm.ws + WS_SF + (item0 + cc) * 8192))[((vh * 2 + kt) * 2 + s2) * 64 + lane] = w; }
                f32x16 nacc[2];
#pragma unroll
                for (int i = 0; i < 2; ++i) {
#pragma unroll
                    for (int rg = 0; rg < 4; ++rg) { const f32x4 v = *(LAS const f32x4*)(slot + 8192 + (i * 64 + lane) * 64 + rg * 16); nacc[i][4 * rg] = v[0]; nacc[i][4 * rg + 1] = v[1]; nacc[i][4 * rg + 2] = v[2]; nacc[i][4 * rg + 3] = v[3]; }
#pragma unroll
                    for (int kt = 0; kt < 2; ++kt)
#pragma unroll
                        for (int s2 = 0; s2 < 2; ++s2) { const bf16x8 mf = *(LAS const bf16x8*)(slot + (((kt * 2 + i) * 2 + s2) * 64 + lane) * 16); nacc[i] = MFMA32(mf, xb[kt][s2], nacc[i]); }
                }
                acc[0] = nacc[0]; acc[1] = nacc[1];
            } else {
                PS_COMMIT(cc + 2, (par + 2) & 7); PS_ISSUE(cc + 10, (par + 2) & 7);
            }
            __syncthreads();
        }
    }
#undef PS_SRC
#undef PS_ISSUE
#undef PS_COMMIT
    if (wave == 0) {
        float* so = prm.out + O_ST_P + ((size_t)seq * 64 + 32 * vh + (lane & 31)) * 64;
#pragma unroll
        for (int kt = 0; kt < 2; ++kt)
#pragma unroll
            for (int rg = 0; rg < 4; ++rg) *(f32x4*)(so + 32 * kt + 8 * rg + 4 * (lane >> 5)) = (f32x4){acc[kt][4 * rg], acc[kt][4 * rg + 1], acc[kt][4 * rg + 2], acc[kt][4 * rg + 3]};
    }
    __syncthreads();
}

__device__ __forceinline__ void passO_pair(const Params& prm, int item, int tt, int lane) {
    const int hi = lane >> 5, l31 = lane & 31;
    const int seq = item >> 7, c = item & 127, b = seq / 6, h = seq % 6;
    const u32x4* sf = (const u32x4*)(prm.ws + WS_SF + (size_t)item * 8192);
    const u32x4* qf = (const u32x4*)(prm.ws + WS_QF + (size_t)item * 8192);
    const f32x4* yf = (const f32x4*)(prm.ws + WS_YF + (size_t)item * 16384);
    bf16x8 qb[2][2];
#pragma unroll
    for (int kt = 0; kt < 2; ++kt)
#pragma unroll
        for (int s2 = 0; s2 < 2; ++s2) qb[kt][s2] = __builtin_bit_cast(bf16x8, qf[((kt * 2 + tt) * 2 + s2) * 64 + lane]);
    f32x16 y[2];
#pragma unroll
    for (int vt = 0; vt < 2; ++vt) {
#pragma unroll
        for (int rg = 0; rg < 4; ++rg) { const f32x4 v = yf[((vt * 2 + tt) * 64 + lane) * 4 + rg]; y[vt][4 * rg] = v[0]; y[vt][4 * rg + 1] = v[1]; y[vt][4 * rg + 2] = v[2]; y[vt][4 * rg + 3] = v[3]; }
#pragma unroll
        for (int kt = 0; kt < 2; ++kt)
#pragma unroll
            for (int s2 = 0; s2 < 2; ++s2) y[vt] = MFMA32(__builtin_bit_cast(bf16x8, sf[((vt * 2 + kt) * 2 + s2) * 64 + lane]), qb[kt][s2], y[vt]);
    }
    float sm = 0.f;
#pragma unroll
    for (int vt = 0; vt < 2; ++vt)
#pragma unroll
        for (int r = 0; r < 16; ++r) sm += y[vt][r];
    sm += __shfl_xor(sm, 32);
    const float mean = sm * (1.f / 64.f);
    float sq = 0.f;
#pragma unroll
    for (int vt = 0; vt < 2; ++vt)
#pragma unroll
        for (int r = 0; r < 16; ++r) { const float d = y[vt][r] - mean; sq += d * d; }
    sq += __shfl_xor(sq, 32);
    const float rstd = rsqrtf(sq * (1.f / 64.f) + 64e-5f);
    const int t = 64 * c + 32 * tt + l31;
    const size_t row = (size_t)b * SEQ + t;
    const float rho = ((const float*)(prm.ws + WS_RHO))[(size_t)item * 64 + 32 * tt + l31];
    const float* ZB = (const float*)(prm.ws + WS_ZB);
    const float* mu = prm.in[11]; const float* lg = prm.in[19]; const float* lb = prm.in[20];
    const bf16_t* Gb = (const bf16_t*)(prm.ws + WS_G); bf16_t* OG = (bf16_t*)(prm.ws + WS_OG);
#pragma unroll
    for (int vt = 0; vt < 2; ++vt)
#pragma unroll
        for (int rg = 0; rg < 4; ++rg) {
            const int v0 = 32 * vt + 8 * rg + 4 * hi, ch = h * 64 + v0;
            const f32x4 z = *(const f32x4*)(ZB + row * SHIFT_W + 2 * RW + ch);
            f32x4 zp = (f32x4){0.f, 0.f, 0.f, 0.f};
            if (t > 0) zp = *(const f32x4*)(ZB + (row - 1) * SHIFT_W + 2 * RW + ch);
            const f32x4 muv = *(const f32x4*)(mu + 2 * RW + ch), gv = *(const f32x4*)(lg + ch), bv = *(const f32x4*)(lb + ch);
            const u32x2 gw = *(const u32x2*)(Gb + row * DM + 384 + ch);
            const float gg[4] = {bflo(gw[0]), bfhi(gw[0]), bflo(gw[1]), bfhi(gw[1])};
            float o[4];
#pragma unroll
            for (int e = 0; e < 4; ++e) { const float vv = z[e] + (zp[e] - z[e]) * muv[e]; o[e] = ((y[vt][4 * rg + e] - mean) * rstd * gv[e] + bv[e] + rho * vv) * gg[e]; }
            *(u32x2*)(OG + row * DM + 384 + ch) = (u32x2){cvtpk(o[0], o[1]), cvtpk(o[2], o[3])};
        }
}

__device__ __forceinline__ void p0_transpose_item(const float* W, const float* gain, int K, int N, bf16_t* WT, int row_off, LAS float* scr, int item, int lane) {
    const int nblk = N / 32, kb = item / nblk, nb = item % nblk, k0 = 64 * kb, n0 = 32 * nb;
#pragma unroll 8
    for (int i = 0; i < 32; ++i) { const int kk = 2 * i + (lane >> 5); const float gk = gain ? gain[k0 + kk] : 1.f; scr[kk * 33 + (lane & 31)] = W[(size_t)(k0 + kk) * N + n0 + (lane & 31)] * gk; }
    LDS_WAIT(); asm volatile("" ::: "memory");
    const int c = lane & 7;
#pragma unroll
    for (int j = 0; j < 4; ++j) { const int n = (lane >> 3) + 8 * j; const LAS float* s = scr + (8 * c) * 33 + n;
        u32x4 o; o[0] = cvtpk(s[0 * 33], s[1 * 33]); o[1] = cvtpk(s[2 * 33], s[3 * 33]); o[2] = cvtpk(s[4 * 33], s[5 * 33]); o[3] = cvtpk(s[6 * 33], s[7 * 33]);
        *(u32x4*)(WT + (size_t)(row_off + n0 + n) * K + k0 + 8 * c) = o; }
    LDS_WAIT(); asm volatile("" ::: "memory");
}
__device__ __forceinline__ void sincos_acc(float angf, float& c, float& s) {
    const double a = (double)angf;
    const double kq = __builtin_rint(a * 0.63661977236758134308);
    const double r = (a - kq * 1.57079632679489655800) - kq * 6.12323399573676603587e-17;
    const double r2 = r * r;
    double sp = -1.0 / 1307674368000.0; sp = sp * r2 + 1.0 / 6227020800.0; sp = sp * r2 - 1.0 / 39916800.0; sp = sp * r2 + 1.0 / 362880.0; sp = sp * r2 - 1.0 / 5040.0; sp = sp * r2 + 1.0 / 120.0; sp = sp * r2 - 1.0 / 6.0; sp = sp * r2 + 1.0; sp *= r;
    double cp = 1.0 / 87178291200.0; cp = cp * r2 - 1.0 / 479001600.0; cp = cp * r2 + 1.0 / 3628800.0; cp = cp * r2 - 1.0 / 40320.0; cp = cp * r2 + 1.0 / 720.0; cp = cp * r2 - 1.0 / 24.0; cp = cp * r2 + 0.5; cp = 1.0 - cp * r2;
    const int qd = ((int)kq) & 3;
    const double sv = (qd == 0) ? sp : (qd == 1) ? cp : (qd == 2) ? -sp : -cp;
    const double cv = (qd == 0) ? cp : (qd == 1) ? -sp : (qd == 2) ? -cp : sp;
    c = (float)cv; s = (float)sv;
}
__device__ __forceinline__ void p0_prologue(const Ptrs& P, LAS unsigned char* lds, int bid, int G, int tid) {
    const int lane = tid & 63, wave = tid >> 6;
    LAS float* scr = (LAS float*)(lds + wave * 16384);
    const int gw = bid * 8 + wave, NGW = G * 8;
    constexpr int I_IN = (DM / 64) * (IN_W / 32), I_MEM = (DM / 64) * (512 / 32), I_OUT = (DM / 64) * (DM / 32);
    for (int it = gw; it < I_IN + I_MEM + I_OUT; it += NGW) {
        int r = it;
        if (r < I_IN) { p0_transpose_item(P.in[10], P.in[9], DM, IN_W, P.WT, 0, scr, r, lane); continue; } r -= I_IN;
        if (r < I_MEM) { p0_transpose_item(P.in[22], P.in[21], DM, 512, P.WT, NPAD, scr, r, lane); continue; } r -= I_MEM;
        p0_transpose_item(P.in[23], nullptr, DM, DM, P.WOT, 0, scr, r, lane);
    }
    const int gt = bid * NTHR + tid, NGT = G * NTHR;
    for (int e = gt; e < (NPAD - IN_W) * DM / 8; e += NGT) *(u32x4*)(P.WT + (size_t)IN_W * DM + (size_t)e * 8) = (u32x4){0u, 0u, 0u, 0u};
    for (int m = gw; m < MROWS; m += NGW) {
        const float* xr = (m < MP) ? P.in[0] + (size_t)m * DM : (m < MTOK) ? P.in[1] + (size_t)(m - MP) * DM : P.in[8] + (size_t)(m - MTOK) * DM;
        f32x4 v[4]; float ss = 0.f;
#pragma unroll
        for (int j = 0; j < 4; ++j) { v[j] = *(const f32x4*)(xr + (size_t)(64 * j + lane) * 4); ss += (v[j][0] * v[j][0] + v[j][1] * v[j][1]) + (v[j][2] * v[j][2] + v[j][3] * v[j][3]); }
        ss = wave_sum(ss);
        if (lane == 0) P.RINV[m] = rsqrtf(ss * (1.f / DM) + 1e-6f);
#pragma unroll
        for (int j = 0; j < 4; ++j) { u32x2 w; w[0] = cvtpk(v[j][0], v[j][1]); w[1] = cvtpk(v[j][2], v[j][3]); *(u32x2*)(P.XB + (size_t)m * DM + (size_t)(64 * j + lane) * 4) = w; }
    }
    for (int e = gt; e < NPOS * 8; e += NGT) {
        const int pos = e >> 3, i = e & 7;
        const float invf[8] = {1.0f, 0.19392274f, 0.03760603f, 0.0072926646f, 0.0014142136f, 0.0002742482f, 5.3182957e-05f, 1.0313385e-05f};
        float fi = invf[0];
#pragma unroll
        for (int k = 1; k < 8; ++k) fi = (i == k) ? invf[k] : fi;
        const float ang = (float)pos * fi; float c, s; sincos_acc(ang, c, s);
        P.ROPE[pos * 16 + i] = c; P.ROPE[pos * 16 + 8 + i] = s;
    }
    for (int e = gt; e < MTOK; e += NGT) P.SS[e] = 0.f;
}

__device__ __forceinline__ void p3_combine(const Ptrs& P, int bid, int G, int tid) {
    const int gt = bid * NTHR + tid, NGT = G * NTHR;
    for (int e = gt; e < MTOK * 48; e += NGT) {
        const int row = e / 48, ch = e % 48, h = ch >> 3;
        const float l0 = P.LSE[((size_t)0 * MTOK + row) * 6 + h], l1 = P.LSE[((size_t)1 * MTOK + row) * 6 + h], l2 = P.LSE[((size_t)2 * MTOK + row) * 6 + h];
        const float mx = fmaxf(l0, fmaxf(l1, l2)); const float e0 = __expf(l0 - mx), e1 = __expf(l1 - mx), e2 = __expf(l2 - mx); const float inv = 1.f / (e0 + e1 + e2);
        const float w0 = e0 * inv, w1 = e1 * inv, w2 = e2 * inv;
        const u32x4 a = *(const u32x4*)(P.OAP + ((size_t)0 * MTOK + row) * ATT_W + ch * 8), b = *(const u32x4*)(P.OAP + ((size_t)1 * MTOK + row) * ATT_W + ch * 8), c = *(const u32x4*)(P.OAP + ((size_t)2 * MTOK + row) * ATT_W + ch * 8);
        const u32x4 gg = *(const u32x4*)(P.Gb + (size_t)row * DM + ch * 8);
        u32x4 o;
#pragma unroll
        for (int k = 0; k < 4; ++k) {
            const float lo = (w0 * bflo(a[k]) + w1 * bflo(b[k]) + w2 * bflo(c[k])) * bflo(gg[k]);
            const float hi = (w0 * bfhi(a[k]) + w1 * bfhi(b[k]) + w2 * bfhi(c[k])) * bfhi(gg[k]);
            o[k] = cvtpk(lo, hi);
        }
        *(u32x4*)(P.OG + (size_t)row * DM + ch * 8) = o;
    }
}

__device__ __forceinline__ void p5_norm(const Ptrs& P, int bid, int G, int tid) {
    const int lane = tid & 63, wave = tid >> 6, gw = bid * 8 + wave, NGW = G * 8;
    const float* gf = P.in[24];
    for (int m = gw; m < MTOK; m += NGW) {
        const float rs = rsqrtf(P.SS[m] * (1.f / DM) + 1e-6f);
        float* yr = P.out + O_Y + (size_t)m * DM;
#pragma unroll
        for (int j = 0; j < 4; ++j) { const size_t c = (size_t)(64 * j + lane) * 4; const f32x4 v = *(const f32x4*)(yr + c); const f32x4 gv = *(const f32x4*)(gf + c); *(f32x4*)(yr + c) = v * rs * gv; }
    }
}

#define XB_TMO      128
#define XB_XCNT(j)  (256  + 64 * (j))
#define XB_XSUB(j)  (1280 + 64 * (j))
#define XB_XGEN(j)  (2304 + 64 * (j))
#define XB_TOP      3328
#define XB_TOPGEN   3392
#define XCD_BAR_WORDS 3456
#define XB_SPIN_CAP (1u << 18)
__device__ __forceinline__ unsigned xb_ld(unsigned* p)              { return __hip_atomic_load(p, __ATOMIC_RELAXED, __HIP_MEMORY_SCOPE_AGENT); }
__device__ __forceinline__ unsigned xb_add(unsigned* p, unsigned v) { return __hip_atomic_fetch_add(p, v, __ATOMIC_RELAXED, __HIP_MEMORY_SCOPE_AGENT); }
__device__ __forceinline__ unsigned xb_xcc_id() { return (unsigned)__builtin_amdgcn_s_getreg((3 << 11) | 20) & 0xFu; }
#define XB_SPIN(cond, bar) do { unsigned _sp = 0; while (cond) { __builtin_amdgcn_s_sleep(1); \
    if ((++_sp & 255u) == 0u) { if (xb_ld(&(bar)[XB_TMO])) break; if (_sp > XB_SPIN_CAP) { atomicAdd(&(bar)[XB_TMO], 1u); break; } } } } while (0)
struct XcdBarrier { unsigned* bar; unsigned x; volatile LAS unsigned* st; };
__device__ __forceinline__ XcdBarrier xcd_barrier_post(unsigned* bar, volatile LAS unsigned* st) {
    XcdBarrier b; b.bar = bar; b.x = xb_xcc_id(); b.st = st;
    if (threadIdx.x == 0) (void)xb_add(&bar[XB_XCNT(b.x)], 1u);
    return b;
}
__device__ __forceinline__ void xcd_barrier_complete(unsigned* bar, unsigned x, unsigned& nloc, unsigned& nx) {
    const unsigned G = gridDim.x * gridDim.y * gridDim.z;
    unsigned sum, cnt, mine, sp = 0u;
    for (;;) {
        sum = 0u; cnt = 0u; mine = 0u;
#pragma unroll
        for (unsigned j = 0; j < 16; ++j) { const unsigned c = xb_ld(&bar[XB_XCNT(j)]); sum += c; cnt += (c > 0u) ? 1u : 0u; mine = (j == x) ? c : mine; }
        if (sum == G) break;
        __builtin_amdgcn_s_sleep(1);
        if ((++sp & 255u) == 0u) { if (xb_ld(&bar[XB_TMO])) break; if (sp > XB_SPIN_CAP) { atomicAdd(&bar[XB_TMO], 1u); break; } }
    }
    nloc = mine > 0u ? mine : 1u; nx = cnt > 0u ? cnt : 1u;
}
__device__ __forceinline__ void xcd_barrier(const XcdBarrier& b) {
    asm volatile("s_waitcnt vmcnt(0)" ::: "memory");
    __syncthreads();
    if (threadIdx.x == 0) {
        unsigned* bar = b.bar;
        __builtin_amdgcn_s_waitcnt(0);
        unsigned nloc = b.st[0], nx = b.st[1];
        if (nloc == 0u) { xcd_barrier_complete(bar, b.x, nloc, nx); b.st[0] = nloc; b.st[1] = nx; }
        const unsigned old = xb_add(&bar[XB_XSUB(b.x)], 1u);
        const unsigned gen = old / nloc;
        if (old + 1u == (gen + 1u) * nloc) {
            __builtin_amdgcn_fence(__ATOMIC_RELEASE, "agent");
            asm volatile("s_waitcnt vmcnt(0)" ::: "memory");
            const unsigned og = xb_add(&bar[XB_TOP], 1u);
            const unsigned tg = og / nx;
            if (og + 1u == (tg + 1u) * nx) xb_add(&bar[XB_TOPGEN], 1u);
            else XB_SPIN(xb_ld(&bar[XB_TOPGEN]) == tg, bar);
            __builtin_amdgcn_fence(__ATOMIC_ACQUIRE, "agent");
            xb_add(&bar[XB_XGEN(b.x)], 1u);
            asm volatile("s_waitcnt vmcnt(0)" ::: "memory");
        } else {
            XB_SPIN(xb_ld(&bar[XB_XGEN(b.x)]) == gen, bar);
            __builtin_amdgcn_fence(__ATOMIC_ACQUIRE, "agent");
            asm volatile("s_waitcnt vmcnt(0)" ::: "memory");
        }
    }
    __syncthreads();
}

__global__ void __launch_bounds__(NTHR, 2) fwd_kernel(Params prm) {
    extern __shared__ __attribute__((aligned(16))) unsigned char lds_raw[];
    LAS unsigned char* lds = (LAS unsigned char*)lds_raw;
    const int tid = threadIdx.x, bid = blockIdx.x, G = gridDim.x;
    Ptrs P;
#pragma unroll
    for (int i = 0; i < 25; ++i) P.in[i] = prm.in[i];
    P.out = prm.out; P.ws = prm.ws;
    P.RINV = (float*)(prm.ws + WS_RINV); P.SS = (float*)(prm.ws + WS_SS); P.ROPE = (float*)(prm.ws + WS_ROPE); P.ZB = (float*)(prm.ws + WS_ZB); P.LSE = (float*)(prm.ws + WS_LSE);
    P.WT = (bf16_t*)(prm.ws + WS_WT); P.WOT = (bf16_t*)(prm.ws + WS_WOT); P.XB = (bf16_t*)(prm.ws + WS_XB); P.Qb = (bf16_t*)(prm.ws + WS_Q); P.Kb = (bf16_t*)(prm.ws + WS_K); P.Vb = (bf16_t*)(prm.ws + WS_V);
    P.QMb = (bf16_t*)(prm.ws + WS_QM); P.Gb = (bf16_t*)(prm.ws + WS_G); P.MKB = (bf16_t*)(prm.ws + WS_MKB); P.MVB = (bf16_t*)(prm.ws + WS_MVB); P.OAP = (bf16_t*)(prm.ws + WS_OAP); P.OG = (bf16_t*)(prm.ws + WS_OG);
    const int lo = prm.ph_lo, hi = prm.ph_hi;
#define IN_PH(k) (lo <= (k) && (k) < hi)
    volatile LAS unsigned* bst = (volatile LAS unsigned*)(lds + LDS_BYTES - 16);
    if (tid < 4) bst[tid] = 0u;
    __syncthreads();
    XcdBarrier xbar; xbar.bar = (unsigned*)(prm.ws + WS_CTL) + 4096; xbar.x = 0; xbar.st = bst;
    if (prm.coop) xbar = xcd_barrier_post((unsigned*)(prm.ws + WS_CTL) + 4096, bst);
#define SEAM(k) do { if (IN_PH(k) && IN_PH((k) + 1)) { if ((k) == 0) cg::this_grid().sync(); else xcd_barrier(xbar); } } while (0)

#ifndef DUP_P0
#define DUP_P0 1
#endif
#ifndef DUP_P1
#define DUP_P1 1
#endif
#ifndef DUP_P4
#define DUP_P4 1
#endif
    if (IN_PH(0)) { for (int rep = 0; rep < DUP_P0; ++rep) p0_prologue(P, lds, bid, G, tid); }
    SEAM(0);
    if (IN_PH(1)) {
        pg8::Gemm g{P.XB, P.WT, MROWS, NWT, DM}; Sched1 S; S.init(G, bid);
        Epi1 E{P.RINV, P.ROPE, P.Qb, P.Kb, P.Vb, P.QMb, P.Gb, P.MKB, P.MVB, P.ZB, P.out};
        for (int rep = 0; rep < DUP_P1; ++rep) pg8::gemm_phase<Epi1, Sched1, true, true>(lds, g, S, E);
    }
    SEAM(1);
#define ITEM_LOOP(LO, HI, B0, GG, CALL) do { int it = (LO) + (((B0) - (LO)) % (GG) + (GG)) % (GG); for (; it < (HI); it += (GG)) { const int li = it - (LO); CALL; } } while (0)
    if (IN_PH(2)) {
        constexpr int N0 = N_L_ITEMS, N1 = N0 + N_SCAN_S;
#ifndef DUP_L
#define DUP_L 1
#endif
#ifndef DUP_SS
#define DUP_SS 1
#endif
#ifndef DUP_S
#define DUP_S 1
#endif
#ifndef DUP_ATT
#define DUP_ATT 1
#endif
#ifndef DUP_MEM
#define DUP_MEM 1
#endif
#ifndef DUP_SDIL
#define DUP_SDIL 1
#endif
#ifndef DUP_SMEM
#define DUP_SMEM 1
#endif
        ITEM_LOOP(0, DUP_L * N0, bid, G, passL_item(prm, lds, li % N_L_ITEMS, tid));
        ITEM_LOOP(0, DUP_SS * N_SCAN_S, bid, G, scan_item(P, lds, true, (li % N_SCAN_S) / 6, li % 6, tid));
    }
    SEAM(2);
    if (IN_PH(3)) {
        if (bid < N_S_BLOCKS) { for (int rep = 0; rep < DUP_S; ++rep) passS_block(prm, lds, bid, tid); }
        else {
            constexpr int N1 = N_DIL_UNITS, N2 = N1 + N_MEMA_UNITS, N3 = N2 + N_SDIL_ITEMS, N4 = N3 + N_SMEM_ITEMS;
            const int b0 = bid - N_S_BLOCKS, gg = G - N_S_BLOCKS;
            ITEM_LOOP(0, DUP_ATT * N1, b0, gg, dil_unit(P, lds, li % N_DIL_UNITS, tid));
            ITEM_LOOP(0, DUP_MEM * N_MEMA_UNITS, b0, gg, mem_unit(P, lds, li % N_MEMA_UNITS, tid));
            ITEM_LOOP(0, DUP_SDIL * N_SDIL_ITEMS, b0, gg, sdil_item(P, lds, li % N_SDIL_ITEMS, tid));
            ITEM_LOOP(0, DUP_SMEM * N_SMEM_ITEMS, b0, gg, smem_item(P, lds, li % N_SMEM_ITEMS, tid));
        }
    }
    SEAM(3);
    if (IN_PH(4)) {
        for (int rep = 0; rep < DUP_P4; ++rep) {
        for (int pr = bid * 8 + (tid >> 6); pr < 2 * N_L_ITEMS; pr += G * 8) passO_pair(prm, pr >> 1, pr & 1, tid & 63);
        p3_combine(P, bid, G, tid); }
    }
    SEAM(4);
    if (IN_PH(5)) {
        pg8::Gemm g{P.OG, P.WOT, MTOK, DM, DM}; pg8::StaticOrder S; S.init(MTOK, DM, G, bid);
        Epi2 E{P.in[0], P.in[1], P.out + O_Y, P.SS};
        pg8::gemm_phase<Epi2, pg8::StaticOrder, true, true>(lds, g, S, E);
    }
    SEAM(5);
    if (IN_PH(6)) { p5_norm(P, bid, G, tid); }
}

constexpr int N_PHASES = 7;
#ifndef MK_ONE_LAUNCH
#define MK_ONE_LAUNCH 1
#endif
extern "C" void kernel_launch(void* const* d_in, const int* in_sizes, int n_in, void* d_out, int out_size, void* d_ws, size_t ws_size, hipStream_t stream) {
    static int grid = 0;
    if (grid == 0) {
        if (n_in != 25 || out_size != (int)O_END || ws_size < WS_END2) { fprintf(stderr, "kernel_launch: unexpected shapes (n_in %d, out %d, ws %zu < %zu)\n", n_in, out_size, ws_size, (size_t)WS_END2); grid = -1; return; }
        int dev = 0, cus = 0, per_cu = 0;
        (void)hipGetDevice(&dev); (void)hipDeviceGetAttribute(&cus, hipDeviceAttributeMultiprocessorCount, dev);
        if (hipFuncSetAttribute((const void*)fwd_kernel, hipFuncAttributeMaxDynamicSharedMemorySize, LDS_BYTES) != hipSuccess) { fprintf(stderr, "kernel_launch: hipFuncSetAttribute failed\n"); grid = -1; return; }
        if (hipOccupancyMaxActiveBlocksPerMultiprocessor(&per_cu, (const void*)fwd_kernel, NTHR, LDS_BYTES) != hipSuccess || per_cu < 1) { fprintf(stderr, "kernel_launch: occupancy query says %d blocks per CU\n", per_cu); (void)hipGetLastError(); per_cu = 1; }
        grid = cus;
    }
    if (grid < 0) return;
    if (hipMemsetAsync((char*)d_ws + WS_CTL, 0, 65536, stream) != hipSuccess) { fprintf(stderr, "kernel_launch: hipMemsetAsync failed\n"); return; }
    Params p{};
    for (int i = 0; i < 25; ++i) p.in[i] = (const float*)d_in[i];
    p.out = (float*)d_out; p.ws = (unsigned char*)d_ws;
#if MK_ONE_LAUNCH
    p.ph_lo = 0; p.ph_hi = N_PHASES; p.coop = 1;
    void* args[] = {&p};
    hipError_t e = hipLaunchCooperativeKernel((const void*)fwd_kernel, dim3(grid), dim3(NTHR), args, LDS_BYTES, stream);
    if (e != hipSuccess) fprintf(stderr, "cooperative launch failed: %s (grid %d)\n", hipGetErrorString(e), grid);
#else
    for (int ph = 0; ph < N_PHASES; ++ph) {
        p.ph_lo = ph; p.ph_hi = ph + 1; p.coop = 0;
        hipLaunchKernelGGL(fwd_kernel, dim3(grid), dim3(NTHR), LDS_BYTES, stream, p);
    }
#endif
}
```

```cpp
#include <hip/hip_runtime.h>
#include <hip/hip_cooperative_groups.h>
#include <cstdio>
#include <cstdint>
namespace cg = cooperative_groups;

#define LAS __attribute__((address_space(3)))
typedef unsigned short bf16_t;
typedef short bf16x8 __attribute__((ext_vector_type(8)));
typedef short s16x4 __attribute__((ext_vector_type(4)));
typedef float f32x4 __attribute__((ext_vector_type(4)));
typedef float f32x2 __attribute__((ext_vector_type(2)));
typedef float f32x16 __attribute__((ext_vector_type(16)));
typedef unsigned u32x4 __attribute__((ext_vector_type(4)));
typedef unsigned u32x2 __attribute__((ext_vector_type(2)));
typedef __bf16 bf16x2_t __attribute__((ext_vector_type(2)));

constexpr int DM = 1024, SEQ = 8192, NB = 2, DB = 32, DT = 8;
constexpr int MP = NB * SEQ;
constexpr int MS = DB * DT;
constexpr int MTOK = MP + MS;
constexpr int NMEM = 256, MMEM = NB * NMEM;
constexpr int MROWS = MTOK + MMEM;
constexpr int ATT_W = 384, RW = 384, MEM_W = 256, SHIFT_W = 1280, IN_W = 3712;
constexpr int NPAD = 3840;
constexpr int NWT = NPAD + 512;
constexpr int WINP = 2048;
constexpr int C_Q = 0, C_K = 384, C_V = 768, C_Z = 1152, C_QM = 2432, C_G = 2688;
constexpr size_t O_Y = 0, O_WK_P = 17039360, O_WV_P = 18612224, O_ST_P = 20185088, O_SH_P = 20234240, O_MK_P = 20236800, O_MV_P = 20367872,
                 O_WK_S = 20498944, O_WV_S = 20597248, O_ST_S = 20695552, O_SH_S = 21481984, O_END = 21522944;
constexpr size_t al256(size_t x) { return (x + 255) & ~(size_t)255; }
constexpr size_t WS_CTL = 0;
constexpr size_t WS_RINV = 1u << 20;
constexpr size_t WS_SS = al256(WS_RINV + (size_t)MROWS * 4);
constexpr size_t WS_ROPE = al256(WS_SS + (size_t)MTOK * 4);
constexpr int NPOS = 8200;
constexpr size_t WS_WT = al256(WS_ROPE + (size_t)NPOS * 16 * 4);
constexpr size_t WS_WOT = al256(WS_WT + (size_t)NWT * DM * 2);
constexpr size_t WS_XB = al256(WS_WOT + (size_t)DM * DM * 2);
constexpr size_t WS_Q = al256(WS_XB + (size_t)MROWS * DM * 2);
constexpr size_t WS_K = al256(WS_Q + (size_t)MTOK * ATT_W * 2);
constexpr size_t WS_V = al256(WS_K + (size_t)MTOK * ATT_W * 2);
constexpr size_t WS_ZB = al256(WS_V + (size_t)MTOK * ATT_W * 2);
constexpr size_t WS_QM = al256(WS_ZB + (size_t)MTOK * SHIFT_W * 4);
constexpr size_t WS_G = al256(WS_QM + (size_t)MTOK * MEM_W * 2);
constexpr size_t WS_MKB = al256(WS_G + (size_t)MTOK * DM * 2);
constexpr size_t WS_MVB = al256(WS_MKB + (size_t)MMEM * MEM_W * 2);
constexpr size_t WS_OAP = al256(WS_MVB + (size_t)MMEM * MEM_W * 2);
constexpr size_t WS_LSE = al256(WS_OAP + (size_t)3 * MTOK * ATT_W * 2);
constexpr size_t WS_OG = al256(WS_LSE + (size_t)3 * MTOK * 6 * 4);
constexpr size_t WS_END = al256(WS_OG + (size_t)MTOK * DM * 2);

constexpr int LDS_BYTES = 147456;
constexpr int NTHR = 512;

struct Params {
    const float* in[25];
    float* out;
    unsigned char* ws;
    int ph_lo, ph_hi, coop, pad;
};

__device__ __forceinline__ unsigned cvtpk(float lo, float hi) { f32x2 v = {lo, hi}; bf16x2_t b = __builtin_convertvector(v, bf16x2_t); return __builtin_bit_cast(unsigned, b); }
__device__ __forceinline__ bf16_t f2bf(float f) { return (bf16_t)(cvtpk(f, 0.f) & 0xffffu); }
__device__ __forceinline__ float bf2f(bf16_t b) { return __builtin_bit_cast(float, (unsigned)b << 16); }
__device__ __forceinline__ float bflo(unsigned w) { return __builtin_bit_cast(float, w << 16); }
__device__ __forceinline__ float bfhi(unsigned w) { return __builtin_bit_cast(float, w & 0xffff0000u); }
__device__ __forceinline__ float wave_sum(float v) {
#pragma unroll
    for (int o = 1; o < 64; o <<= 1) v += __shfl_xor(v, o);
    return v;
}
__device__ __forceinline__ float wave_max(float v) {
#pragma unroll
    for (int o = 1; o < 64; o <<= 1) v = fmaxf(v, __shfl_xor(v, o));
    return v;
}
template <int CTRL> __device__ __forceinline__ float dpp_f(float v) { return __builtin_bit_cast(float, __builtin_amdgcn_update_dpp(0, __builtin_bit_cast(int, v), CTRL, 0xf, 0xf, true)); }
__device__ __forceinline__ float sum8(float v) { v += dpp_f<0xB1>(v); v += dpp_f<0x4E>(v); v += dpp_f<0x141>(v); return v; }
#define LDS_WAIT() asm volatile("s_waitcnt lgkmcnt(0)" ::: "memory")

namespace pg8 {
constexpr int BM = 256, BK = 64, HALF = 128, HTB = HALF * BK * 2, STAGE_BYTES = 8 * HTB, NXCD = 8, WGM = 8;
__host__ __device__ __forceinline__ int lds_byte(int r, int c) { const int st = (r >> 4) * 2 + (c >> 5), rr = r & 15, cc = c & 31, ob = rr * 64 + cc * 2; return st * 1024 + (ob ^ (((ob >> 9) & 1) << 5)); }
__host__ __device__ __forceinline__ void stage_rc(int b, int& R, int& C) { const int st = b / 1024, sb = b % 1024, swz = sb ^ (((sb >> 9) & 1) << 5); R = (st >> 1) * 16 + swz / 64; C = (st & 1) * 32 + (swz % 64) / 2; }
__host__ __device__ __forceinline__ int perm32(int rho) { const int n = rho >> 4, i = rho & 15; return 8 * (i >> 2) + 4 * n + (i & 3); }
struct Unit { int pm, pn; };
struct Gemm { const bf16_t* A; const bf16_t* Bt; int M, N, K; };
struct StaticOrder {
    int nM, nN, nwg, G, c;
    __host__ __device__ void init(int M, int N, int G_, int c_) { nM = M / BM; nN = N / BM; nwg = nM * nN; G = G_; c = c_; }
    __host__ __device__ bool next(int i, Unit& u) const {
        const long L = (long)i * G + c; if (L >= nwg) return false;
        int wgid = (int)L; { const int q = nwg / NXCD, r = nwg % NXCD, xcd = wgid % NXCD, off = wgid / NXCD; wgid = (xcd < r ? xcd * (q + 1) : r * (q + 1) + (xcd - r) * q) + off; }
        const int nig = WGM * nN, gid = wgid / nig, fm = gid * WGM, gsz = (nM - fm) < WGM ? (nM - fm) : WGM;
        u.pm = fm + ((wgid % nig) % gsz); u.pn = (wgid % nig) / gsz; return true;
    }
    __device__ __forceinline__ void a_ready(const Unit&) const {}
    __device__ __forceinline__ void done(const Unit&) const {}
};

template <class Epi, class Sched, bool ALIGN_EPI = false, bool SP2 = false>
__device__ __forceinline__ void gemm_phase(LAS unsigned char* lds, const Gemm g, const Sched& S, const Epi& E) {
    const int tid = threadIdx.x, wid = __builtin_amdgcn_readfirstlane(tid >> 6), lane = tid & 63, wr = wid >> 2, wc = wid & 3, fr = lane & 15, fq = lane >> 4;
    const int K = g.K, nt = K / BK;
    unsigned voffA[2], voffB[2];
#pragma unroll
    for (int i = 0; i < 2; ++i) { int R, C; stage_rc(tid * 16 + i * 8192, R, C); const int Rb = Epi::PERM ? ((R & ~31) + perm32(R & 31)) : R;
        voffA[i] = (unsigned)(R * K + C) * 2u; voffB[i] = (unsigned)(Rb * K + C) * 2u; }
    const size_t kstep = (size_t)(BK * 2);
    const size_t hstep = (size_t)HALF * K * 2;
    const size_t tstep = 2 * hstep;
    const unsigned ldsw = (unsigned)wid * 1024u;
    const int aoff = lds_byte(wr * 64 + fr, fq * 8), boff = lds_byte(wc * 32 + fr, fq * 8);
#define PG8_SA(b, h) (((b) * 2 + (h)) * HTB)
#define PG8_SB(b, h) ((4 + (b) * 2 + (h)) * HTB)
#define PG8_STAGE(bufoff, gbase, voff) do { _Pragma("unroll") for (int _i = 0; _i < 2; ++_i) \
        __builtin_amdgcn_global_load_lds((const unsigned*)((const char*)(gbase) + (voff)[_i]), (LAS unsigned*)(lds + (bufoff) + ldsw + _i * 8192), 16, 0, 0); } while (0)
#define PG8_LDA(dst, b, h) do { _Pragma("unroll") for (int m = 0; m < 4; ++m) _Pragma("unroll") for (int k = 0; k < 2; ++k) dst[m][k] = *(const LAS bf16x8*)(lds + PG8_SA(b, h) + aoff + m * 2048 + k * 1024); } while (0)
#define PG8_LDB(dst, b, h) do { _Pragma("unroll") for (int n = 0; n < 2; ++n) _Pragma("unroll") for (int k = 0; k < 2; ++k) dst[n][k] = *(const LAS bf16x8*)(lds + PG8_SB(b, h) + boff + n * 2048 + k * 1024); } while (0)
#define PG8_MMA(ai, bj, At, Bt) do { __builtin_amdgcn_s_setprio(1); _Pragma("unroll") for (int m = 0; m < 4; ++m) _Pragma("unroll") for (int n = 0; n < 2; ++n) _Pragma("unroll") for (int k = 0; k < 2; ++k) \
        acc[ai][bj][m][n] = __builtin_amdgcn_mfma_f32_16x16x32_bf16(Bt[n][k], At[m][k], acc[ai][bj][m][n], 0, 0, 0); __builtin_amdgcn_s_setprio(0); } while (0)
#define PG8_WAIT_V(n) asm volatile("s_waitcnt vmcnt(" #n ")" ::: "memory")
#define PG8_WAIT_L(n) asm volatile("s_waitcnt lgkmcnt(" #n ")" ::: "memory")
#define PG8_BAR __builtin_amdgcn_s_barrier()
#define PG8_SCHED __builtin_amdgcn_sched_barrier(0)
    Unit cur, nxt; int ui = 0;
    if (!S.next(0, cur)) return;
    f32x4 acc[2][2][4][2];
#pragma unroll
    for (int a = 0; a < 2; ++a)
#pragma unroll
        for (int b = 0; b < 2; ++b)
#pragma unroll
            for (int m = 0; m < 4; ++m)
#pragma unroll
                for (int n = 0; n < 2; ++n) acc[a][b][m][n] = (f32x4){0.f, 0.f, 0.f, 0.f};
    bf16x8 At[4][2], B0[2][2], B1[2][2];
    const char* cA = (const char*)g.A + (size_t)cur.pm * tstep; const char* cB = (const char*)g.Bt + (size_t)cur.pn * tstep;
    S.a_ready(cur);
    if constexpr (SP2) {
        PG8_STAGE(PG8_SB(0, 0), cB, voffB); PG8_STAGE(PG8_SB(0, 1), cB + hstep, voffB); PG8_STAGE(PG8_SA(0, 0), cA, voffA); PG8_STAGE(PG8_SA(0, 1), cA + hstep, voffA);
        if (wr == 1) PG8_BAR;
        PG8_WAIT_V(2); PG8_BAR;
        PG8_STAGE(PG8_SB(1, 0), cB + kstep, voffB); PG8_STAGE(PG8_SA(1, 0), cA + kstep, voffA); PG8_STAGE(PG8_SB(1, 1), cB + hstep + kstep, voffB);
        PG8_WAIT_V(6); PG8_BAR;
    } else {
        PG8_STAGE(PG8_SB(0, 0), cB, voffB); PG8_STAGE(PG8_SA(0, 0), cA, voffA); PG8_STAGE(PG8_SB(0, 1), cB + hstep, voffB); PG8_STAGE(PG8_SA(0, 1), cA + hstep, voffA);
        if (wr == 1) PG8_BAR;
        PG8_WAIT_V(4); PG8_BAR;
        PG8_STAGE(PG8_SB(1, 0), cB + kstep, voffB); PG8_STAGE(PG8_SA(1, 0), cA + kstep, voffA); PG8_STAGE(PG8_SB(1, 1), cB + hstep + kstep, voffB);
        PG8_WAIT_V(6); PG8_BAR;
    }
    for (;;) {
        const bool has_next = S.next(ui + 1, nxt);
        const char* nA = has_next ? (const char*)g.A + (size_t)nxt.pm * tstep : cA; const char* nB = has_next ? (const char*)g.Bt + (size_t)nxt.pn * tstep : cB;
        for (int t = 0; t < nt; t += 2) {
            const bool last = (t == nt - 2);
            const char* a1 = cA + (size_t)(t + 1) * kstep;
            const char* a2 = last ? nA : cA + (size_t)(t + 2) * kstep; const char* b2 = last ? nB : cB + (size_t)(t + 2) * kstep;
            const char* a3 = a2 + kstep; const char* b3 = b2 + kstep;
            if (last && has_next) S.a_ready(nxt);
            if constexpr (SP2) {
            PG8_LDB(B0, 0, 0); PG8_LDB(B1, 0, 1); PG8_SCHED; PG8_LDA(At, 0, 0); PG8_STAGE(PG8_SA(1, 1), a1 + hstep, voffA);
            PG8_WAIT_V(8); PG8_WAIT_L(0); PG8_BAR; PG8_MMA(0, 0, At, B0); PG8_MMA(0, 1, At, B1); PG8_BAR; PG8_SCHED;
            PG8_LDA(At, 0, 1); PG8_STAGE(PG8_SB(0, 0), b2, voffB); PG8_STAGE(PG8_SB(0, 1), b2 + hstep, voffB); PG8_STAGE(PG8_SA(0, 0), a2, voffA);
            PG8_WAIT_V(8); PG8_WAIT_L(0); PG8_BAR; PG8_MMA(1, 0, At, B0); PG8_MMA(1, 1, At, B1); PG8_BAR; PG8_SCHED;
            PG8_LDB(B0, 1, 0); PG8_LDB(B1, 1, 1); PG8_SCHED; PG8_LDA(At, 1, 0); PG8_STAGE(PG8_SA(0, 1), a2 + hstep, voffA);
            PG8_WAIT_V(8); PG8_WAIT_L(0); PG8_BAR; PG8_MMA(0, 0, At, B0); PG8_MMA(0, 1, At, B1); PG8_BAR; PG8_SCHED;
            PG8_LDA(At, 1, 1); PG8_STAGE(PG8_SB(1, 0), b3, voffB); PG8_STAGE(PG8_SB(1, 1), b3 + hstep, voffB); PG8_STAGE(PG8_SA(1, 0), a3, voffA);
            PG8_WAIT_V(8); PG8_WAIT_L(0); PG8_BAR; PG8_MMA(1, 0, At, B0); PG8_MMA(1, 1, At, B1); PG8_BAR; PG8_SCHED;
            } else {
            PG8_LDB(B0, 0, 0); PG8_SCHED; PG8_LDA(At, 0, 0); PG8_STAGE(PG8_SA(1, 1), a1 + hstep, voffA);
            PG8_WAIT_L(8); PG8_BAR; PG8_WAIT_L(0); PG8_MMA(0, 0, At, B0); PG8_BAR; PG8_SCHED;
            PG8_LDB(B1, 0, 1); PG8_STAGE(PG8_SB(0, 0), b2, voffB);
            PG8_BAR; PG8_WAIT_L(0); PG8_MMA(0, 1, At, B1); PG8_BAR;
            PG8_LDA(At, 0, 1); PG8_STAGE(PG8_SA(0, 0), a2, voffA);
            PG8_BAR; PG8_WAIT_L(0); PG8_MMA(1, 0, At, B0); PG8_BAR; PG8_SCHED;
            PG8_STAGE(PG8_SB(0, 1), b2 + hstep, voffB);
            PG8_WAIT_V(6); PG8_BAR; PG8_MMA(1, 1, At, B1); PG8_BAR;
            PG8_LDB(B0, 1, 0); PG8_SCHED; PG8_LDA(At, 1, 0); PG8_STAGE(PG8_SA(0, 1), a2 + hstep, voffA);
            PG8_WAIT_L(8); PG8_BAR; PG8_WAIT_L(0); PG8_MMA(0, 0, At, B0); PG8_BAR; PG8_SCHED;
            PG8_LDB(B1, 1, 1); PG8_STAGE(PG8_SB(1, 0), b3, voffB);
            PG8_BAR; PG8_WAIT_L(0); PG8_MMA(0, 1, At, B1); PG8_BAR;
            PG8_LDA(At, 1, 1); PG8_STAGE(PG8_SA(1, 0), a3, voffA);
            PG8_BAR; PG8_WAIT_L(0); PG8_MMA(1, 0, At, B0); PG8_BAR; PG8_SCHED;
            PG8_STAGE(PG8_SB(1, 1), b3 + hstep, voffB);
            PG8_WAIT_V(6); PG8_BAR; PG8_MMA(1, 1, At, B1); PG8_BAR;
            }
        }
        if constexpr (ALIGN_EPI) { if (wr == 0) PG8_BAR; }
        if constexpr (!Epi::AFTER_DRAIN) { E(acc, cur, wr, wc, fr, fq); S.done(cur); }
        if (!has_next) break;
#pragma unroll
        for (int a = 0; a < 2; ++a)
#pragma unroll
            for (int b = 0; b < 2; ++b)
#pragma unroll
                for (int m = 0; m < 4; ++m)
#pragma unroll
                    for (int n = 0; n < 2; ++n) acc[a][b][m][n] = (f32x4){0.f, 0.f, 0.f, 0.f};
        cur = nxt; cA = nA; cB = nB; ++ui;
        if constexpr (ALIGN_EPI) { if (wr == 1) PG8_BAR; }
    }
    PG8_WAIT_V(0);
    if constexpr (!ALIGN_EPI) { if (wr == 0) PG8_BAR; }
    PG8_BAR;
    if constexpr (Epi::AFTER_DRAIN) { E.fused(acc, cur, wr, wc, fr, fq, lds, wid, lane); S.done(cur); }
#undef PG8_SA
#undef PG8_SB
#undef PG8_STAGE
#undef PG8_LDA
#undef PG8_LDB
#undef PG8_MMA
#undef PG8_WAIT_V
#undef PG8_WAIT_L
#undef PG8_BAR
#undef PG8_SCHED
}
}

constexpr int G1_NM = MTOK / 256, G1_NN = NPAD / 256, G1_MAIN = G1_NM * G1_NN, G1_UNITS = G1_MAIN + 4;
struct Sched1 {
    pg8::StaticOrder so;
    __device__ void init(int G, int c) { so.init(MTOK, NPAD, G, c); }
    __device__ bool next(int i, pg8::Unit& u) const {
        const long L = (long)i * so.G + so.c;
        if (L >= G1_UNITS) return false;
        if (L >= G1_MAIN) { const int e = (int)L - G1_MAIN; u.pm = G1_NM + (e >> 1); u.pn = G1_NN + (e & 1); return true; }
        return so.next(i, u);
    }
    __device__ __forceinline__ void a_ready(const pg8::Unit&) const {}
    __device__ __forceinline__ void done(const pg8::Unit&) const {}
};

struct Epi1 {
    static constexpr bool PERM = true, AFTER_DRAIN = false;
    const float* rinv; const float* rope; bf16_t *Qb, *Kb, *Vb, *QMb, *Gb, *MKB, *MVB; float* ZB; float* out;
    __device__ __forceinline__ void operator()(const f32x4 (&acc)[2][2][4][2], const pg8::Unit& u, int wr, int wc, int fr, int fq) const {
        const bool memu = u.pm >= G1_NM;
#pragma unroll
        for (int ai = 0; ai < 2; ++ai)
#pragma unroll
            for (int m = 0; m < 4; ++m) {
                const int row = u.pm * 256 + ai * 128 + wr * 64 + m * 16 + fr;
                const float rs = rinv[row];
#pragma unroll
                for (int bj = 0; bj < 2; ++bj) {
                    const int c0 = u.pn * 256 + bj * 128 + wc * 32 + 8 * fq;
                    float v[8];
#pragma unroll
                    for (int e = 0; e < 4; ++e) { v[e] = acc[ai][bj][m][0][e] * rs; v[4 + e] = acc[ai][bj][m][1][e] * rs; }
                    if (memu) {
                        const int mrow = row - MTOK, mc = c0 - NPAD;
                        float* of = out + (mc < 256 ? O_MK_P : O_MV_P) + (size_t)mrow * 256 + (mc & 255);
                        *(f32x4*)of = (f32x4){v[0], v[1], v[2], v[3]}; *(f32x4*)(of + 4) = (f32x4){v[4], v[5], v[6], v[7]};
                        bf16_t* ob = (mc < 256 ? MKB : MVB) + (size_t)mrow * 256 + (mc & 255);
                        *(u32x4*)ob = (u32x4){cvtpk(v[0], v[1]), cvtpk(v[2], v[3]), cvtpk(v[4], v[5]), cvtpk(v[6], v[7])};
                        continue;
                    }
                    const int cb = c0 >> 7;
                    const bool samp = row >= MP;
                    const int srow = row - MP;
                    if (cb < 6) {
                        if ((wc & 1) == 0) {
                            float pr[8];
#pragma unroll
                            for (int e = 0; e < 8; ++e) pr[e] = __shfl_xor(v[e], 16);
                            if (fq < 2) {
                                const int pos = samp ? (SEQ + (srow & 7)) : (row & (SEQ - 1));
                                const f32x4 c0v = *(const f32x4*)(rope + (size_t)pos * 16), c1v = *(const f32x4*)(rope + (size_t)pos * 16 + 4);
                                const f32x4 s0v = *(const f32x4*)(rope + (size_t)pos * 16 + 8), s1v = *(const f32x4*)(rope + (size_t)pos * 16 + 12);
                                const float cs[8] = {c0v[0], c0v[1], c0v[2], c0v[3], c1v[0], c1v[1], c1v[2], c1v[3]};
                                const float sn[8] = {s0v[0], s0v[1], s0v[2], s0v[3], s1v[0], s1v[1], s1v[2], s1v[3]};
                                const float sg = (fq == 0) ? -1.f : 1.f;
#pragma unroll
                                for (int e = 0; e < 8; ++e) v[e] = v[e] * cs[e] + sg * pr[e] * sn[e];
                            }
                        }
                        if (cb < 3) {
#pragma unroll
                            for (int e = 0; e < 8; ++e) v[e] *= 0.125f;
                            *(u32x4*)(Qb + (size_t)row * ATT_W + c0) = (u32x4){cvtpk(v[0], v[1]), cvtpk(v[2], v[3]), cvtpk(v[4], v[5]), cvtpk(v[6], v[7])};
                        } else {
                            const int cc = c0 - C_K;
                            *(u32x4*)(Kb + (size_t)row * ATT_W + cc) = (u32x4){cvtpk(v[0], v[1]), cvtpk(v[2], v[3]), cvtpk(v[4], v[5]), cvtpk(v[6], v[7])};
                            float* of = nullptr;
                            if (samp) of = out + O_WK_S + (size_t)srow * ATT_W + cc;
                            else { const int t = row & (SEQ - 1); if (t >= SEQ - WINP) of = out + O_WK_P + ((size_t)(row >> 13) * WINP + (t - (SEQ - WINP))) * ATT_W + cc; }
                            if (of) { *(f32x4*)of = (f32x4){v[0], v[1], v[2], v[3]}; *(f32x4*)(of + 4) = (f32x4){v[4], v[5], v[6], v[7]}; }
                        }
                    } else if (cb < 9) {
                        const int cc = c0 - C_V;
                        *(u32x4*)(Vb + (size_t)row * ATT_W + cc) = (u32x4){cvtpk(v[0], v[1]), cvtpk(v[2], v[3]), cvtpk(v[4], v[5]), cvtpk(v[6], v[7])};
                        float* of = nullptr;
                        if (samp) of = out + O_WV_S + (size_t)srow * ATT_W + cc;
                        else { const int t = row & (SEQ - 1); if (t >= SEQ - WINP) of = out + O_WV_P + ((size_t)(row >> 13) * WINP + (t - (SEQ - WINP))) * ATT_W + cc; }
                        if (of) { *(f32x4*)of = (f32x4){v[0], v[1], v[2], v[3]}; *(f32x4*)(of + 4) = (f32x4){v[4], v[5], v[6], v[7]}; }
                    } else if (cb < 19) {
                        const int cc = c0 - C_Z;
                        float* zf = ZB + (size_t)row * SHIFT_W + cc;
                        *(f32x4*)zf = (f32x4){v[0], v[1], v[2], v[3]}; *(f32x4*)(zf + 4) = (f32x4){v[4], v[5], v[6], v[7]};
                        float* of = nullptr;
                        if (samp) { if ((srow & 7) == 7) of = out + O_SH_S + (size_t)(srow >> 3) * SHIFT_W + cc; }
                        else if ((row & (SEQ - 1)) == SEQ - 1) of = out + O_SH_P + (size_t)(row >> 13) * SHIFT_W + cc;
                        if (of) { *(f32x4*)of = (f32x4){v[0], v[1], v[2], v[3]}; *(f32x4*)(of + 4) = (f32x4){v[4], v[5], v[6], v[7]}; }
                    } else if (cb < 21) {
                        const int cc = c0 - C_QM;
#pragma unroll
                        for (int e = 0; e < 8; ++e) v[e] *= 0.125f;
                        *(u32x4*)(QMb + (size_t)row * MEM_W + cc) = (u32x4){cvtpk(v[0], v[1]), cvtpk(v[2], v[3]), cvtpk(v[4], v[5]), cvtpk(v[6], v[7])};
                    } else if (cb < 29) {
                        const int cc = c0 - C_G;
#pragma unroll
                        for (int e = 0; e < 8; ++e) v[e] = v[e] / (1.f + __expf(-v[e]));
                        *(u32x4*)(Gb + (size_t)row * DM + cc) = (u32x4){cvtpk(v[0], v[1]), cvtpk(v[2], v[3]), cvtpk(v[4], v[5]), cvtpk(v[6], v[7])};
                    }
                }
            }
    }
};

struct Epi2 {
    static constexpr bool PERM = false, AFTER_DRAIN = false;
    const float* xp; const float* xs; float* Y; float* SS;
    __device__ __forceinline__ void operator()(const f32x4 (&acc)[2][2][4][2], const pg8::Unit& u, int wr, int wc, int fr, int fq) const {
#pragma unroll
        for (int ai = 0; ai < 2; ++ai)
#pragma unroll
            for (int m = 0; m < 4; ++m) {
                const int row = u.pm * 256 + ai * 128 + wr * 64 + m * 16 + fr;
                const float* xr = (row < MP) ? xp + (size_t)row * DM : xs + (size_t)(row - MP) * DM;
                float ss = 0.f;
#pragma unroll
                for (int bj = 0; bj < 2; ++bj)
#pragma unroll
                    for (int n = 0; n < 2; ++n) {
                        const int c = u.pn * 256 + bj * 128 + wc * 32 + n * 16 + 4 * fq;
                        const f32x4 xv = *(const f32x4*)(xr + c);
                        const f32x4 o = xv + acc[ai][bj][m][n];
                        ss += (o[0] * o[0] + o[1] * o[1]) + (o[2] * o[2] + o[3] * o[3]);
                        *(f32x4*)(Y + (size_t)row * DM + c) = o;
                    }
                ss += __shfl_xor(ss, 16); ss += __shfl_xor(ss, 32);
                if (fq == 0) atomicAdd(SS + row, ss);
            }
    }
};

constexpr int KS = 144, VS = 144;
constexpr float L2E = 1.4426950408889634f;
__device__ __forceinline__ int crow(int r, int hi) { return (r & 3) + 8 * (r >> 2) + 4 * hi; }
typedef short v4i16_t __attribute__((ext_vector_type(4)));
__device__ __forceinline__ s16x4 vtr(LAS const unsigned char* p) { return __builtin_bit_cast(s16x4, __builtin_amdgcn_ds_read_tr16_b64_v4i16((LAS v4i16_t*)p)); }

template <int NTG, int NG, bool BAND>
__device__ __forceinline__ void strip_attn(const bf16x8 (&qf)[4], LAS const unsigned char* Kl, LAS const unsigned char* Vl, int krow0, int lane, int kmin,
                                           f32x16 (&o)[2], float& m_out, float& l_out) {
    const int q = lane & 31, hi = lane >> 5;
    float m_run = -INFINITY, l_run = 0.f;
#pragma unroll
    for (int r = 0; r < 16; ++r) { o[0][r] = 0.f; o[1][r] = 0.f; }
#pragma unroll
    for (int g = 0; g < NG; ++g) {
        f32x16 S[NTG];
#pragma unroll
        for (int t = 0; t < NTG; ++t) {
#pragma unroll
            for (int r = 0; r < 16; ++r) S[t][r] = 0.f;
            LAS const unsigned char* kp = Kl + (size_t)(krow0 + (g * NTG + t) * 32 + q) * KS + hi * 16;
#pragma unroll
            for (int d0 = 0; d0 < 4; ++d0) {
                const bf16x8 kf = *(LAS const bf16x8*)(kp + d0 * 32);
                S[t] = __builtin_amdgcn_mfma_f32_32x32x16_bf16(kf, qf[d0], S[t], 0, 0, 0);
            }
            if (t & 1) __builtin_amdgcn_sched_barrier(0);
        }
        float mx = -INFINITY;
#pragma unroll
        for (int t = 0; t < NTG; ++t)
#pragma unroll
            for (int r = 0; r < 16; ++r) {
                if (BAND) { const int ko = 32 * (g * NTG + t) + crow(r, hi); if (ko < q || ko > q + 128 || ko < kmin) S[t][r] = -INFINITY; }
                mx = fmaxf(mx, S[t][r]);
            }
        mx = fmaxf(mx, __shfl_xor(mx, 32));
        const float m_new = fmaxf(m_run, mx);
        const float alpha = __builtin_amdgcn_exp2f((m_run - m_new) * L2E);
        float ls = 0.f;
#pragma unroll
        for (int t = 0; t < NTG; ++t)
#pragma unroll
            for (int r = 0; r < 16; ++r) { const float p = __builtin_amdgcn_exp2f((S[t][r] - m_new) * L2E); S[t][r] = p; ls += p; }
        ls += __shfl_xor(ls, 32);
        l_run = l_run * alpha + ls; m_run = m_new;
        if (g > 0) {
#pragma unroll
            for (int r = 0; r < 16; ++r) { const float a = __shfl(alpha, crow(r, hi)); o[0][r] *= a; o[1][r] *= a; }
        }
#pragma unroll
        for (int t = 0; t < NTG; ++t)
#pragma unroll
            for (int s = 0; s < 2; ++s) {
                u32x4 pw; pw[0] = cvtpk(S[t][8 * s + 0], S[t][8 * s + 1]); pw[1] = cvtpk(S[t][8 * s + 2], S[t][8 * s + 3]);
                pw[2] = cvtpk(S[t][8 * s + 4], S[t][8 * s + 5]); pw[3] = cvtpk(S[t][8 * s + 6], S[t][8 * s + 7]);
                const bf16x8 pa = __builtin_bit_cast(bf16x8, pw);
                const int vrow = krow0 + (g * NTG + t) * 32 + 16 * s + 4 * hi + ((lane & 15) >> 2);
                LAS const unsigned char* vp = Vl + (size_t)vrow * VS + (16 * ((lane >> 4) & 1) + 4 * (lane & 3)) * 2;
#pragma unroll
                for (int dt = 0; dt < 2; ++dt) {
                    const s16x4 lo = vtr(vp + dt * 64), hh = vtr(vp + dt * 64 + 8 * VS);
                    const bf16x8 vb = (bf16x8){lo[0], lo[1], lo[2], lo[3], hh[0], hh[1], hh[2], hh[3]};
                    o[dt] = __builtin_amdgcn_mfma_f32_32x32x16_bf16(pa, vb, o[dt], 0, 0, 0);
                }
            }
    }
    m_out = m_run; l_out = l_run;
}

struct Ptrs {
    const float* in[25]; float* out; unsigned char* ws;
    float *RINV, *SS, *ROPE, *ZB, *LSE;
    bf16_t *WT, *WOT, *XB, *Qb, *Kb, *Vb, *QMb, *Gb, *MKB, *MVB, *OAP, *OG;
};

constexpr int N_DIL_UNITS = NB * 6 * 3 * 32;
constexpr int OSTG = 110592;
__device__ __forceinline__ void o_stage(LAS unsigned char* stg, const f32x16 (&o)[2], float linv, int lane, u32x4 (&outv)[4]) {
    const int hi = lane >> 5, q = lane & 31;
#pragma unroll
    for (int r = 0; r < 16; ++r) {
        const int qq = crow(r, hi); const float li = __shfl(linv, qq);
        *(LAS bf16_t*)(stg + qq * 144 + q * 2) = f2bf(o[0][r] * li); *(LAS bf16_t*)(stg + qq * 144 + (32 + q) * 2) = f2bf(o[1][r] * li);
    }
    LDS_WAIT();
#pragma unroll
    for (int k = 0; k < 4; ++k) { const int idx = lane + 64 * k; outv[k] = *(LAS const u32x4*)(stg + (idx >> 3) * 144 + (idx & 7) * 16); }
}
__device__ __forceinline__ void dil_unit(const Ptrs& P, LAS unsigned char* lds, int unit, int tid) {
    const int lane = tid & 63, wave = tid >> 6;
    const int u32 = unit & 31, x = unit >> 5, di = x % 3, bh = x / 3, b = bh / 6, h = bh % 6;
    const int dil = (di == 0) ? 1 : (di == 1 ? 4 : 16), nb2 = 32 / dil, res = u32 / nb2, j = u32 % nb2;
    LAS unsigned char* Kl = lds; LAS unsigned char* Vl = lds + 384 * KS;
    const int l0 = 256 * j - 128;
    const int q = lane & 31, hi = lane >> 5, lq0 = 256 * j + 32 * wave;
    const size_t tokq = (size_t)b * SEQ + (size_t)(lq0 + q) * dil + res;
    u32x4 kv[6], vv[6];
#pragma unroll
    for (int i = 0; i < 6; ++i) {
        const int e = tid + NTHR * i, row = e >> 3, c = e & 7, l = l0 + row, lc = l < 0 ? 0 : l;
        const size_t off = ((size_t)b * SEQ + (size_t)lc * dil + res) * ATT_W + h * 64 + c * 8;
        kv[i] = *(const u32x4*)(P.Kb + off); vv[i] = *(const u32x4*)(P.Vb + off);
    }
    bf16x8 qf[4];
#pragma unroll
    for (int d0 = 0; d0 < 4; ++d0) qf[d0] = *(const bf16x8*)(P.Qb + tokq * ATT_W + h * 64 + d0 * 16 + hi * 8);
#pragma unroll
    for (int i = 0; i < 6; ++i) {
        const int e = tid + NTHR * i, row = e >> 3, c = e & 7, l = l0 + row;
        if (l < 0) { kv[i] = (u32x4){0u, 0u, 0u, 0u}; vv[i] = kv[i]; }
        *(LAS u32x4*)(Kl + row * KS + c * 16) = kv[i]; *(LAS u32x4*)(Vl + row * VS + c * 16) = vv[i];
    }
    __syncthreads();
    f32x16 o[2]; float mm, ll;
    strip_attn<5, 1, true>(qf, Kl, Vl, 32 * wave, lane, (lq0 < 128) ? 128 - lq0 : 0, o, mm, ll);
    u32x4 ov[4];
    o_stage(lds + OSTG + wave * 4608, o, 1.f / ll, lane, ov);
#pragma unroll
    for (int k = 0; k < 4; ++k) { const int idx = lane + 64 * k, row = idx >> 3, c = idx & 7;
        const size_t tok = (size_t)b * SEQ + (size_t)(lq0 + row) * dil + res;
        *(u32x4*)(P.OAP + ((size_t)di * MTOK + tok) * ATT_W + h * 64 + c * 8) = ov[k]; }
    if (hi == 0) P.LSE[((size_t)di * MTOK + tokq) * 6 + h] = mm + __logf(ll);
    __syncthreads();
}

constexpr int N_MEMA_UNITS = NB * 4 * 32;
__device__ __forceinline__ void mem_unit(const Ptrs& P, LAS unsigned char* lds, int unit, int tid) {
    const int lane = tid & 63, wave = tid >> 6;
    const int jq = unit & 31, bh = unit >> 5, b = bh >> 2, hm = bh & 3;
    LAS unsigned char* Kl = lds; LAS unsigned char* Vl = lds + 256 * KS;
    const int q = lane & 31, hi = lane >> 5;
    const size_t tok0 = (size_t)b * SEQ + 256 * jq + 32 * wave;
    u32x4 kv[4], vv[4];
#pragma unroll
    for (int i = 0; i < 4; ++i) {
        const int e = tid + NTHR * i, row = e >> 3, c = e & 7;
        const size_t off = ((size_t)b * NMEM + row) * MEM_W + hm * 64 + c * 8;
        kv[i] = *(const u32x4*)(P.MKB + off); vv[i] = *(const u32x4*)(P.MVB + off);
    }
    bf16x8 qf[4];
#pragma unroll
    for (int d0 = 0; d0 < 4; ++d0) qf[d0] = *(const bf16x8*)(P.QMb + (tok0 + q) * MEM_W + hm * 64 + d0 * 16 + hi * 8);
    u32x4 gv[4];
#pragma unroll
    for (int k = 0; k < 4; ++k) { const int idx = lane + 64 * k; gv[k] = *(const u32x4*)(P.Gb + (tok0 + (idx >> 3)) * DM + 768 + hm * 64 + (idx & 7) * 8); }
#pragma unroll
    for (int i = 0; i < 4; ++i) { const int e = tid + NTHR * i, row = e >> 3, c = e & 7; *(LAS u32x4*)(Kl + row * KS + c * 16) = kv[i]; *(LAS u32x4*)(Vl + row * VS + c * 16) = vv[i]; }
    __syncthreads();
    f32x16 o[2]; float mm, ll;
    strip_attn<4, 2, false>(qf, Kl, Vl, 0, lane, 0, o, mm, ll);
    u32x4 ov[4];
    o_stage(lds + OSTG + wave * 4608, o, 1.f / ll, lane, ov);
#pragma unroll
    for (int k = 0; k < 4; ++k) { const int idx = lane + 64 * k;
        u32x4 w;
#pragma unroll
        for (int e = 0; e < 4; ++e) w[e] = cvtpk(bflo(ov[k][e]) * bflo(gv[k][e]), bfhi(ov[k][e]) * bfhi(gv[k][e]));
        *(u32x4*)(P.OG + (tok0 + (idx >> 3)) * DM + 768 + hm * 64 + (idx & 7) * 8) = w; }
    __syncthreads();
}

constexpr int N_SDIL_ITEMS = DB * DT * 3;
__device__ __forceinline__ void sdil_item(const Ptrs& P, LAS unsigned char* lds, int item, int tid) {
    const int di = item % 3, qi = item / 3, db = qi >> 3, i = qi & 7, lane = tid & 63, wave = tid >> 6;
    const int dil = (di == 0) ? 1 : (di == 1 ? 4 : 16);
    LAS float* sc = (LAS float*)lds;
    LAS float* stm = sc + 132 * 6;
    LAS float* red = stm + 16;
    const int g = tid / 96, u = tid % 96, hh = u >> 4;
    const size_t srow = (size_t)MP + db * 8 + i;
    const float* ck = P.in[2] + (size_t)db * WINP * ATT_W; const float* cv = P.in[3] + (size_t)db * WINP * ATT_W;
    const float* nk = P.out + O_WK_S + (size_t)db * 8 * ATT_W; const float* nv = P.out + O_WV_S + (size_t)db * 8 * ATT_W;
    f32x4 q4 = (f32x4){0.f, 0.f, 0.f, 0.f};
    if (g < 5) { const u32x2 w = *(const u32x2*)(P.Qb + srow * ATT_W + u * 4); q4 = (f32x4){bflo(w[0]), bfhi(w[0]), bflo(w[1]), bfhi(w[1])}; }
    const int gc = g < 5 ? g : 4;
#pragma unroll
    for (int half = 0; half < 2; ++half) {
        f32x4 kr[13];
#pragma unroll
        for (int k = 0; k < 13; ++k) { int jj = gc + 5 * (13 * half + k); if (jj > 128) jj = 128; const int idx = WINP + i - dil * jj;
            const float* p = (idx >= WINP) ? nk + (size_t)(idx - WINP) * ATT_W : ck + (size_t)idx * ATT_W; kr[k] = *(const f32x4*)(p + u * 4); }
#pragma unroll
        for (int k = 0; k < 13; ++k) { const int jj = g + 5 * (13 * half + k);
            float d = (kr[k][0] * q4[0] + kr[k][1] * q4[1]) + (kr[k][2] * q4[2] + kr[k][3] * q4[3]);
            d += __shfl_xor(d, 1); d += __shfl_xor(d, 2); d += __shfl_xor(d, 4); d += __shfl_xor(d, 8);
            if (g < 5 && jj < 129 && (u & 15) == 0) sc[jj * 6 + hh] = d; }
    }
    __syncthreads();
    if (wave < 6) {
        float v0 = sc[lane * 6 + wave], v1 = sc[(64 + lane) * 6 + wave], v2 = (lane == 0) ? sc[128 * 6 + wave] : -INFINITY;
        const float mx = wave_max(fmaxf(fmaxf(v0, v1), v2));
        v0 = __expf(v0 - mx); v1 = __expf(v1 - mx); v2 = (lane == 0) ? __expf(v2 - mx) : 0.f;
        const float sm = wave_sum(v0 + v1 + v2);
        sc[lane * 6 + wave] = v0; sc[(64 + lane) * 6 + wave] = v1; if (lane == 0) { sc[128 * 6 + wave] = v2; stm[wave] = mx; stm[8 + wave] = sm; }
    }
    __syncthreads();
    {
        f32x4 a = (f32x4){0.f, 0.f, 0.f, 0.f};
#pragma unroll
        for (int half = 0; half < 2; ++half) {
            f32x4 vr[13];
#pragma unroll
            for (int k = 0; k < 13; ++k) { int jj = gc + 5 * (13 * half + k); if (jj > 128) jj = 128; const int idx = WINP + i - dil * jj;
                const float* p = (idx >= WINP) ? nv + (size_t)(idx - WINP) * ATT_W : cv + (size_t)idx * ATT_W; vr[k] = *(const f32x4*)(p + u * 4); }
#pragma unroll
            for (int k = 0; k < 13; ++k) { const int jj = g + 5 * (13 * half + k); const float pw = (g < 5 && jj < 129) ? sc[jj * 6 + hh] : 0.f; a += vr[k] * pw; }
        }
        if (g < 5) *(LAS f32x4*)(red + g * 384 + u * 4) = a;
    }
    __syncthreads();
    if (tid < 96) {
        f32x4 a = *(LAS f32x4*)(red + tid * 4);
#pragma unroll
        for (int k = 1; k < 5; ++k) a += *(LAS f32x4*)(red + k * 384 + tid * 4);
        const float li = 1.f / stm[8 + (tid >> 4)];
        *(u32x2*)(P.OAP + ((size_t)di * MTOK + srow) * ATT_W + tid * 4) = (u32x2){cvtpk(a[0] * li, a[1] * li), cvtpk(a[2] * li, a[3] * li)};
        if ((tid & 15) == 0) P.LSE[((size_t)di * MTOK + srow) * 6 + (tid >> 4)] = stm[tid >> 4] + __logf(stm[8 + (tid >> 4)]);
    }
    __syncthreads();
}

constexpr int N_SMEM_ITEMS = DB * 4;
__device__ __forceinline__ void smem_item(const Ptrs& P, LAS unsigned char* lds, int item, int tid) {
    const int db = item >> 2, hm = item & 3, lane = tid & 63, wave = tid >> 6;
    LAS float* qs = (LAS float*)lds;
    LAS float* sc = qs + 512;
    LAS float* li = sc + 2048;
    { const int qi = tid >> 6, d = tid & 63; qs[tid] = bf2f(P.QMb[((size_t)MP + db * 8 + qi) * MEM_W + hm * 64 + d]); }
    __syncthreads();
    {
        const int m = tid & 255, qh = tid >> 8;
        const float* kr = P.in[6] + (((size_t)db * NMEM + m) * 4 + hm) * 64;
        float d0 = 0.f, d1 = 0.f, d2 = 0.f, d3 = 0.f;
#pragma unroll 4
        for (int c = 0; c < 16; ++c) {
            const f32x4 k4 = *(const f32x4*)(kr + c * 4);
            const f32x4 a0 = *(LAS f32x4*)(qs + (qh * 4 + 0) * 64 + c * 4), a1 = *(LAS f32x4*)(qs + (qh * 4 + 1) * 64 + c * 4), a2 = *(LAS f32x4*)(qs + (qh * 4 + 2) * 64 + c * 4), a3 = *(LAS f32x4*)(qs + (qh * 4 + 3) * 64 + c * 4);
            d0 += (k4[0] * a0[0] + k4[1] * a0[1]) + (k4[2] * a0[2] + k4[3] * a0[3]); d1 += (k4[0] * a1[0] + k4[1] * a1[1]) + (k4[2] * a1[2] + k4[3] * a1[3]);
            d2 += (k4[0] * a2[0] + k4[1] * a2[1]) + (k4[2] * a2[2] + k4[3] * a2[3]); d3 += (k4[0] * a3[0] + k4[1] * a3[1]) + (k4[2] * a3[2] + k4[3] * a3[3]);
        }
        sc[(qh * 4 + 0) * 256 + m] = d0; sc[(qh * 4 + 1) * 256 + m] = d1; sc[(qh * 4 + 2) * 256 + m] = d2; sc[(qh * 4 + 3) * 256 + m] = d3;
    }
    __syncthreads();
    {
        float v[4]; float mx = -INFINITY;
#pragma unroll
        for (int k = 0; k < 4; ++k) { v[k] = sc[wave * 256 + k * 64 + lane]; mx = fmaxf(mx, v[k]); }
        mx = wave_max(mx); float sm = 0.f;
#pragma unroll
        for (int k = 0; k < 4; ++k) { v[k] = __expf(v[k] - mx); sm += v[k]; sc[wave * 256 + k * 64 + lane] = v[k]; }
        sm = wave_sum(sm); if (lane == 0) li[wave] = 1.f / sm;
    }
    __syncthreads();
    {
        const int qi = tid >> 6, d = tid & 63;
        const float* vr = P.in[7] + (((size_t)db * NMEM) * 4 + hm) * 64 + d;
        float a = 0.f;
#pragma unroll 8
        for (int m = 0; m < 256; ++m) a += sc[qi * 256 + m] * vr[(size_t)m * 256];
        const size_t oo = ((size_t)MP + db * 8 + qi) * DM + 768 + hm * 64 + d;
        P.OG[oo] = f2bf(a * li[qi] * bf2f(P.Gb[oo]));
    }
    __syncthreads();
}

constexpr int N_SCAN_P = NB * 6, N_SCAN_S = DB * 6;
constexpr int CH = 32;
__device__ __forceinline__ float softplusf(float x) { return fmaxf(x, 0.f) + log1pf(__expf(-fabsf(x))); }
__device__ __forceinline__ void scan_item(const Ptrs& P, LAS unsigned char* lds, bool sample, int bb, int h, int tid) {
    const int lane = tid & 63, wave = tid >> 6;
    const int T = sample ? DT : SEQ;
    const size_t row0 = sample ? (size_t)MP + bb * DT : (size_t)bb * SEQ;
    LAS float* W2h = (LAS float*)lds;
    LAS float* A2h = W2h + 4096;
    LAS float* Rr = A2h + 4096;
    LAS float* Kk = Rr + CH * 64;
    LAS float* Vv = Kk + CH * 64;
    LAS float* Wd = Vv + CH * 64;
    LAS float* KK = Wd + CH * 64;
    LAS float* Bb = KK + CH * 64;
    LAS float* TW = Bb + CH * 64;
    LAS float* AL = TW + CH * 64;
    LAS float* Yb = AL + CH * 64;
    const float* mu = P.in[11]; const float* w0 = P.in[12]; const float* w2 = P.in[13]; const float* a0 = P.in[14]; const float* a2 = P.in[15];
    const float* k_k = P.in[16]; const float* k_a = P.in[17]; const float* r_k = P.in[18]; const float* lnx_g = P.in[19]; const float* lnx_b = P.in[20];
    for (int e = tid; e < 4096; e += NTHR) { const int jr = e >> 6, c = e & 63; W2h[e] = w2[(size_t)jr * RW + h * 64 + c]; A2h[e] = a2[(size_t)jr * RW + h * 64 + c]; }
    const int v = tid >> 3, kq = tid & 7;
    float s[8];
    if (sample) {
        const float* sp = P.in[4] + (((size_t)bb * 6 + h) * 64 + v) * 64 + kq * 8;
#pragma unroll
        for (int e = 0; e < 8; ++e) s[e] = sp[e];
    } else {
#pragma unroll
        for (int e = 0; e < 8; ++e) s[e] = 0.f;
    }
    const float* shift0 = P.in[5] + (size_t)bb * SHIFT_W;
    __syncthreads();
    for (int c0 = 0; c0 < T; c0 += CH) {
        const int n = (T - c0) < CH ? (T - c0) : CH;
        {
            float zv[20], zpv[20];
#pragma unroll
            for (int ti = 0; ti < 4; ++ti)
#pragma unroll
                for (int grp = 0; grp < 5; ++grp) {
                    const int t = wave + 8 * ti, col = (grp < 3) ? grp * RW + h * 64 + lane : 3 * RW + (grp - 3) * 64 + lane;
                    const size_t row = row0 + c0 + t;
                    float z = 0.f, zp = 0.f;
                    if (t < n) { z = P.ZB[row * SHIFT_W + col]; zp = (c0 + t == 0) ? (sample ? shift0[col] : 0.f) : P.ZB[(row - 1) * SHIFT_W + col]; }
                    zv[ti * 5 + grp] = z; zpv[ti * 5 + grp] = zp;
                }
#pragma unroll
            for (int ti = 0; ti < 4; ++ti)
#pragma unroll
                for (int grp = 0; grp < 5; ++grp) {
                    const int t = wave + 8 * ti, col = (grp < 3) ? grp * RW + h * 64 + lane : 3 * RW + (grp - 3) * 64 + lane;
                    const float zs = zv[ti * 5 + grp] + (zpv[ti * 5 + grp] - zv[ti * 5 + grp]) * mu[col];
                    if (t < n) {
                        if (grp == 0) Rr[t * 64 + lane] = zs; else if (grp == 1) Kk[t * 64 + lane] = zs; else if (grp == 2) Vv[t * 64 + lane] = zs;
                        else if (grp == 3) TW[t * 64 + lane] = tanhf(zs); else AL[t * 64 + lane] = zs;
                    }
                }
        }
        __syncthreads();
        for (int idx = tid; idx < n * 64; idx += NTHR) {
            const int t = idx >> 6, c = idx & 63, ch = h * 64 + c;
            float wv = w0[ch], av = a0[ch];
#pragma unroll 8
            for (int jr = 0; jr < 64; ++jr) { wv += TW[t * 64 + jr] * W2h[jr * 64 + c]; av += AL[t * 64 + jr] * A2h[jr * 64 + c]; }
            const float w = -softplusf(-wv) - 0.5f;
            const float decay = __expf(-__expf(w));
            const float a = 1.f / (1.f + __expf(-av));
            const float kraw = Kk[t * 64 + c];
            Wd[t * 64 + c] = decay;
            KK[t * 64 + c] = kraw * k_k[ch];
            Kk[t * 64 + c] = kraw * (1.f + (a - 1.f) * k_a[ch]);
            Bb[t * 64 + c] = a;
        }
        __syncthreads();
        for (int t = wave; t < n; t += 8) {
            const float x = KK[t * 64 + lane];
            const float nrm = fmaxf(sqrtf(wave_sum(x * x)), 1e-12f);
            const float kkn = x / nrm;
            KK[t * 64 + lane] = kkn; Bb[t * 64 + lane] = kkn * Bb[t * 64 + lane];
        }
        __syncthreads();
        for (int t = 0; t < n; ++t) {
            const f32x4 kk0 = *(LAS f32x4*)(KK + t * 64 + kq * 8), kk1 = *(LAS f32x4*)(KK + t * 64 + kq * 8 + 4);
            const f32x4 w0v = *(LAS f32x4*)(Wd + t * 64 + kq * 8), w1v = *(LAS f32x4*)(Wd + t * 64 + kq * 8 + 4);
            const f32x4 b0 = *(LAS f32x4*)(Bb + t * 64 + kq * 8), b1 = *(LAS f32x4*)(Bb + t * 64 + kq * 8 + 4);
            const f32x4 k0 = *(LAS f32x4*)(Kk + t * 64 + kq * 8), k1 = *(LAS f32x4*)(Kk + t * 64 + kq * 8 + 4);
            const f32x4 r0 = *(LAS f32x4*)(Rr + t * 64 + kq * 8), r1 = *(LAS f32x4*)(Rr + t * 64 + kq * 8 + 4);
            const float vv = Vv[t * 64 + v];
            float sa = 0.f;
#pragma unroll
            for (int e = 0; e < 4; ++e) { sa += s[e] * kk0[e]; sa += s[4 + e] * kk1[e]; }
            sa = -sum8(sa);
            float y = 0.f;
#pragma unroll
            for (int e = 0; e < 4; ++e) {
                s[e] = s[e] * w0v[e] + sa * b0[e] + vv * k0[e];
                s[4 + e] = s[4 + e] * w1v[e] + sa * b1[e] + vv * k1[e];
                y += s[e] * r0[e]; y += s[4 + e] * r1[e];
            }
            y = sum8(y);
            if (kq == 0) Yb[t * 64 + v] = y;
        }
        __syncthreads();
        for (int t = wave; t < n; t += 8) {
            const int ch = h * 64 + lane;
            const float y = Yb[t * 64 + lane];
            const float mean = wave_sum(y) * (1.f / 64.f);
            const float d = y - mean;
            const float var = wave_sum(d * d) * (1.f / 64.f);
            const float yn = d * rsqrtf(var + 64e-5f) * lnx_g[ch] + lnx_b[ch];
            const float bonus = wave_sum(Rr[t * 64 + lane] * Kk[t * 64 + lane] * r_k[ch]) * Vv[t * 64 + lane];
            const size_t oo = (row0 + c0 + t) * DM + 384 + ch;
            P.OG[oo] = f2bf((yn + bonus) * bf2f(P.Gb[oo]));
        }
        __syncthreads();
    }
    if (sample) {
        float* so = P.out + O_ST_S + (((size_t)bb * 6 + h) * 64 + v) * 64 + kq * 8;
#pragma unroll
        for (int e = 0; e < 8; ++e) so[e] = s[e];
    }
    __syncthreads();
}

constexpr int NCH = SEQ / 64, N_L_ITEMS = NB * 6 * NCH;
constexpr size_t WS_MF = WS_END;
constexpr size_t WS_NF = WS_MF + (size_t)N_L_ITEMS * 8192;
constexpr size_t WS_QF = WS_NF + (size_t)N_L_ITEMS * 16384;
constexpr size_t WS_YF = WS_QF + (size_t)N_L_ITEMS * 8192;
constexpr size_t WS_SF = WS_YF + (size_t)N_L_ITEMS * 16384;
constexpr size_t WS_RHO = WS_SF + (size_t)N_L_ITEMS * 8192;
constexpr size_t WS_END2 = al256(WS_RHO + (size_t)N_L_ITEMS * 256);
constexpr int TS = 144;
constexpr int FS = 272;
#define MFMA32(a, b, c) __builtin_amdgcn_mfma_f32_32x32x16_bf16((a), (b), (c), 0, 0, 0)
__device__ __forceinline__ bf16x8 rowfrag(LAS const unsigned char* tile, int row, int s, int h) { return *(LAS const bf16x8*)(tile + row * TS + (16 * s + 8 * h) * 2); }
__device__ __forceinline__ bf16x8 colfrag(LAS const unsigned char* tile, int f0, int s, int lane) {
    LAS const unsigned char* p = tile + (16 * s + 8 * (lane >> 5) + ((lane & 15) >> 2)) * TS + (f0 + 16 * ((lane >> 4) & 1) + 4 * (lane & 3)) * 2;
    const s16x4 lo = vtr(p), hh = vtr(p + 4 * TS);
    return (bf16x8){lo[0], lo[1], lo[2], lo[3], hh[0], hh[1], hh[2], hh[3]};
}
__device__ __forceinline__ f32x16 zero16() { f32x16 z; _Pragma("unroll") for (int r = 0; r < 16; ++r) z[r] = 0.f; return z; }

__device__ __forceinline__ void passL_item(const Params& prm, LAS unsigned char* lds, int item, int tid) {
    const int lane = tid & 63, wave = tid >> 6, hi = lane >> 5, l31 = lane & 31;
    const int seq = item >> 7, c = item & 127, b = seq / 6, h = seq % 6;
    const size_t row0 = (size_t)b * SEQ + 64 * c;
    const float* ZB = (const float*)(prm.ws + WS_ZB);
    LAS unsigned char* F_R = lds; LAS unsigned char* F_K = lds + 17408; LAS unsigned char* F_KK = lds + 34816; LAS unsigned char* F_B = lds + 52224; LAS unsigned char* F_LD = lds + 69632;
    LAS unsigned char* T_TW = lds + 87040; LAS unsigned char* T_AL = lds + 96256; LAS unsigned char* T_W2 = lds + 105472; LAS unsigned char* T_A2 = lds + 114688;
    LAS float* SEG = (LAS float*)(lds + 133120);
    LAS unsigned char* T_V = lds + 135168; LAS float* GCs = (LAS float*)(lds + 144384);
    LAS unsigned char* T_At = lds; LAS unsigned char* T_Bt = lds + 9216; LAS unsigned char* T_Kt = lds + 18432; LAS unsigned char* T_Rt = lds + 27648; LAS unsigned char* T_Bh = lds + 36864; LAS unsigned char* T_Kh = lds + 46080;
    LAS unsigned char* T_Aak = lds + 55296; LAS unsigned char* T_Arb = lds + 64512; LAS unsigned char* T_Ark = lds + 73728;
    LAS unsigned char* ATm = lds + 82944;
    LAS unsigned char* RHST = lds + 100352;
    LAS unsigned char* XsT = lds + 9216;
    {
        const float* mu = prm.in[11];
        const int r32 = tid >> 4, cc4 = tid & 15;
#pragma unroll
        for (int half = 0; half < 2; ++half) {
            const int t = 32 * half + r32; const size_t row = row0 + t;
            f32x4 zv[5], zpv[5];
#pragma unroll
            for (int grp = 0; grp < 5; ++grp) {
                const int col = ((grp < 3) ? grp * RW + h * 64 : 3 * RW + (grp - 3) * 64) + 4 * cc4;
                zv[grp] = *(const f32x4*)(ZB + row * SHIFT_W + col);
                zpv[grp] = (c == 0 && t == 0) ? (f32x4){0.f, 0.f, 0.f, 0.f} : *(const f32x4*)(ZB + (row - 1) * SHIFT_W + col);
            }
#pragma unroll
            for (int grp = 0; grp < 5; ++grp) {
                const int col = ((grp < 3) ? grp * RW + h * 64 : 3 * RW + (grp - 3) * 64) + 4 * cc4;
                const f32x4 muv = *(const f32x4*)(mu + col);
                const f32x4 zs = zv[grp] + (zpv[grp] - zv[grp]) * muv;
                if (grp == 0) *(LAS f32x4*)(F_R + t * FS + cc4 * 16) = zs;
                else if (grp == 1) *(LAS f32x4*)(F_K + t * FS + cc4 * 16) = zs;
                else if (grp == 2) *(LAS u32x2*)(T_V + t * TS + cc4 * 8) = (u32x2){cvtpk(zs[0], zs[1]), cvtpk(zs[2], zs[3])};
                else if (grp == 3) *(LAS u32x2*)(T_TW + t * TS + cc4 * 8) = (u32x2){cvtpk(tanhf(zs[0]), tanhf(zs[1])), cvtpk(tanhf(zs[2]), tanhf(zs[3]))};
                else *(LAS u32x2*)(T_AL + t * TS + cc4 * 8) = (u32x2){cvtpk(zs[0], zs[1]), cvtpk(zs[2], zs[3])};
            }
        }
        const float* w2 = prm.in[13]; const float* a2 = prm.in[15];
#pragma unroll
        for (int i = 0; i < 8; ++i) { const int e = tid + NTHR * i, jr = e >> 6, cc = e & 63;
            *(LAS bf16_t*)(T_W2 + cc * TS + jr * 2) = f2bf(w2[(size_t)jr * RW + h * 64 + cc]); *(LAS bf16_t*)(T_A2 + cc * TS + jr * 2) = f2bf(a2[(size_t)jr * RW + h * 64 + cc]); }
    }
    __syncthreads();
    if (wave < 4) {
        const int t = 16 * wave + (lane & 15), g = lane >> 4;
        f32x4 accW[4], accA[4];
#pragma unroll
        for (int ct = 0; ct < 4; ++ct) { accW[ct] = (f32x4){0.f, 0.f, 0.f, 0.f}; accA[ct] = accW[ct]; }
#pragma unroll
        for (int ks = 0; ks < 2; ++ks) {
            const bf16x8 bw = *(LAS const bf16x8*)(T_TW + t * TS + (32 * ks + 8 * g) * 2), ba = *(LAS const bf16x8*)(T_AL + t * TS + (32 * ks + 8 * g) * 2);
#pragma unroll
            for (int ct = 0; ct < 4; ++ct) {
                const bf16x8 aw = *(LAS const bf16x8*)(T_W2 + (16 * ct + (lane & 15)) * TS + (32 * ks + 8 * g) * 2), aa = *(LAS const bf16x8*)(T_A2 + (16 * ct + (lane & 15)) * TS + (32 * ks + 8 * g) * 2);
                accW[ct] = __builtin_amdgcn_mfma_f32_16x16x32_bf16(aw, bw, accW[ct], 0, 0, 0);
                accA[ct] = __builtin_amdgcn_mfma_f32_16x16x32_bf16(aa, ba, accA[ct], 0, 0, 0);
            }
        }
        const float* w0 = prm.in[12]; const float* a0 = prm.in[14]; const float* k_k = prm.in[16]; const float* k_a = prm.in[17]; const float* r_k = prm.in[18];
        float ssq = 0.f, rho = 0.f; f32x4 kkv[4], av[4];
#pragma unroll
        for (int ct = 0; ct < 4; ++ct) {
            const int c4 = 16 * ct + 4 * g, ch = h * 64 + c4;
            const f32x4 kraw = *(LAS const f32x4*)(F_K + t * FS + c4 * 4), rr = *(LAS const f32x4*)(F_R + t * FS + c4 * 4);
            const f32x4 w0v = *(const f32x4*)(w0 + ch), a0v = *(const f32x4*)(a0 + ch), kkc = *(const f32x4*)(k_k + ch), kac = *(const f32x4*)(k_a + ch), rkc = *(const f32x4*)(r_k + ch);
            f32x4 ld, kp;
#pragma unroll
            for (int e = 0; e < 4; ++e) {
                const float wv = w0v[e] + accW[ct][e];
                const float w = -softplusf(-wv) - 0.5f;
                ld[e] = -__expf(w);
                const float a = 1.f / (1.f + __expf(-(a0v[e] + accA[ct][e])));
                av[ct][e] = a;
                kkv[ct][e] = kraw[e] * kkc[e];
                kp[e] = kraw[e] * (1.f + (a - 1.f) * kac[e]);
                ssq += kkv[ct][e] * kkv[ct][e];
                rho += rr[e] * kp[e] * rkc[e];
            }
            *(LAS f32x4*)(F_LD + t * FS + c4 * 4) = ld; *(LAS f32x4*)(F_K + t * FS + c4 * 4) = kp;
        }
        ssq += __shfl_xor(ssq, 16); ssq += __shfl_xor(ssq, 32); rho += __shfl_xor(rho, 16); rho += __shfl_xor(rho, 32);
        const float inv = 1.f / fmaxf(sqrtf(ssq), 1e-12f);
#pragma unroll
        for (int ct = 0; ct < 4; ++ct) {
            const int c4 = 16 * ct + 4 * g; f32x4 kk, bb;
#pragma unroll
            for (int e = 0; e < 4; ++e) { kk[e] = kkv[ct][e] * inv; bb[e] = kk[e] * av[ct][e]; }
            *(LAS f32x4*)(F_KK + t * FS + c4 * 4) = kk; *(LAS f32x4*)(F_B + t * FS + c4 * 4) = bb;
        }
        if (g == 0) ((float*)(prm.ws + WS_RHO))[(size_t)item * 64 + t] = rho;
    }
    __syncthreads();
    {
        const int cch = tid & 63, seg = tid >> 6;
        float L[8], kk[8], bb[8], kp[8], rr[8];
        float run = 0.f;
#pragma unroll
        for (int i = 0; i < 8; ++i) { const int t = 8 * seg + i; run += *(LAS const float*)(F_LD + t * FS + cch * 4); L[i] = run;
            kk[i] = *(LAS const float*)(F_KK + t * FS + cch * 4); bb[i] = *(LAS const float*)(F_B + t * FS + cch * 4); kp[i] = *(LAS const float*)(F_K + t * FS + cch * 4); rr[i] = *(LAS const float*)(F_R + t * FS + cch * 4); }
        SEG[seg * 64 + cch] = run;
        __syncthreads();
        float off = 0.f, tot = 0.f;
#pragma unroll
        for (int sgi = 0; sgi < 8; ++sgi) { const float v = SEG[sgi * 64 + cch]; tot += v; if (sgi < seg) off += v; }
        __syncthreads();
        f32x4 at0, at1;
#pragma unroll
        for (int i = 0; i < 8; ++i) {
            const int t = 8 * seg + i;
            const float Lc = off + L[i], Lp = (i == 0) ? off : off + L[i - 1];
            const float ep = __expf(Lp), em = __expf(-Lc), el = __expf(Lc), eh = __expf(tot - Lc);
            const float at = -kk[i] * ep;
            if (i < 4) at0[i] = at; else at1[i - 4] = at;
            *(LAS bf16_t*)(T_At + t * TS + cch * 2) = f2bf(at);
            *(LAS bf16_t*)(T_Bt + t * TS + cch * 2) = f2bf(bb[i] * em);
            *(LAS bf16_t*)(T_Kt + t * TS + cch * 2) = f2bf(kp[i] * em);
            *(LAS bf16_t*)(T_Rt + t * TS + cch * 2) = f2bf(rr[i] * el);
            *(LAS bf16_t*)(T_Bh + t * TS + cch * 2) = f2bf(bb[i] * eh);
            *(LAS bf16_t*)(T_Kh + t * TS + cch * 2) = f2bf(kp[i] * eh);
        }
#pragma unroll
        for (int i = 0; i < 8; ++i) *(LAS float*)(RHST + cch * FS + ((i & 3) * 16 + 2 * seg + (i >> 2)) * 4) = (i < 4) ? at0[i & 3] : at1[i & 3];
        if (seg == 0) GCs[cch] = __expf(tot);
    }
    __syncthreads();
#pragma unroll
    for (int rep = 0; rep < 2; ++rep) {
        const int slot = wave + 8 * rep, prod = slot >> 2, tile = slot & 3;
        if (prod == 0) {
            const int tt = tile >> 1, it = tile & 1;
            if (!(tt == 0 && it == 1)) {
                f32x16 d = zero16();
#pragma unroll
                for (int s4 = 0; s4 < 4; ++s4) d = MFMA32(rowfrag(T_At, 32 * tt + l31, s4, hi), rowfrag(T_Bt, 32 * it + l31, s4, hi), d);
#pragma unroll
                for (int rg = 0; rg < 4; ++rg)
#pragma unroll
                    for (int e = 0; e < 4; ++e) *(LAS float*)(ATm + (32 * it + l31) * FS + (e * 16 + 8 * tt + 2 * rg + hi) * 4) = d[4 * rg + e];
            }
        } else {
            const int it = tile >> 1, tt = tile & 1;
            LAS const unsigned char* TA = (prod == 2) ? T_Bt : T_Kt; LAS const unsigned char* TB = (prod == 1) ? T_At : T_Rt;
            LAS unsigned char* TO = (prod == 1) ? T_Aak : (prod == 2) ? T_Arb : T_Ark;
            f32x16 d = zero16();
            if (!(it == 1 && tt == 0)) {
#pragma unroll
                for (int s4 = 0; s4 < 4; ++s4) d = MFMA32(rowfrag(TA, 32 * it + l31, s4, hi), rowfrag(TB, 32 * tt + l31, s4, hi), d);
            }
            const int tg = 32 * tt + l31;
#pragma unroll
            for (int rg = 0; rg < 4; ++rg) {
                float v4[4];
#pragma unroll
                for (int e = 0; e < 4; ++e) { const int ig = 32 * it + 8 * rg + 4 * hi + e; const bool keep = (prod == 1) ? (ig < tg) : (ig <= tg); v4[e] = keep ? d[4 * rg + e] : 0.f; }
                *(LAS u32x2*)(TO + tg * TS + (32 * it + 8 * rg + 4 * hi) * 2) = (u32x2){cvtpk(v4[0], v4[1]), cvtpk(v4[2], v4[3])};
            }
        }
    }
    __syncthreads();
    if (wave < 4) {
        const int tt = wave >> 1, vt = wave & 1;
        f32x16 d = zero16();
#pragma unroll
        for (int s4 = 0; s4 < 4; ++s4) d = MFMA32(rowfrag(T_Aak, 32 * tt + l31, s4, hi), colfrag(T_V, 32 * vt, s4, lane), d);
#pragma unroll
        for (int rg = 0; rg < 4; ++rg)
#pragma unroll
            for (int e = 0; e < 4; ++e) *(LAS float*)(RHST + (64 + 32 * vt + l31) * FS + (e * 16 + 8 * tt + 2 * rg + hi) * 4) = d[4 * rg + e];
    }
    __syncthreads();
    {
        const int col = tid >> 2, j = tid & 3;
        float acc[16];
#pragma unroll
        for (int q = 0; q < 4; ++q) { const f32x4 v = *(LAS const f32x4*)(RHST + col * FS + (j * 16 + 4 * q) * 4); acc[4 * q] = v[0]; acc[4 * q + 1] = v[1]; acc[4 * q + 2] = v[2]; acc[4 * q + 3] = v[3]; }
        LAS const unsigned char* atp = ATm + j * 64;
#pragma clang loop unroll(full)
        for (int i = 0; i < 63; ++i) {
            const int jo = i & 3, mo = i >> 2;
            const float x = (jo == 0) ? dpp_f<0x00>(acc[mo]) : (jo == 1) ? dpp_f<0x55>(acc[mo]) : (jo == 2) ? dpp_f<0xAA>(acc[mo]) : dpp_f<0xFF>(acc[mo]);
#pragma unroll
            for (int q = mo / 4; q < 4; ++q) {
                const f32x4 a4 = *(LAS const f32x4*)(atp + i * FS + q * 16);
#pragma unroll
                for (int e = 0; e < 4; ++e) { const int m = 4 * q + e;
                    if (m > mo) acc[m] += a4[e] * x;
                    else if (m == mo) acc[m] += ((j > jo) ? a4[e] : 0.f) * x; }
            }
        }
#pragma unroll
        for (int m = 0; m < 16; ++m) *(LAS bf16_t*)(XsT + col * TS + (4 * m + j) * 2) = f2bf(acc[m]);
    }
    __syncthreads();
    {
        const int tile = wave & 3, ta = tile >> 1, tb = tile & 1;
        if (wave < 4) {
            f32x16 d = zero16();
#pragma unroll
            for (int s4 = 0; s4 < 4; ++s4) d = MFMA32(rowfrag(XsT, 32 * ta + l31, s4, hi), colfrag(T_Bh, 32 * tb, s4, lane), d);
            if (ta == tb) { const float gc = GCs[32 * tb + l31];
#pragma unroll
                for (int r = 0; r < 16; ++r) if (crow(r, hi) == l31) d[r] += gc; }
            u32x4* mf = (u32x4*)(prm.ws + WS_MF + (size_t)item * 8192) + ((ta * 2 + tb) * 2) * 64 + lane;
#pragma unroll
            for (int s2 = 0; s2 < 2; ++s2) mf[s2 * 64] = (u32x4){cvtpk(d[8 * s2], d[8 * s2 + 1]), cvtpk(d[8 * s2 + 2], d[8 * s2 + 3]), cvtpk(d[8 * s2 + 4], d[8 * s2 + 5]), cvtpk(d[8 * s2 + 6], d[8 * s2 + 7])};
            f32x16 n = zero16();
#pragma unroll
            for (int s4 = 0; s4 < 4; ++s4) n = MFMA32(colfrag(T_Bh, 32 * ta, s4, lane), rowfrag(XsT, 64 + 32 * tb + l31, s4, hi), n);
#pragma unroll
            for (int s4 = 0; s4 < 4; ++s4) n = MFMA32(colfrag(T_Kh, 32 * ta, s4, lane), colfrag(T_V, 32 * tb, s4, lane), n);
            f32x4* nf = (f32x4*)(prm.ws + WS_NF + (size_t)item * 16384) + ((tb * 2 + ta) * 64 + lane) * 4;
#pragma unroll
            for (int rg = 0; rg < 4; ++rg) nf[rg] = (f32x4){n[4 * rg], n[4 * rg + 1], n[4 * rg + 2], n[4 * rg + 3]};
        } else {
            f32x16 d;
#pragma unroll
            for (int rg = 0; rg < 4; ++rg) { const u32x2 w = *(LAS const u32x2*)(T_Rt + (32 * tb + l31) * TS + (32 * ta + 8 * rg + 4 * hi) * 2);
                d[4 * rg] = bflo(w[0]); d[4 * rg + 1] = bfhi(w[0]); d[4 * rg + 2] = bflo(w[1]); d[4 * rg + 3] = bfhi(w[1]); }
#pragma unroll
            for (int s4 = 0; s4 < 4; ++s4) d = MFMA32(rowfrag(XsT, 32 * ta + l31, s4, hi), rowfrag(T_Arb, 32 * tb + l31, s4, hi), d);
            u32x4* qf = (u32x4*)(prm.ws + WS_QF + (size_t)item * 8192) + ((ta * 2 + tb) * 2) * 64 + lane;
#pragma unroll
            for (int s2 = 0; s2 < 2; ++s2) qf[s2 * 64] = (u32x4){cvtpk(d[8 * s2], d[8 * s2 + 1]), cvtpk(d[8 * s2 + 2], d[8 * s2 + 3]), cvtpk(d[8 * s2 + 4], d[8 * s2 + 5]), cvtpk(d[8 * s2 + 6], d[8 * s2 + 7])};
            f32x16 y = zero16();
#pragma unroll
            for (int s4 = 0; s4 < 4; ++s4) y = MFMA32(rowfrag(XsT, 64 + 32 * ta + l31, s4, hi), rowfrag(T_Arb, 32 * tb + l31, s4, hi), y);
#pragma unroll
            for (int s4 = 0; s4 < 4; ++s4) y = MFMA32(colfrag(T_V, 32 * ta, s4, lane), rowfrag(T_Ark, 32 * tb + l31, s4, hi), y);
            f32x4* yf = (f32x4*)(prm.ws + WS_YF + (size_t)item * 16384) + ((ta * 2 + tb) * 64 + lane) * 4;
#pragma unroll
            for (int rg = 0; rg < 4; ++rg) yf[rg] = (f32x4){y[4 * rg], y[4 * rg + 1], y[4 * rg + 2], y[4 * rg + 3]};
        }
    }
    __syncthreads();
}

constexpr int N_S_BLOCKS = NB * 6 * 2;
__device__ __forceinline__ void passS_block(const Params& prm, LAS unsigned char* lds, int sblk, int tid) {
    const int lane = tid & 63, wave = tid >> 6;
    const int seq = sblk >> 1, vh = sblk & 1;
    const size_t item0 = (size_t)seq * NCH;
    const int ltid = tid - 64;
    const unsigned char* mbase = prm.ws + WS_MF + item0 * 8192;
    const unsigned char* nbase = prm.ws + WS_NF + item0 * 16384 + (size_t)vh * 8192;
    u32x4 hold[8][3];
#define PS_SRC(chunk, piece) (((piece) < 512) ? (const u32x4*)(mbase + (size_t)(chunk) * 8192) + (piece) : (const u32x4*)(nbase + (size_t)(chunk) * 16384) + ((piece) - 512))
#define PS_ISSUE(chunk, buf) do { if ((chunk) < NCH) { hold[buf][0] = *PS_SRC(chunk, ltid); hold[buf][1] = *PS_SRC(chunk, ltid + 448); if (ltid < 128) hold[buf][2] = *PS_SRC(chunk, ltid + 896); } } while (0)
#define PS_COMMIT(chunk, buf) do { if ((chunk) < NCH) { LAS unsigned char* slot_ = lds + ((chunk) & 7) * 16384; *(LAS u32x4*)(slot_ + ltid * 16) = hold[buf][0]; *(LAS u32x4*)(slot_ + (ltid + 448) * 16) = hold[buf][1]; \
        if (ltid < 128) *(LAS u32x4*)(slot_ + (ltid + 896) * 16) = hold[buf][2]; } } while (0)
    f32x16 acc[2]; acc[0] = zero16(); acc[1] = zero16();
    if (wave >= 1) {
        PS_ISSUE(0, 0); PS_ISSUE(1, 1); PS_COMMIT(0, 0); PS_COMMIT(1, 1);
        PS_ISSUE(2, 2); PS_ISSUE(3, 3); PS_ISSUE(4, 4); PS_ISSUE(5, 5); PS_ISSUE(6, 6); PS_ISSUE(7, 7); PS_ISSUE(8, 0); PS_ISSUE(9, 1);
    }
    __syncthreads();
    for (int c8 = 0; c8 < NCH; c8 += 8) {
#pragma unroll
        for (int par = 0; par < 8; ++par) {
            const int cc = c8 + par;
            if (wave == 0) {
                LAS const unsigned char* slot = lds + par * 16384;
                bf16x8 xb[2][2];
#pragma unroll
                for (int kt = 0; kt < 2; ++kt)
#pragma unroll
                    for (int s2 = 0; s2 < 2; ++s2) { const u32x4 w = (u32x4){cvtpk(acc[kt][8 * s2], acc[kt][8 * s2 + 1]), cvtpk(acc[kt][8 * s2 + 2], acc[kt][8 * s2 + 3]), cvtpk(acc[kt][8 * s2 + 4], acc[kt][8 * s2 + 5]), cvtpk(acc[kt][8 * s2 + 6], acc[kt][8 * s2 + 7])};
                        xb[kt][s2] = __builtin_bit_cast(bf16x8, w);
                        ((u32x4*)(prm.ws + WS_SF + (item0 + cc) * 8192))[((vh * 2 + kt) * 2 + s2) * 64 + lane] = w; }
                f32x16 nacc[2];
#pragma unroll
                for (int i = 0; i < 2; ++i) {
#pragma unroll
                    for (int rg = 0; rg < 4; ++rg) { const f32x4 v = *(LAS const f32x4*)(slot + 8192 + (i * 64 + lane) * 64 + rg * 16); nacc[i][4 * rg] = v[0]; nacc[i][4 * rg + 1] = v[1]; nacc[i][4 * rg + 2] = v[2]; nacc[i][4 * rg + 3] = v[3]; }
#pragma unroll
                    for (int kt = 0; kt < 2; ++kt)
#pragma unroll
                        for (int s2 = 0; s2 < 2; ++s2) { const bf16x8 mf = *(LAS const bf16x8*)(slot + (((kt * 2 + i) * 2 + s2) * 64 + lane) * 16); nacc[i] = MFMA32(mf, xb[kt][s2], nacc[i]); }
                }
                acc[0] = nacc[0]; acc[1] = nacc[1];
            } else {
                PS_COMMIT(cc + 2, (par + 2) & 7); PS_ISSUE(cc + 10, (par + 2) & 7);
            }
            __syncthreads();
        }
    }
#undef PS_SRC
#undef PS_ISSUE
#undef PS_COMMIT
    if (wave == 0) {
        float* so = prm.out + O_ST_P + ((size_t)seq * 64 + 32 * vh + (lane & 31)) * 64;
#pragma unroll
        for (int kt = 0; kt < 2; ++kt)
#pragma unroll
            for (int rg = 0; rg < 4; ++rg) *(f32x4*)(so + 32 * kt + 8 * rg + 4 * (lane >> 5)) = (f32x4){acc[kt][4 * rg], acc[kt][4 * rg + 1], acc[kt][4 * rg + 2], acc[kt][4 * rg + 3]};
    }
    __syncthreads();
}

__device__ __forceinline__ void passO_pair(const Params& prm, int item, int tt, int lane) {
    const int hi = lane >> 5, l31 = lane & 31;
    const int seq = item >> 7, c = item & 127, b = seq / 6, h = seq % 6;
    const u32x4* sf = (const u32x4*)(prm.ws + WS_SF + (size_t)item * 8192);
    const u32x4* qf = (const u32x4*)(prm.ws + WS_QF + (size_t)item * 8192);
    const f32x4* yf = (const f32x4*)(prm.ws + WS_YF + (size_t)item * 16384);
    bf16x8 qb[2][2];
#pragma unroll
    for (int kt = 0; kt < 2; ++kt)
#pragma unroll
        for (int s2 = 0; s2 < 2; ++s2) qb[kt][s2] = __builtin_bit_cast(bf16x8, qf[((kt * 2 + tt) * 2 + s2) * 64 + lane]);
    f32x16 y[2];
#pragma unroll
    for (int vt = 0; vt < 2; ++vt) {
#pragma unroll
        for (int rg = 0; rg < 4; ++rg) { const f32x4 v = yf[((vt * 2 + tt) * 64 + lane) * 4 + rg]; y[vt][4 * rg] = v[0]; y[vt][4 * rg + 1] = v[1]; y[vt][4 * rg + 2] = v[2]; y[vt][4 * rg + 3] = v[3]; }
#pragma unroll
        for (int kt = 0; kt < 2; ++kt)
#pragma unroll
            for (int s2 = 0; s2 < 2; ++s2) y[vt] = MFMA32(__builtin_bit_cast(bf16x8, sf[((vt * 2 + kt) * 2 + s2) * 64 + lane]), qb[kt][s2], y[vt]);
    }
    float sm = 0.f;
#pragma unroll
    for (int vt = 0; vt < 2; ++vt)
#pragma unroll
        for (int r = 0; r < 16; ++r) sm += y[vt][r];
    sm += __shfl_xor(sm, 32);
    const float mean = sm * (1.f / 64.f);
    float sq = 0.f;
#pragma unroll
    for (int vt = 0; vt < 2; ++vt)
#pragma unroll
        for (int r = 0; r < 16; ++r) { const float d = y[vt][r] - mean; sq += d * d; }
    sq += __shfl_xor(sq, 32);
    const float rstd = rsqrtf(sq * (1.f / 64.f) + 64e-5f);
    const int t = 64 * c + 32 * tt + l31;
    const size_t row = (size_t)b * SEQ + t;
    const float rho = ((const float*)(prm.ws + WS_RHO))[(size_t)item * 64 + 32 * tt + l31];
    const float* ZB = (const float*)(prm.ws + WS_ZB);
    const float* mu = prm.in[11]; const float* lg = prm.in[19]; const float* lb = prm.in[20];
    const bf16_t* Gb = (const bf16_t*)(prm.ws + WS_G); bf16_t* OG = (bf16_t*)(prm.ws + WS_OG);
#pragma unroll
    for (int vt = 0; vt < 2; ++vt)
#pragma unroll
        for (int rg = 0; rg < 4; ++rg) {
            const int v0 = 32 * vt + 8 * rg + 4 * hi, ch = h * 64 + v0;
            const f32x4 z = *(const f32x4*)(ZB + row * SHIFT_W + 2 * RW + ch);
            f32x4 zp = (f32x4){0.f, 0.f, 0.f, 0.f};
            if (t > 0) zp = *(const f32x4*)(ZB + (row - 1) * SHIFT_W + 2 * RW + ch);
            const f32x4 muv = *(const f32x4*)(mu + 2 * RW + ch), gv = *(const f32x4*)(lg + ch), bv = *(const f32x4*)(lb + ch);
            const u32x2 gw = *(const u32x2*)(Gb + row * DM + 384 + ch);
            const float gg[4] = {bflo(gw[0]), bfhi(gw[0]), bflo(gw[1]), bfhi(gw[1])};
            float o[4];
#pragma unroll
            for (int e = 0; e < 4; ++e) { const float vv = z[e] + (zp[e] - z[e]) * muv[e]; o[e] = ((y[vt][4 * rg + e] - mean) * rstd * gv[e] + bv[e] + rho * vv) * gg[e]; }
            *(u32x2*)(OG + row * DM + 384 + ch) = (u32x2){cvtpk(o[0], o[1]), cvtpk(o[2], o[3])};
        }
}

__device__ __forceinline__ void p0_transpose_item(const float* W, const float* gain, int K, int N, bf16_t* WT, int row_off, LAS float* scr, int item, int lane) {
    const int nblk = N / 32, kb = item / nblk, nb = item % nblk, k0 = 64 * kb, n0 = 32 * nb;
#pragma unroll 8
    for (int i = 0; i < 32; ++i) { const int kk = 2 * i + (lane >> 5); const float gk = gain ? gain[k0 + kk] : 1.f; scr[kk * 33 + (lane & 31)] = W[(size_t)(k0 + kk) * N + n0 + (lane & 31)] * gk; }
    LDS_WAIT(); asm volatile("" ::: "memory");
    const int c = lane & 7;
#pragma unroll
    for (int j = 0; j < 4; ++j) { const int n = (lane >> 3) + 8 * j; const LAS float* s = scr + (8 * c) * 33 + n;
        u32x4 o; o[0] = cvtpk(s[0 * 33], s[1 * 33]); o[1] = cvtpk(s[2 * 33], s[3 * 33]); o[2] = cvtpk(s[4 * 33], s[5 * 33]); o[3] = cvtpk(s[6 * 33], s[7 * 33]);
        *(u32x4*)(WT + (size_t)(row_off + n0 + n) * K + k0 + 8 * c) = o; }
    LDS_WAIT(); asm volatile("" ::: "memory");
}
__device__ __forceinline__ void sincos_acc(float angf, float& c, float& s) {
    const double a = (double)angf;
    const double kq = __builtin_rint(a * 0.63661977236758134308);
    const double r = (a - kq * 1.57079632679489655800) - kq * 6.12323399573676603587e-17;
    const double r2 = r * r;
    double sp = -1.0 / 1307674368000.0; sp = sp * r2 + 1.0 / 6227020800.0; sp = sp * r2 - 1.0 / 39916800.0; sp = sp * r2 + 1.0 / 362880.0; sp = sp * r2 - 1.0 / 5040.0; sp = sp * r2 + 1.0 / 120.0; sp = sp * r2 - 1.0 / 6.0; sp = sp * r2 + 1.0; sp *= r;
    double cp = 1.0 / 87178291200.0; cp = cp * r2 - 1.0 / 479001600.0; cp = cp * r2 + 1.0 / 3628800.0; cp = cp * r2 - 1.0 / 40320.0; cp = cp * r2 + 1.0 / 720.0; cp = cp * r2 - 1.0 / 24.0; cp = cp * r2 + 0.5; cp = 1.0 - cp * r2;
    const int qd = ((int)kq) & 3;
    const double sv = (qd == 0) ? sp : (qd == 1) ? cp : (qd == 2) ? -sp : -cp;
    const double cv = (qd == 0) ? cp : (qd == 1) ? -sp : (qd == 2) ? -cp : sp;
    c = (float)cv; s = (float)sv;
}
__device__ __forceinline__ void p0_prologue(const Ptrs& P, LAS unsigned char* lds, int bid, int G, int tid) {
    const int lane = tid & 63, wave = tid >> 6;
    LAS float* scr = (LAS float*)(lds + wave * 16384);
    const int gw = bid * 8 + wave, NGW = G * 8;
    constexpr int I_IN = (DM / 64) * (IN_W / 32), I_MEM = (DM / 64) * (512 / 32), I_OUT = (DM / 64) * (DM / 32);
    for (int it = gw; it < I_IN + I_MEM + I_OUT; it += NGW) {
        int r = it;
        if (r < I_IN) { p0_transpose_item(P.in[10], P.in[9], DM, IN_W, P.WT, 0, scr, r, lane); continue; } r -= I_IN;
        if (r < I_MEM) { p0_transpose_item(P.in[22], P.in[21], DM, 512, P.WT, NPAD, scr, r, lane); continue; } r -= I_MEM;
        p0_transpose_item(P.in[23], nullptr, DM, DM, P.WOT, 0, scr, r, lane);
    }
    const int gt = bid * NTHR + tid, NGT = G * NTHR;
    for (int e = gt; e < (NPAD - IN_W) * DM / 8; e += NGT) *(u32x4*)(P.WT + (size_t)IN_W * DM + (size_t)e * 8) = (u32x4){0u, 0u, 0u, 0u};
    for (int m = gw; m < MROWS; m += NGW) {
        const float* xr = (m < MP) ? P.in[0] + (size_t)m * DM : (m < MTOK) ? P.in[1] + (size_t)(m - MP) * DM : P.in[8] + (size_t)(m - MTOK) * DM;
        f32x4 v[4]; float ss = 0.f;
#pragma unroll
        for (int j = 0; j < 4; ++j) { v[j] = *(const f32x4*)(xr + (size_t)(64 * j + lane) * 4); ss += (v[j][0] * v[j][0] + v[j][1] * v[j][1]) + (v[j][2] * v[j][2] + v[j][3] * v[j][3]); }
        ss = wave_sum(ss);
        if (lane == 0) P.RINV[m] = rsqrtf(ss * (1.f / DM) + 1e-6f);
#pragma unroll
        for (int j = 0; j < 4; ++j) { u32x2 w; w[0] = cvtpk(v[j][0], v[j][1]); w[1] = cvtpk(v[j][2], v[j][3]); *(u32x2*)(P.XB + (size_t)m * DM + (size_t)(64 * j + lane) * 4) = w; }
    }
    for (int e = gt; e < NPOS * 8; e += NGT) {
        const int pos = e >> 3, i = e & 7;
        const float invf[8] = {1.0f, 0.19392274f, 0.03760603f, 0.0072926646f, 0.0014142136f, 0.0002742482f, 5.3182957e-05f, 1.0313385e-05f};
        float fi = invf[0];
#pragma unroll
        for (int k = 1; k < 8; ++k) fi = (i == k) ? invf[k] : fi;
        const float ang = (float)pos * fi; float c, s; sincos_acc(ang, c, s);
        P.ROPE[pos * 16 + i] = c; P.ROPE[pos * 16 + 8 + i] = s;
    }
    for (int e = gt; e < MTOK; e += NGT) P.SS[e] = 0.f;
}

__device__ __forceinline__ void p3_combine(const Ptrs& P, int bid, int G, int tid) {
    const int gt = bid * NTHR + tid, NGT = G * NTHR;
    for (int e = gt; e < MTOK * 48; e += NGT) {
        const int row = e / 48, ch = e % 48, h = ch >> 3;
        const float l0 = P.LSE[((size_t)0 * MTOK + row) * 6 + h], l1 = P.LSE[((size_t)1 * MTOK + row) * 6 + h], l2 = P.LSE[((size_t)2 * MTOK + row) * 6 + h];
        const float mx = fmaxf(l0, fmaxf(l1, l2)); const float e0 = __expf(l0 - mx), e1 = __expf(l1 - mx), e2 = __expf(l2 - mx); const float inv = 1.f / (e0 + e1 + e2);
        const float w0 = e0 * inv, w1 = e1 * inv, w2 = e2 * inv;
        const u32x4 a = *(const u32x4*)(P.OAP + ((size_t)0 * MTOK + row) * ATT_W + ch * 8), b = *(const u32x4*)(P.OAP + ((size_t)1 * MTOK + row) * ATT_W + ch * 8), c = *(const u32x4*)(P.OAP + ((size_t)2 * MTOK + row) * ATT_W + ch * 8);
        const u32x4 gg = *(const u32x4*)(P.Gb + (size_t)row * DM + ch * 8);
        u32x4 o;
#pragma unroll
        for (int k = 0; k < 4; ++k) {
            const float lo = (w0 * bflo(a[k]) + w1 * bflo(b[k]) + w2 * bflo(c[k])) * bflo(gg[k]);
            const float hi = (w0 * bfhi(a[k]) + w1 * bfhi(b[k]) + w2 * bfhi(c[k])) * bfhi(gg[k]);
            o[k] = cvtpk(lo, hi);
        }
        *(u32x4*)(P.OG + (size_t)row * DM + ch * 8) = o;
    }
}

__device__ __forceinline__ void p5_norm(const Ptrs& P, int bid, int G, int tid) {
    const int lane = tid & 63, wave = tid >> 6, gw = bid * 8 + wave, NGW = G * 8;
    const float* gf = P.in[24];
    for (int m = gw; m < MTOK; m += NGW) {
        const float rs = rsqrtf(P.SS[m] * (1.f / DM) + 1e-6f);
        float* yr = P.out + O_Y + (size_t)m * DM;
#pragma unroll
        for (int j = 0; j < 4; ++j) { const size_t c = (size_t)(64 * j + lane) * 4; const f32x4 v = *(const f32x4*)(yr + c); const f32x4 gv = *(const f32x4*)(gf + c); *(f32x4*)(yr + c) = v * rs * gv; }
    }
}

#define XB_TMO      128
#define XB_XCNT(j)  (256  + 64 * (j))
#define XB_XSUB(j)  (1280 + 64 * (j))
#define XB_XGEN(j)  (2304 + 64 * (j))
#define XB_TOP      3328
#define XB_TOPGEN   3392
#define XCD_BAR_WORDS 3456
#define XB_SPIN_CAP (1u << 18)
__device__ __forceinline__ unsigned xb_ld(unsigned* p)              { return __hip_atomic_load(p, __ATOMIC_RELAXED, __HIP_MEMORY_SCOPE_AGENT); }
__device__ __forceinline__ unsigned xb_add(unsigned* p, unsigned v) { return __hip_atomic_fetch_add(p, v, __ATOMIC_RELAXED, __HIP_MEMORY_SCOPE_AGENT); }
__device__ __forceinline__ unsigned xb_xcc_id() { return (unsigned)__builtin_amdgcn_s_getreg((3 << 11) | 20) & 0xFu; }
#define XB_SPIN(cond, bar) do { unsigned _sp = 0; while (cond) { __builtin_amdgcn_s_sleep(1); \
    if ((++_sp & 255u) == 0u) { if (xb_ld(&(bar)[XB_TMO])) break; if (_sp > XB_SPIN_CAP) { atomicAdd(&(bar)[XB_TMO], 1u); break; } } } } while (0)
struct XcdBarrier { unsigned* bar; unsigned x; volatile LAS unsigned* st; };
__device__ __forceinline__ XcdBarrier xcd_barrier_post(unsigned* bar, volatile LAS unsigned* st) {
    XcdBarrier b; b.bar = bar; b.x = xb_xcc_id(); b.st = st;
    if (threadIdx.x == 0) (void)xb_add(&bar[XB_XCNT(b.x)], 1u);
    return b;
}
__device__ __forceinline__ void xcd_barrier_complete(unsigned* bar, unsigned x, unsigned& nloc, unsigned& nx) {
    const unsigned G = gridDim.x * gridDim.y * gridDim.z;
    unsigned sum, cnt, mine, sp = 0u;
    for (;;) {
        sum = 0u; cnt = 0u; mine = 0u;
#pragma unroll
        for (unsigned j = 0; j < 16; ++j) { const unsigned c = xb_ld(&bar[XB_XCNT(j)]); sum += c; cnt += (c > 0u) ? 1u : 0u; mine = (j == x) ? c : mine; }
        if (sum == G) break;
        __builtin_amdgcn_s_sleep(1);
        if ((++sp & 255u) == 0u) { if (xb_ld(&bar[XB_TMO])) break; if (sp > XB_SPIN_CAP) { atomicAdd(&bar[XB_TMO], 1u); break; } }
    }
    nloc = mine > 0u ? mine : 1u; nx = cnt > 0u ? cnt : 1u;
}
__device__ __forceinline__ void xcd_barrier(const XcdBarrier& b) {
    asm volatile("s_waitcnt vmcnt(0)" ::: "memory");
    __syncthreads();
    if (threadIdx.x == 0) {
        unsigned* bar = b.bar;
        __builtin_amdgcn_s_waitcnt(0);
        unsigned nloc = b.st[0], nx = b.st[1];
        if (nloc == 0u) { xcd_barrier_complete(bar, b.x, nloc, nx); b.st[0] = nloc; b.st[1] = nx; }
        const unsigned old = xb_add(&bar[XB_XSUB(b.x)], 1u);
        const unsigned gen = old / nloc;
        if (old + 1u == (gen + 1u) * nloc) {
            __builtin_amdgcn_fence(__ATOMIC_RELEASE, "agent");
            asm volatile("s_waitcnt vmcnt(0)" ::: "memory");
            const unsigned og = xb_add(&bar[XB_TOP], 1u);
            const unsigned tg = og / nx;
            if (og + 1u == (tg + 1u) * nx) xb_add(&bar[XB_TOPGEN], 1u);
            else XB_SPIN(xb_ld(&bar[XB_TOPGEN]) == tg, bar);
            __builtin_amdgcn_fence(__ATOMIC_ACQUIRE, "agent");
            xb_add(&bar[XB_XGEN(b.x)], 1u);
            asm volatile("s_waitcnt vmcnt(0)" ::: "memory");
        } else {
            XB_SPIN(xb_ld(&bar[XB_XGEN(b.x)]) == gen, bar);
            __builtin_amdgcn_fence(__ATOMIC_ACQUIRE, "agent");
            asm volatile("s_waitcnt vmcnt(0)" ::: "memory");
        }
    }
    __syncthreads();
}

__global__ void __launch_bounds__(NTHR, 2) fwd_kernel(Params prm) {
    extern __shared__ __attribute__((aligned(16))) unsigned char lds_raw[];
    LAS unsigned char* lds = (LAS unsigned char*)lds_raw;
    const int tid = threadIdx.x, bid = blockIdx.x, G = gridDim.x;
    Ptrs P;
#pragma unroll
    for (int i = 0; i < 25; ++i) P.in[i] = prm.in[i];
    P.out = prm.out; P.ws = prm.ws;
    P.RINV = (float*)(prm.ws + WS_RINV); P.SS = (float*)(prm.ws + WS_SS); P.ROPE = (float*)(prm.ws + WS_ROPE); P.ZB = (float*)(prm.ws + WS_ZB); P.LSE = (float*)(prm.ws + WS_LSE);
    P.WT = (bf16_t*)(prm.ws + WS_WT); P.WOT = (bf16_t*)(prm.ws + WS_WOT); P.XB = (bf16_t*)(prm.ws + WS_XB); P.Qb = (bf16_t*)(prm.ws + WS_Q); P.Kb = (bf16_t*)(prm.ws + WS_K); P.Vb = (bf16_t*)(prm.ws + WS_V);
    P.QMb = (bf16_t*)(prm.ws + WS_QM); P.Gb = (bf16_t*)(prm.ws + WS_G); P.MKB = (bf16_t*)(prm.ws + WS_MKB); P.MVB = (bf16_t*)(prm.ws + WS_MVB); P.OAP = (bf16_t*)(prm.ws + WS_OAP); P.OG = (bf16_t*)(prm.ws + WS_OG);
    const int lo = prm.ph_lo, hi = prm.ph_hi;
#define IN_PH(k) (lo <= (k) && (k) < hi)
    volatile LAS unsigned* bst = (volatile LAS unsigned*)(lds + LDS_BYTES - 16);
    if (tid < 4) bst[tid] = 0u;
    __syncthreads();
    XcdBarrier xbar; xbar.bar = (unsigned*)(prm.ws + WS_CTL) + 4096; xbar.x = 0; xbar.st = bst;
    if (prm.coop) xbar = xcd_barrier_post((unsigned*)(prm.ws + WS_CTL) + 4096, bst);
#define SEAM(k) do { if (IN_PH(k) && IN_PH((k) + 1)) { if (prm.pad == 0x5eed) cg::this_grid().sync(); else xcd_barrier(xbar); } } while (0)

#ifndef DUP_P0
#define DUP_P0 1
#endif
#ifndef DUP_P1
#define DUP_P1 1
#endif
#ifndef DUP_P4
#define DUP_P4 1
#endif
    if (IN_PH(0)) { for (int rep = 0; rep < DUP_P0; ++rep) p0_prologue(P, lds, bid, G, tid); }
    SEAM(0);
    if (IN_PH(1)) {
        pg8::Gemm g{P.XB, P.WT, MROWS, NWT, DM}; Sched1 S; S.init(G, bid);
        Epi1 E{P.RINV, P.ROPE, P.Qb, P.Kb, P.Vb, P.QMb, P.Gb, P.MKB, P.MVB, P.ZB, P.out};
        for (int rep = 0; rep < DUP_P1; ++rep) pg8::gemm_phase<Epi1, Sched1, true, true>(lds, g, S, E);
    }
    SEAM(1);
#define ITEM_LOOP(LO, HI, B0, GG, CALL) do { int it = (LO) + (((B0) - (LO)) % (GG) + (GG)) % (GG); for (; it < (HI); it += (GG)) { const int li = it - (LO); CALL; } } while (0)
    if (IN_PH(2)) {
        constexpr int N0 = N_L_ITEMS, N1 = N0 + N_SCAN_S;
#ifndef DUP_L
#define DUP_L 1
#endif
#ifndef DUP_SS
#define DUP_SS 1
#endif
#ifndef DUP_S
#define DUP_S 1
#endif
#ifndef DUP_ATT
#define DUP_ATT 1
#endif
#ifndef DUP_MEM
#define DUP_MEM 1
#endif
#ifndef DUP_SDIL
#define DUP_SDIL 1
#endif
#ifndef DUP_SMEM
#define DUP_SMEM 1
#endif
        ITEM_LOOP(0, DUP_L * N0, bid, G, passL_item(prm, lds, li % N_L_ITEMS, tid));
        ITEM_LOOP(0, DUP_SS * N_SCAN_S, bid, G, scan_item(P, lds, true, (li % N_SCAN_S) / 6, li % 6, tid));
    }
    SEAM(2);
    if (IN_PH(3)) {
        if (bid < N_S_BLOCKS) { for (int rep = 0; rep < DUP_S; ++rep) passS_block(prm, lds, bid, tid); }
        else {
            constexpr int N1 = N_DIL_UNITS, N2 = N1 + N_MEMA_UNITS, N3 = N2 + N_SDIL_ITEMS, N4 = N3 + N_SMEM_ITEMS;
            const int b0 = bid - N_S_BLOCKS, gg = G - N_S_BLOCKS;
            ITEM_LOOP(0, DUP_ATT * N1, b0, gg, dil_unit(P, lds, li % N_DIL_UNITS, tid));
            ITEM_LOOP(0, DUP_MEM * N_MEMA_UNITS, b0, gg, mem_unit(P, lds, li % N_MEMA_UNITS, tid));
            ITEM_LOOP(0, DUP_SDIL * N_SDIL_ITEMS, b0, gg, sdil_item(P, lds, li % N_SDIL_ITEMS, tid));
            ITEM_LOOP(0, DUP_SMEM * N_SMEM_ITEMS, b0, gg, smem_item(P, lds, li % N_SMEM_ITEMS, tid));
        }
    }
    SEAM(3);
    if (IN_PH(4)) {
        for (int rep = 0; rep < DUP_P4; ++rep) {
        for (int pr = bid * 8 + (tid >> 6); pr < 2 * N_L_ITEMS; pr += G * 8) passO_pair(prm, pr >> 1, pr & 1, tid & 63);
        p3_combine(P, bid, G, tid); }
    }
    SEAM(4);
    if (IN_PH(5)) {
        pg8::Gemm g{P.OG, P.WOT, MTOK, DM, DM}; pg8::StaticOrder S; S.init(MTOK, DM, G, bid);
        Epi2 E{P.in[0], P.in[1], P.out + O_Y, P.SS};
        pg8::gemm_phase<Epi2, pg8::StaticOrder, true, true>(lds, g, S, E);
    }
    SEAM(5);
    if (IN_PH(6)) { p5_norm(P, bid, G, tid); }
}

constexpr int N_PHASES = 7;
#ifndef MK_ONE_LAUNCH
#define MK_ONE_LAUNCH 1
#endif
extern "C" void kernel_launch(void* const* d_in, const int* in_sizes, int n_in, void* d_out, int out_size, void* d_ws, size_t ws_size, hipStream_t stream) {
    static int grid = 0;
    if (grid == 0) {
        if (n_in != 25 || out_size != (int)O_END || ws_size < WS_END2) { fprintf(stderr, "kernel_launch: unexpected shapes (n_in %d, out %d, ws %zu < %zu)\n", n_in, out_size, ws_size, (size_t)WS_END2); grid = -1; return; }
        int dev = 0, cus = 0, per_cu = 0;
        (void)hipGetDevice(&dev); (void)hipDeviceGetAttribute(&cus, hipDeviceAttributeMultiprocessorCount, dev);
        if (hipFuncSetAttribute((const void*)fwd_kernel, hipFuncAttributeMaxDynamicSharedMemorySize, LDS_BYTES) != hipSuccess) { fprintf(stderr, "kernel_launch: hipFuncSetAttribute failed\n"); grid = -1; return; }
        if (hipOccupancyMaxActiveBlocksPerMultiprocessor(&per_cu, (const void*)fwd_kernel, NTHR, LDS_BYTES) != hipSuccess || per_cu < 1) { fprintf(stderr, "kernel_launch: occupancy query says %d blocks per CU\n", per_cu); (void)hipGetLastError(); per_cu = 1; }
        grid = cus;
    }
    if (grid < 0) return;
    if (hipMemsetAsync((char*)d_ws + WS_CTL, 0, 65536, stream) != hipSuccess) { fprintf(stderr, "kernel_launch: hipMemsetAsync failed\n"); return; }
    Params p{};
    for (int i = 0; i < 25; ++i) p.in[i] = (const float*)d_in[i];
    p.out = (float*)d_out; p.ws = (unsigned char*)d_ws;
#if MK_ONE_LAUNCH
    p.ph_lo = 0; p.ph_hi = N_PHASES; p.coop = 1;
    void* args[] = {&p};
    hipError_t e = hipLaunchCooperativeKernel((const void*)fwd_kernel, dim3(grid), dim3(NTHR), args, LDS_BYTES, stream);
    if (e != hipSuccess) fprintf(stderr, "cooperative launch failed: %s (grid %d)\n", hipGetErrorString(e), grid);
#else
    for (int ph = 0; ph < N_PHASES; ++ph) {
        p.ph_lo = ph; p.ph_hi = ph + 1; p.coop = 0;
        hipLaunchKernelGGL(fwd_kernel, dim3(grid), dim3(NTHR), LDS_BYTES, stream, p);
    }
#endif
}
```
